# Optimizing an MI355X kernel written in HIP

```python
import jax, jax.numpy as jnp
from jax import lax
import numpy as np

D_MODEL = 2048
BATCH = 16
SEQ = 256
DEPTH = 4
DEC_BATCH = 4
DEC_SEQ = 4096
PAST_LEN = 256

GRID_W = 64
N_HEADS = 8
HEAD_DIM = 128
ATTN_DIM = N_HEADS * HEAD_DIM
NA_KH = 8
NA_KW = 16
F_GROUPS = 4
F_GROUP_DIM = 256
FOURIER_DIM = F_GROUPS * F_GROUP_DIM
FFN_DIM = 5632
N_MOD = 6
RMS_EPS = 1e-6
IN_DIM = 3 * ATTN_DIM + FOURIER_DIM + 2 * D_MODEL
IN_SPLITS = (ATTN_DIM, 2 * ATTN_DIM, 3 * ATTN_DIM, 3 * ATTN_DIM + FOURIER_DIM,
             3 * ATTN_DIM + FOURIER_DIM + D_MODEL)
ATTN_SCALE = 1.0 / math.sqrt(HEAD_DIM) if False else HEAD_DIM ** -0.5

kernel_name = 'hybrid_natten_fnet_prefix_diffusion_step'


def rms_norm(x, g):
    x32 = x.astype(jnp.float32)
    y = x32 * lax.rsqrt(jnp.mean(x32 * x32, axis=-1, keepdims=True) + RMS_EPS)
    return (y * g.astype(jnp.float32)).astype(x.dtype)


def adaln_params(cvec, w_mod_l, b_mod_l):
    m = jax.nn.silu(cvec) @ w_mod_l + b_mod_l
    m = m.reshape(cvec.shape[:-1] + (N_MOD, D_MODEL))
    return tuple(m[..., i, None, :] for i in range(N_MOD))


def context_attention(q, k, v):
    s = jnp.einsum('bhqd,bhkd->bhqk', q, k).astype(jnp.float32) * ATTN_SCALE
    p = jax.nn.softmax(s, axis=-1).astype(v.dtype)
    return jnp.einsum('bhqk,bhkd->bhqd', p, v)


def neighbourhood_attention(q, k, v, k_ctx, v_ctx, rpb_l):
    B, H, N, dh = q.shape
    rows = N // GRID_W
    kh = min(NA_KH, rows)
    kw = min(NA_KW, GRID_W)
    qg = q.reshape(B, H, rows, GRID_W, dh)
    kg = k.reshape(B, H, rows, GRID_W, dh)
    vg = v.reshape(B, H, rows, GRID_W, dh)
    r = jnp.arange(rows)
    r0 = jnp.clip(r - kh // 2, 0, rows - kh)
    key_rows = r0[:, None] + jnp.arange(kh)[None, :]
    k_nb = jnp.take(kg, key_rows, axis=2)
    v_nb = jnp.take(vg, key_rows, axis=2)
    s_nb = jnp.einsum('bhrqd,bhrikd->bhrqik', qg, k_nb).astype(jnp.float32) * ATTN_SCALE
    col = jnp.arange(GRID_W)
    c0 = jnp.clip(col - kw // 2, 0, GRID_W - kw)
    in_win = (col[None, :] >= c0[:, None]) & (col[None, :] < c0[:, None] + kw)
    dr = key_rows - r[:, None]
    dc = jnp.clip(col[None, :] - col[:, None], -(NA_KW - 1), NA_KW - 1)
    bias = rpb_l[:, dr[:, None, :, None] + (NA_KH - 1), dc[None, :, None, :] + (NA_KW - 1)]
    s_nb = s_nb + bias[None].astype(jnp.float32)
    s_nb = jnp.where(in_win[:, None, :], s_nb, -jnp.inf)
    s_nb = s_nb.reshape(B, H, rows, GRID_W, kh * GRID_W)
    s_ctx = jnp.einsum('bhrqd,bhtd->bhrqt', qg, k_ctx).astype(jnp.float32) * ATTN_SCALE
    s = jnp.concatenate([s_nb, s_ctx], axis=-1)
    p = jax.nn.softmax(s, axis=-1).astype(v.dtype)
    p_nb = p[..., :kh * GRID_W].reshape(B, H, rows, GRID_W, kh, GRID_W)
    p_ctx = p[..., kh * GRID_W:]
    o = (jnp.einsum('bhrqik,bhrikd->bhrqd', p_nb, v_nb)
         + jnp.einsum('bhrqt,bhtd->bhrqd', p_ctx, v_ctx))
    return o.reshape(B, H, N, dh)


def fourier_mix(f):
    B, N, _ = f.shape
    f32 = f.astype(jnp.float32).reshape(B, N, F_GROUPS, F_GROUP_DIM)
    y = jnp.fft.fft2(f32, axes=(1, 3), norm='ortho').real
    return y.reshape(B, N, FOURIER_DIM).astype(f.dtype)


def dwconv_seq(u, w, b):
    up = jnp.pad(u, ((0, 0), (1, 1), (0, 0)))
    return up[:, :-2] * w[0] + up[:, 1:-1] * w[1] + up[:, 2:] * w[2] + b


def conv_ffn(h, w_up_l, conv_w_l, conv_b_l, w_down_l):
    u = dwconv_seq(h @ w_up_l, conv_w_l, conv_b_l)
    a, g = jnp.split(u, 2, axis=-1)
    return (jax.nn.silu(g) * a) @ w_down_l


def trunk_layer(x, mods, g1, w_in_l, w_pa_l, w_pb_l, w_out_l, g2, w_up_l, conv_w_l, conv_b_l,
                w_down_l, attend):
    shift1, scale1, gate1, shift2, scale2, gate2 = mods
    B, N, _ = x.shape
    h = rms_norm(x, g1) * (1 + scale1) + shift1
    q, k, v, f, ga, gb = jnp.split(h @ w_in_l, IN_SPLITS, axis=-1)
    q = q.reshape(B, N, N_HEADS, HEAD_DIM).transpose(0, 2, 1, 3)
    k = k.reshape(B, N, N_HEADS, HEAD_DIM).transpose(0, 2, 1, 3)
    v = v.reshape(B, N, N_HEADS, HEAD_DIM).transpose(0, 2, 1, 3)
    a = attend(q, k, v).transpose(0, 2, 1, 3).reshape(B, N, ATTN_DIM)
    fo = fourier_mix(f)
    y = jax.nn.sigmoid(ga) * (a @ w_pa_l) + jax.nn.sigmoid(gb) * (fo @ w_pb_l)
    x = x + gate1 * (y @ w_out_l)
    h = rms_norm(x, g2) * (1 + scale2) + shift2
    x = x + gate2 * conv_ffn(h, w_up_l, conv_w_l, conv_b_l, w_down_l)
    return x, k, v


def setup_inputs(seed: int = 0) -> dict:
    key = jax.random.key(seed)
    ks = jax.random.split(key, 20)
    nrm = jax.random.normal
    f32 = jnp.float32
    return {
        'x_prompt': nrm(ks[0], (BATCH, SEQ, D_MODEL), f32),
        'x_sample': nrm(ks[1], (DEC_BATCH, DEC_SEQ, D_MODEL), f32),
        'cache_k': nrm(ks[2], (DEC_BATCH, DEPTH, N_HEADS, PAST_LEN, HEAD_DIM), f32),
        'cache_v': nrm(ks[3], (DEC_BATCH, DEPTH, N_HEADS, PAST_LEN, HEAD_DIM), f32),
        'c': nrm(ks[4], (DEC_BATCH, D_MODEL), f32),
        'c_ctx': nrm(ks[5], (D_MODEL,), f32),
        'w_mod': nrm(ks[6], (DEPTH, D_MODEL, N_MOD * D_MODEL), f32) * (0.5 * D_MODEL ** -0.5),
        'b_mod': nrm(ks[7], (DEPTH, N_MOD * D_MODEL), f32) * 0.01,
        'norm1_g': 1.0 + 0.05 * nrm(ks[8], (DEPTH, D_MODEL), f32),
        'w_in': nrm(ks[9], (DEPTH, D_MODEL, IN_DIM), f32) * D_MODEL ** -0.5,
        'rpb': nrm(ks[10], (DEPTH, N_HEADS, 2 * NA_KH - 1, 2 * NA_KW - 1), f32) * 0.1,
        'w_pa': nrm(ks[11], (DEPTH, ATTN_DIM, D_MODEL), f32) * ATTN_DIM ** -0.5,
        'w_pb': nrm(ks[12], (DEPTH, FOURIER_DIM, D_MODEL), f32) * FOURIER_DIM ** -0.5,
        'w_out': nrm(ks[13], (DEPTH, D_MODEL, D_MODEL), f32) * D_MODEL ** -0.5,
        'norm2_g': 1.0 + 0.05 * nrm(ks[14], (DEPTH, D_MODEL), f32),
        'w_up': nrm(ks[15], (DEPTH, D_MODEL, 2 * FFN_DIM), f32) * D_MODEL ** -0.5,
        'conv_w': nrm(ks[16], (DEPTH, 3, 2 * FFN_DIM), f32) * 3 ** -0.5,
        'conv_b': nrm(ks[17], (DEPTH, 2 * FFN_DIM), f32) * 0.01,
        'w_down': nrm(ks[18], (DEPTH, FFN_DIM, D_MODEL), f32) * FFN_DIM ** -0.5,
        'norm_f_g': 1.0 + 0.05 * nrm(ks[19], (D_MODEL,), f32),
    }


def reference(x_prompt, x_sample, cache_k, cache_v, c, c_ctx, w_mod, b_mod, norm1_g, w_in, rpb,
              w_pa, w_pb, w_out, norm2_g, w_up, conv_w, conv_b, w_down, norm_f_g):
    xp = x_prompt
    xs = x_sample
    new_k = []
    new_v = []
    for l in range(DEPTH):
        lw = (norm1_g[l], w_in[l], w_pa[l], w_pb[l], w_out[l], norm2_g[l], w_up[l], conv_w[l],
              conv_b[l], w_down[l])
        mods_ctx = adaln_params(c_ctx, w_mod[l], b_mod[l])
        mods_lat = adaln_params(c, w_mod[l], b_mod[l])
        xp, k_l, v_l = trunk_layer(xp, mods_ctx, *lw, attend=context_attention)
        new_k.append(k_l)
        new_v.append(v_l)
        k_ctx = cache_k[:, l]
        v_ctx = cache_v[:, l]
        rpb_l = rpb[l]
        xs, _, _ = trunk_layer(
            xs, mods_lat, *lw,
            attend=lambda q, k, v: neighbourhood_attention(q, k, v, k_ctx, v_ctx, rpb_l))
    y_prompt = rms_norm(xp, norm_f_g)
    y_sample = rms_norm(xs, norm_f_g)
    new_cache_k = jnp.stack(new_k, axis=1)
    new_cache_v = jnp.stack(new_v, axis=1)
    return (y_prompt, y_sample, new_cache_k, new_cache_v)
```

```cpp
#include <hip/hip_runtime.h>
#include <cstdio>
#include <cstdint>

#define GAS __attribute__((address_space(1)))
#define LAS __attribute__((address_space(3)))
typedef unsigned short bf16_t;
typedef short bf16x8 __attribute__((ext_vector_type(8)));
typedef short s16x4 __attribute__((ext_vector_type(4)));
typedef float f32x4 __attribute__((ext_vector_type(4)));
typedef float f32x2 __attribute__((ext_vector_type(2)));
typedef float f32x16 __attribute__((ext_vector_type(16)));
typedef unsigned u32x4 __attribute__((ext_vector_type(4)));
typedef unsigned u32x2 __attribute__((ext_vector_type(2)));

#ifndef EN_MODS
#define EN_MODS 1
#endif
#ifndef EN_WT
#define EN_WT 1
#endif
#ifndef EN_MISC
#define EN_MISC 1
#endif
#ifndef EN_NORM
#define EN_NORM 1
#endif
#ifndef EN_GIN
#define EN_GIN 1
#endif
#ifndef EN_ATT
#define EN_ATT 1
#endif
#ifndef EN_F1
#define EN_F1 1
#endif
#ifndef EN_F2
#define EN_F2 1
#endif
#ifndef EN_PAB
#define EN_PAB 1
#endif
#ifndef EN_OUT
#define EN_OUT 1
#endif
#ifndef EN_UP
#define EN_UP 1
#endif
#ifndef EN_CONV
#define EN_CONV 1
#endif
#ifndef EN_DOWN
#define EN_DOWN 1
#endif
#ifndef EN_FINAL
#define EN_FINAL 1
#endif
#ifndef REP_P0
#define REP_P0 1
#endif
#ifndef REP_ATT
#define REP_ATT 1
#endif
#ifndef REP_THIN
#define REP_THIN 1
#endif
#ifndef REP_GIN
#define REP_GIN 1
#endif
#ifndef REP_BAR
#define REP_BAR 1
#endif
#ifndef REP_OUT
#define REP_OUT 1
#endif
#ifndef REP_DOWN
#define REP_DOWN 1
#endif
#ifndef REP_PAB
#define REP_PAB 1
#endif
#ifndef REP_FOUR
#define REP_FOUR 1
#endif
#ifndef REP_UP
#define REP_UP 1
#endif
constexpr int D = 2048, NB_P = 16, SEQ_P = 256, DEPTH = 4, NB_S = 4, SEQ_S = 4096, PAST = 256;
constexpr int MP = NB_P * SEQ_P;
constexpr int MS = NB_S * SEQ_S;
constexpr int M = MP + MS;
constexpr int NH = 8, HD = 128, AD = 1024, FD = 1024, FFN = 5632, FFN2 = 11264, IN_DIM = 8192, NMOD = 6;
constexpr int GW = 64;
constexpr float RMS_EPS = 1e-6f;
constexpr float QSCALE = 0.08838834764831845f * 1.4426950408889634f;
constexpr float LOG2E = 1.4426950408889634f;

constexpr size_t MiB = 1u << 20;
constexpr size_t WS_CTL = 0, CTL_ZERO_BYTES = 2 * MiB;
constexpr size_t WS_SS = 1 * MiB;
constexpr size_t WS_MODS = 2 * MiB;
constexpr size_t WS_BIAS = 3 * MiB;
constexpr size_t WS_CACHE = 5 * MiB;
constexpr size_t WS_DC = 21 * MiB;
constexpr size_t WS_DP = WS_DC + 256 * 1024;
constexpr size_t WS_DS = WS_DP + 256 * 1024;
constexpr size_t WS_UP2 = 22 * MiB;
constexpr size_t WS_WT = 86 * MiB;
constexpr size_t WT_IN = 0, WT_PA = (size_t)IN_DIM * D * 2, WT_PB = WT_PA + (size_t)D * AD * 2, WT_OUT = WT_PB + (size_t)D * FD * 2,
                 WT_UP = WT_OUT + (size_t)D * D * 2, WT_DOWN = WT_UP + (size_t)FFN2 * D * 2, WT_LAYER = WT_DOWN + (size_t)D * FFN * 2;
static_assert(WT_LAYER == 114 * MiB, "weight copy size");
constexpr size_t WS_H = WS_WT + 4 * WT_LAYER;
constexpr size_t WS_BIG = WS_H + 80 * MiB;
constexpr size_t WS_UH = WS_BIG + 320 * MiB;
constexpr size_t WS_AF = WS_BIG + 440 * MiB;
constexpr size_t WS_GTS = WS_AF + 80 * MiB;
constexpr size_t WS_GTP = WS_GTS + 64 * MiB;
constexpr size_t WS_T1 = WS_GTP + 16 * MiB;
constexpr size_t WS_ACT = WS_AF;
constexpr size_t WS_Y = WS_T1 + 160 * MiB;
constexpr size_t WS_END = WS_Y + 80 * MiB;
static_assert(WS_END <= 1536 * MiB, "workspace map");
static_assert((size_t)M * FFN * 2 <= 320 * MiB, "act overlay");

constexpr int CW_FLAG = 65536;
constexpr int CW_XRANK = 32768;
constexpr int CW_BAR = 4096;

constexpr int LDS_BYTES = 147456;
constexpr int MISC_OFF = LDS_BYTES - 256;
constexpr int NWAVES = 8, NTHREADS = 512;

#define LDS_WAIT() asm volatile("s_waitcnt lgkmcnt(0)" ::: "memory")
#define VM_WAIT() asm volatile("s_waitcnt vmcnt(0)" ::: "memory")
__device__ __forceinline__ unsigned cvt_pk_bf16(float lo, float hi) { unsigned r; asm volatile("v_cvt_pk_bf16_f32 %0, %1, %2" : "=v"(r) : "v"(lo), "v"(hi)); return r; }
__device__ __forceinline__ float bf_lo(unsigned w) { return __uint_as_float(w << 16); }
__device__ __forceinline__ float bf_hi(unsigned w) { return __uint_as_float(w & 0xffff0000u); }
__device__ __forceinline__ float sigmoidf_fast(float x) { return __builtin_amdgcn_rcpf(1.0f + __expf(-x)); }
template <int CTRL> __device__ __forceinline__ float dpp_add(float v) { return v + __int_as_float(__builtin_amdgcn_update_dpp(0, __float_as_int(v), CTRL, 0xf, 0xf, true)); }
__device__ __forceinline__ float wave_sum(float v) {
    v = dpp_add<0xB1>(v);
    v = dpp_add<0x4E>(v);
    v = dpp_add<0x141>(v);
    v = dpp_add<0x140>(v);
    const float s0 = __int_as_float(__builtin_amdgcn_readlane(__float_as_int(v), 0)), s1 = __int_as_float(__builtin_amdgcn_readlane(__float_as_int(v), 16));
    const float s2 = __int_as_float(__builtin_amdgcn_readlane(__float_as_int(v), 32)), s3 = __int_as_float(__builtin_amdgcn_readlane(__float_as_int(v), 48));
    return (s0 + s1) + (s2 + s3);
}
__device__ __forceinline__ int fresh_wave(int w) { asm volatile("; opaque wave index" : "+s"(w)); return w; }
__device__ __forceinline__ int fresh_lane() { int l; asm volatile("v_mbcnt_lo_u32_b32 %0, -1, 0\n\tv_mbcnt_hi_u32_b32 %0, -1, %0" : "=v"(l)); return l; }

#define XB_TMO      128
#define XB_XCNT(j)  (256  + 64 * (j))
#define XB_XSUB(j)  (1280 + 64 * (j))
#define XB_XGEN(j)  (2304 + 64 * (j))
#define XB_TOP      3328
#define XB_TOPGEN   3392
#define XCD_BAR_WORDS 3456
#define XB_SPIN_CAP (1u << 18)
__device__ __forceinline__ unsigned xb_ld(unsigned* p)              { return __hip_atomic_load((GAS unsigned*)p, __ATOMIC_RELAXED, __HIP_MEMORY_SCOPE_AGENT); }
__device__ __forceinline__ unsigned xb_add(unsigned* p, unsigned v) { return __hip_atomic_fetch_add((GAS unsigned*)p, v, __ATOMIC_RELAXED, __HIP_MEMORY_SCOPE_AGENT); }
__device__ __forceinline__ unsigned xb_xcc_id() { return (unsigned)__builtin_amdgcn_s_getreg((3 << 11) | 20) & 0xFu; }
#define XB_SPIN(cond, bar) do { unsigned _sp = 0; while (cond) { __builtin_amdgcn_s_sleep(1); \
    if ((++_sp & 255u) == 0u) { if (xb_ld(&(bar)[XB_TMO])) break; if (_sp > XB_SPIN_CAP) { xb_add(&(bar)[XB_TMO], 1u); break; } } } } while (0)
struct XcdBarrier { unsigned* bar; unsigned x; volatile LAS unsigned* st; };
__device__ __forceinline__ XcdBarrier xcd_barrier_post(unsigned* bar, volatile LAS unsigned* st) {
    XcdBarrier b; b.bar = bar; b.x = xb_xcc_id(); b.st = st;
    if (threadIdx.x == 0) (void)xb_add(&bar[XB_XCNT(b.x)], 1u);
    return b;
}
__device__ __forceinline__ void xcd_barrier_complete(unsigned* bar, unsigned x, unsigned& nloc, unsigned& nx) {
    const unsigned G = gridDim.x * gridDim.y * gridDim.z;
    unsigned sum, cnt, mine, sp = 0u;
    for (;;) {
        sum = 0u; cnt = 0u; mine = 0u;
#pragma unroll
        for (unsigned j = 0; j < 16; ++j) { const unsigned c = xb_ld(&bar[XB_XCNT(j)]); sum += c; cnt += (c > 0u) ? 1u : 0u; mine = (j == x) ? c : mine; }
        if (sum == G) break;
        __builtin_amdgcn_s_sleep(1);
        if ((++sp & 255u) == 0u) { if (xb_ld(&bar[XB_TMO])) break; if (sp > XB_SPIN_CAP) { xb_add(&bar[XB_TMO], 1u); break; } }
    }
    nloc = mine > 0u ? mine : 1u; nx = cnt > 0u ? cnt : 1u;
}
__device__ __forceinline__ void xcd_barrier(const XcdBarrier& b, const bool leader_thread) {
    asm volatile("s_waitcnt vmcnt(0)" ::: "memory");
    __syncthreads();
    if (leader_thread) {
        unsigned* bar = b.bar;
        __builtin_amdgcn_s_waitcnt(0);
        unsigned nloc = b.st[0], nx = b.st[1];
        if (nloc == 0u) { xcd_barrier_complete(bar, b.x, nloc, nx); b.st[0] = nloc; b.st[1] = nx; }
        const unsigned old = xb_add(&bar[XB_XSUB(b.x)], 1u);
        const unsigned gen = old / nloc;
        if (old + 1u == (gen + 1u) * nloc) {
            __builtin_amdgcn_fence(__ATOMIC_RELEASE, "agent");
            asm volatile("s_waitcnt vmcnt(0)" ::: "memory");
            const unsigned og = xb_add(&bar[XB_TOP], 1u);
            const unsigned tg = og / nx;
            if (og + 1u == (tg + 1u) * nx) xb_add(&bar[XB_TOPGEN], 1u);
            else XB_SPIN(xb_ld(&bar[XB_TOPGEN]) == tg, bar);
            __builtin_amdgcn_fence(__ATOMIC_ACQUIRE, "agent");
            xb_add(&bar[XB_XGEN(b.x)], 1u);
            asm volatile("s_waitcnt vmcnt(0)" ::: "memory");
        } else {
            XB_SPIN(xb_ld(&bar[XB_XGEN(b.x)]) == gen, bar);
            __builtin_amdgcn_fence(__ATOMIC_ACQUIRE, "agent");
            asm volatile("s_waitcnt vmcnt(0)" ::: "memory");
        }
    }
    __syncthreads();
}

namespace pg8 {
constexpr int BM = 256, BK = 64, HALF = 128, HTB = HALF * BK * 2, STAGE_BYTES = 8 * HTB, NXCD = 8, WGM = 8;
__host__ __device__ __forceinline__ int lds_byte(int r, int c) { const int st = (r >> 4) * 2 + (c >> 5), rr = r & 15, cc = c & 31, ob = rr * 64 + cc * 2; return st * 1024 + (ob ^ (((ob >> 9) & 1) << 5)); }
__host__ __device__ __forceinline__ void stage_rc(int b, int& R, int& C) { const int st = b / 1024, sb = b % 1024, swz = sb ^ (((sb >> 9) & 1) << 5); R = (st >> 1) * 16 + swz / 64; C = (st & 1) * 32 + (swz % 64) / 2; }
__host__ __device__ __forceinline__ int perm32(int rho) { const int n = rho >> 4, i = rho & 15; return 8 * (i >> 2) + 4 * n + (i & 3); }

struct Unit { const char* a; const char* b; char* c; int pm, pn, hm; };

struct TileOrder {
    static constexpr int BH_ROWS = 128; static constexpr bool KSPLIT = true;
    int nM, nN, nwg, G, c; const char* A; const char* B; char* C; size_t astep, bstep, cstep; int ldc, cesz; int tail, ktp; size_t khalf; unsigned* flags;
    __device__ __forceinline__ void init(int M_, int N_, int G_, int c_, const void* A_, int lda, const void* B_, int ldb, void* C_, int ldc_, int cesz_) {
        nM = M_ / BM; nN = N_ / BM; nwg = nM * nN; G = G_; c = c_; A = (const char*)A_; B = (const char*)B_; C = (char*)C_;
        astep = (size_t)BM * lda * 2; bstep = (size_t)BM * ldb * 2; ldc = ldc_; cesz = cesz_; cstep = (size_t)BM * ldc_ * cesz_; tail = 0; ktp = 0; khalf = 0; flags = nullptr;
    }
    __device__ __forceinline__ void half_tail() { if (G == 256 && nwg == 640) tail = 1; }
    __device__ __forceinline__ void split_tail(int ktp_, unsigned* flags_) { if (G == 256 && nwg == 640) { tail = 2; ktp = ktp_; khalf = (size_t)ktp_ * (BK * 2); flags = flags_; } }
    __device__ __forceinline__ bool next(int i, Unit& u) const {
        int wgid; u.hm = 0;
        if (tail && i >= 2) { if (i > 2) return false;
            const int xcd = c % NXCD, k = c / NXCD, j = k >> 1; wgid = xcd * (nwg / NXCD) + 64 + j;
            u.hm = (tail == 1) ? 1 + (k & 1) : ((3 + (k & 1)) | ((xcd * 16 + j) << 4)); }
        else { const long L = (long)i * G + c; if (L >= nwg) return false;
            wgid = (int)L; { const int q = nwg / NXCD, r = nwg % NXCD, xcd = wgid % NXCD, off = wgid / NXCD; wgid = (xcd < r ? xcd * (q + 1) : r * (q + 1) + (xcd - r) * q) + off; } }
        const int nig = WGM * nN, gid = wgid / nig, fm = gid * WGM, gsz = (nM - fm) < WGM ? (nM - fm) : WGM;
        u.pm = fm + ((wgid % nig) % gsz); u.pn = (wgid % nig) / gsz;
        const size_t ko = ((u.hm & 15) == 4) ? khalf : 0;
        u.a = A + (size_t)u.pm * astep + ((u.hm & 15) == 2 ? astep / 2 : 0) + ko; u.b = B + (size_t)u.pn * bstep + ko; u.c = C + (size_t)u.pm * cstep + (size_t)u.pn * BM * cesz;
        return true;
    }
};

template <class Epi, class Sched, bool ALIGN_EPI = true>
__device__ __forceinline__ void gemm_phase(LAS unsigned char* lds, const int wave0, const int lda, const int ldb, const int K, const Sched& S, const Epi& E) {
    const int lane = fresh_lane(), wid = fresh_wave(wave0), tid = wid * 64 + lane, wr = wid >> 2, wc = wid & 3, fr = lane & 15, fq = lane >> 4;
    const int nt = K / BK;
    unsigned voffA[2], voffB[2];
#pragma unroll
    for (int i = 0; i < 2; ++i) { int R, C; stage_rc(tid * 16 + i * 8192, R, C); const int Rb = Epi::PERM ? ((R & ~31) + perm32(R & 31)) : R;
        const int Ra = Epi::APERM ? (8 * (16 * (R >> 6) + (R & 15)) + ((R >> 4) & 3)) : R;
        voffA[i] = (unsigned)(Ra * lda + C) * 2u; voffB[i] = (unsigned)(Rb * ldb + C) * 2u; }
    const size_t kstep = (size_t)(BK * 2);
    const size_t hstepA = (size_t)(Epi::APERM ? 4 : HALF) * lda * 2, hstepB = (size_t)Sched::BH_ROWS * ldb * 2;
    const unsigned ldsw = (unsigned)wid * 1024u;
    const int aoff = lds_byte(wr * 64 + fr, fq * 8), boff = lds_byte(wc * 32 + fr, fq * 8);
#define PG8_SA(b, h) (((b) * 2 + (h)) * HTB)
#define PG8_SB(b, h) ((4 + (b) * 2 + (h)) * HTB)
#ifndef PG8_AUX_A
#define PG8_AUX_A 0
#endif
#ifndef PG8_AUX_B
#define PG8_AUX_B 0
#endif
#define PG8_STAGE(bufoff, gbase, voff) do { const GAS char* gb_ = (const GAS char*)(gbase); asm("" : "+s"(gb_));   _Pragma("unroll") for (int _i = 0; _i < 2; ++_i) { asm("" : "+v"((voff)[_i]));   \
        __builtin_amdgcn_global_load_lds((const GAS unsigned*)(gb_ + (voff)[_i]), (LAS unsigned*)(lds + (bufoff) + ldsw + _i * 8192), 16, 0, PG8_AUX_A); } } while (0)
#define PG8_STAGEB(bufoff, gbase, voff) do { const GAS char* gb_ = (const GAS char*)(gbase); asm("" : "+s"(gb_));   _Pragma("unroll") for (int _i = 0; _i < 2; ++_i) { asm("" : "+v"((voff)[_i]));   \
        __builtin_amdgcn_global_load_lds((const GAS unsigned*)(gb_ + (voff)[_i]), (LAS unsigned*)(lds + (bufoff) + ldsw + _i * 8192), 16, 0, PG8_AUX_B); } } while (0)
#define PG8_LDA(dst, b, h) do { _Pragma("unroll") for (int m = 0; m < 4; ++m) _Pragma("unroll") for (int k = 0; k < 2; ++k) dst[m][k] = *(const LAS bf16x8*)(lds + PG8_SA(b, h) + aoff + m * 2048 + k * 1024); } while (0)
#define PG8_LDB(dst, b, h) do { _Pragma("unroll") for (int n = 0; n < 2; ++n) _Pragma("unroll") for (int k = 0; k < 2; ++k) dst[n][k] = *(const LAS bf16x8*)(lds + PG8_SB(b, h) + boff + n * 2048 + k * 1024); } while (0)
#define PG8_MMA(ai, bj, At, Bt) do { __builtin_amdgcn_s_setprio(1); _Pragma("unroll") for (int m = 0; m < 4; ++m) _Pragma("unroll") for (int n = 0; n < 2; ++n) _Pragma("unroll") for (int k = 0; k < 2; ++k) \
        acc[ai][bj][m][n] = __builtin_amdgcn_mfma_f32_16x16x32_bf16(Bt[n][k], At[m][k], acc[ai][bj][m][n], 0, 0, 0); __builtin_amdgcn_s_setprio(0); } while (0)
#define PG8_WAIT_V(n) asm volatile("s_waitcnt vmcnt(" #n ")" ::: "memory")
#define PG8_WAIT_L(n) asm volatile("s_waitcnt lgkmcnt(" #n ")" ::: "memory")
#define PG8_BAR __builtin_amdgcn_s_barrier()
#define PG8_SCHED __builtin_amdgcn_sched_barrier(0)
    Unit cur, nxt; int ui = 0;
    if (!S.next(0, cur)) return;
    f32x4 acc[2][2][4][2];
#pragma unroll
    for (int a = 0; a < 2; ++a)
#pragma unroll
        for (int b = 0; b < 2; ++b)
#pragma unroll
            for (int m = 0; m < 4; ++m)
#pragma unroll
                for (int n = 0; n < 2; ++n) acc[a][b][m][n] = (f32x4){0.f, 0.f, 0.f, 0.f};
    bf16x8 At[4][2], B0[2][2], B1[2][2];
    const char* cA = cur.a; const char* cB = cur.b;
    PG8_STAGEB(PG8_SB(0, 0), cB, voffB); PG8_STAGEB(PG8_SB(0, 1), cB + hstepB, voffB); PG8_STAGE(PG8_SA(0, 0), cA, voffA); PG8_STAGE(PG8_SA(0, 1), cA + hstepA, voffA);
    if (wr == 1) PG8_BAR;
    PG8_WAIT_V(2); PG8_BAR;
    PG8_STAGEB(PG8_SB(1, 0), cB + kstep, voffB); PG8_STAGE(PG8_SA(1, 0), cA + kstep, voffA); PG8_STAGEB(PG8_SB(1, 1), cB + hstepB + kstep, voffB);
    PG8_WAIT_V(6); PG8_BAR;
    for (;;) {
        const bool has_next = S.next(ui + 1, nxt);
        const char* nA = has_next ? nxt.a : cA; const char* nB = has_next ? nxt.b : cB;
        const int hmode = cur.hm & 15;
        const bool full = (hmode == 0) || (hmode >= 3);
        int unt = nt; if constexpr (Sched::KSPLIT) { if (hmode == 3) unt = S.ktp; else if (hmode == 4) unt = nt - S.ktp; }
        float pf = 0.f;
        for (int t = 0; t < unt; t += 2) {
            const bool last = (t == unt - 2);
            const char* a1 = cA + (size_t)(t + 1) * kstep;
            const char* a2 = last ? nA : cA + (size_t)(t + 2) * kstep; const char* b2 = last ? nB : cB + (size_t)(t + 2) * kstep;
            const char* a3 = a2 + kstep; const char* b3 = b2 + kstep;
            if constexpr (Epi::MIDK > 0) { if (t == Epi::MIDK) E.mid(acc, cur, wid); }
            if constexpr (Epi::PREF) { if (last) pf = E.prefetch(cur, tid); }
            PG8_LDB(B0, 0, 0); PG8_LDB(B1, 0, 1); PG8_SCHED; PG8_LDA(At, 0, 0); PG8_STAGE(PG8_SA(1, 1), a1 + hstepA, voffA);
            PG8_WAIT_V(8); PG8_WAIT_L(0); PG8_BAR; PG8_MMA(0, 0, At, B0); PG8_MMA(0, 1, At, B1); PG8_BAR; PG8_SCHED;
            if (full) PG8_LDA(At, 0, 1); PG8_STAGEB(PG8_SB(0, 0), b2, voffB); PG8_STAGEB(PG8_SB(0, 1), b2 + hstepB, voffB); PG8_STAGE(PG8_SA(0, 0), a2, voffA);
            PG8_WAIT_V(8); PG8_WAIT_L(0); PG8_BAR; if (full) { PG8_MMA(1, 0, At, B0); PG8_MMA(1, 1, At, B1); } PG8_BAR; PG8_SCHED;
            PG8_LDB(B0, 1, 0); PG8_LDB(B1, 1, 1); PG8_SCHED; PG8_LDA(At, 1, 0); PG8_STAGE(PG8_SA(0, 1), a2 + hstepA, voffA);
            PG8_WAIT_V(8); PG8_WAIT_L(0); PG8_BAR; PG8_MMA(0, 0, At, B0); PG8_MMA(0, 1, At, B1); PG8_BAR; PG8_SCHED;
            if (full) PG8_LDA(At, 1, 1); PG8_STAGEB(PG8_SB(1, 0), b3, voffB); PG8_STAGEB(PG8_SB(1, 1), b3 + hstepB, voffB); PG8_STAGE(PG8_SA(1, 0), a3, voffA);
            PG8_WAIT_V(8); PG8_WAIT_L(0); PG8_BAR; if (full) { PG8_MMA(1, 0, At, B0); PG8_MMA(1, 1, At, B1); } PG8_BAR; PG8_SCHED;
        }
        if constexpr (ALIGN_EPI) { if (wr == 0) PG8_BAR; }
        if constexpr (Epi::PREF) { static_assert(ALIGN_EPI, "the side-buffer exchange needs both halves in the epilogue together");
            *(LAS float*)(lds + STAGE_BYTES + tid * 4) = pf; PG8_WAIT_L(0); PG8_BAR; }
        if constexpr (Sched::KSPLIT) {
            if (hmode == 3) {
                E.produce(acc, cur, wid);
                PG8_WAIT_V(0); PG8_BAR;
                if (wid == 0 && fresh_lane() == 0) __hip_atomic_store((GAS unsigned*)(S.flags + (size_t)(cur.hm >> 4) * 16), 1u, __ATOMIC_RELAXED, __HIP_MEMORY_SCOPE_AGENT);
            } else {
                if (hmode == 4) {
                    if (wid == 0) { GAS unsigned* fp = (GAS unsigned*)(S.flags + (size_t)(cur.hm >> 4) * 16); unsigned sp = 0;
                        while ((unsigned)__builtin_amdgcn_readfirstlane(__hip_atomic_load(fp, __ATOMIC_RELAXED, __HIP_MEMORY_SCOPE_AGENT)) != 1u) { __builtin_amdgcn_s_sleep(2); if (++sp > (1u << 20)) break; }
                        __builtin_amdgcn_fence(__ATOMIC_ACQUIRE, "agent"); PG8_WAIT_V(0); }
                    PG8_BAR;
                }
                E(acc, cur, wid);
            }
        } else E(acc, cur, wid);
        if (!has_next) break;
#pragma unroll
        for (int a = 0; a < 2; ++a)
#pragma unroll
            for (int b = 0; b < 2; ++b)
#pragma unroll
                for (int m = 0; m < 4; ++m)
#pragma unroll
                    for (int n = 0; n < 2; ++n) acc[a][b][m][n] = (f32x4){0.f, 0.f, 0.f, 0.f};
        cur = nxt; cA = nA; cB = nB; ++ui;
        if constexpr (ALIGN_EPI) { if (wr == 1) PG8_BAR; }
    }
    PG8_WAIT_V(0);
    if constexpr (!ALIGN_EPI) { if (wr == 0) PG8_BAR; }
    PG8_BAR;
#undef PG8_SA
#undef PG8_SB
#undef PG8_STAGE
#undef PG8_STAGEB
#undef PG8_LDA
#undef PG8_LDB
#undef PG8_MMA
#undef PG8_WAIT_V
#undef PG8_WAIT_L
#undef PG8_BAR
#undef PG8_SCHED
}

typedef f32x4 Acc[2][2][4][2];

template <int LDC> struct EpiBf16U {
    static constexpr bool PERM = true, APERM = false; static constexpr int MIDK = 0; static constexpr bool PREF = false;
    __device__ __forceinline__ void operator()(const Acc& acc, const Unit& u, const int wid) const {
        const int lane = fresh_lane(), wr = wid >> 2, wc = wid & 3, fr = lane & 15, fq = lane >> 4;
        const unsigned loff = (unsigned)((wr * 64 + fr) * LDC + wc * 32 + 8 * fq) * 2u;
#pragma unroll
        for (int ai = 0; ai < 2; ++ai)
#pragma unroll
            for (int m = 0; m < 4; ++m) { char* rowp = u.c + (size_t)(ai * HALF + m * 16) * LDC * 2; asm("" : "+s"(rowp));
#pragma unroll
                for (int bj = 0; bj < 2; ++bj) { const f32x4 v0 = acc[ai][bj][m][0], v1 = acc[ai][bj][m][1];
                    u32x4 w; w.x = cvt_pk_bf16(v0[0], v0[1]); w.y = cvt_pk_bf16(v0[2], v0[3]); w.z = cvt_pk_bf16(v1[0], v1[1]); w.w = cvt_pk_bf16(v1[2], v1[3]);
                    *(GAS u32x4*)(rowp + loff + bj * HALF * 2) = w; } }
    }
};
struct EpiIn {
    static constexpr bool PERM = true, APERM = false; static constexpr int MIDK = 0; static constexpr bool PREF = true;
    float* outk; float* outv; int layer; const float* ss; const float* bias; const LAS float* side;
    __device__ __forceinline__ void produce(const Acc&, const Unit&, const int) const {}
    __device__ __forceinline__ float prefetch(const Unit& u, const int tid) const {
        const int bv = u.pm < NB_P ? 0 : 1 + ((u.pm - NB_P) >> 4);
        const float* p = tid < 256 ? ss + (size_t)u.pm * BM + tid : bias + (size_t)bv * IN_DIM + u.pn * BM + (tid - 256);
        return *(const GAS float*)p;
    }
    __device__ __forceinline__ void operator()(const Acc& acc, const Unit& u, const int wid) const {
        const int lane = fresh_lane(), wr = wid >> 2, wc = wid & 3, fr = lane & 15, fq = lane >> 4;
        const bool sig = u.pn >= 16, kv = (u.pm < NB_P) && (u.pn >= 4) && (u.pn < 12);
        const int r0 = wr * 64 + fr, c0 = wc * 32 + 8 * fq;
        const unsigned loff = (unsigned)(r0 * IN_DIM + c0) * 2u, koff = (unsigned)(r0 * HD + c0) * 4u;
        float rstd[2][4]; f32x4 bb[2][2];
        {
#pragma unroll
          for (int ai = 0; ai < 2; ++ai)
#pragma unroll
              for (int m = 0; m < 4; ++m) rstd[ai][m] = side[r0 + ai * HALF + m * 16];
#pragma unroll
          for (int bj = 0; bj < 2; ++bj)
#pragma unroll
              for (int n = 0; n < 2; ++n) bb[bj][n] = *(const LAS f32x4*)(side + 256 + c0 + bj * HALF + 4 * n);
#pragma unroll
          for (int ai = 0; ai < 2; ++ai)
#pragma unroll
              for (int m = 0; m < 4; ++m) rstd[ai][m] = rsqrtf(rstd[ai][m] * (1.0f / D) + RMS_EPS); }
#pragma unroll
        for (int ai = 0; ai < 2; ++ai)
#pragma unroll
            for (int m = 0; m < 4; ++m) { char* rowp = u.c + (size_t)(ai * HALF + m * 16) * IN_DIM * 2; asm("" : "+s"(rowp));
#pragma unroll
                for (int bj = 0; bj < 2; ++bj) { f32x4 v0 = acc[ai][bj][m][0] * rstd[ai][m] + bb[bj][0], v1 = acc[ai][bj][m][1] * rstd[ai][m] + bb[bj][1];
                    if (sig) {
#pragma unroll
                        for (int j = 0; j < 4; ++j) { v0[j] = sigmoidf_fast(v0[j]); v1[j] = sigmoidf_fast(v1[j]); } }
                    u32x4 w; w.x = cvt_pk_bf16(v0[0], v0[1]); w.y = cvt_pk_bf16(v0[2], v0[3]); w.z = cvt_pk_bf16(v1[0], v1[1]); w.w = cvt_pk_bf16(v1[2], v1[3]);
                    *(GAS u32x4*)(rowp + loff + bj * HALF * 2) = w;
                    if (kv) { const int colt = u.pn * BM + bj * HALF; const bool isv = colt >= 2048; const int head = (colt - (isv ? 2048 : 1024)) >> 7;
                        char* dst = (char*)((isv ? outv : outk) + ((((size_t)u.pm * DEPTH + layer) * NH + head) * SEQ_P + (ai * HALF + m * 16)) * HD); asm("" : "+s"(dst));
                        *(GAS f32x4*)(dst + koff) = v0; *(GAS f32x4*)(dst + koff + 16) = v1; } } }
    }
};
struct EpiPab {
    static constexpr bool PERM = true, APERM = false; static constexpr int MIDK = 16; static constexpr bool PREF = false;
    const bf16_t* G; bf16_t* Y;
    __device__ __forceinline__ void produce(const Acc&, const Unit&, const int) const {}
    __device__ __forceinline__ void mid(Acc& acc, const Unit& u, const int wid) const {
        const int lane = fresh_lane(), wr = wid >> 2, wc = wid & 3, fr = lane & 15, fq = lane >> 4;
        const unsigned goff = (unsigned)((wr * 64 + fr) * IN_DIM + wc * 32 + 8 * fq) * 2u;
        const int hb = (u.hm & 15) == 2 ? HALF : 0, na = ((u.hm & 15) == 1 || (u.hm & 15) == 2) ? 1 : 2;
#pragma unroll
        for (int ai = 0; ai < 2; ++ai) if (ai < na) {
#pragma unroll
            for (int mp = 0; mp < 2; ++mp) {
                u32x4 ga[2][2], gb[2][2];
#pragma unroll
                for (int mm = 0; mm < 2; ++mm) { const int m = 2 * mp + mm; const char* gp = (const char*)(G + (size_t)(u.pm * BM + hb + ai * HALF + m * 16) * IN_DIM + 4096 + u.pn * BM); asm("" : "+s"(gp));
#pragma unroll
                    for (int bj = 0; bj < 2; ++bj) { ga[mm][bj] = *(const GAS u32x4*)(gp + goff + bj * HALF * 2); gb[mm][bj] = *(const GAS u32x4*)(gp + goff + bj * HALF * 2 + 2048 * 2); } }
                asm volatile("" ::: "memory");
#pragma unroll
                for (int mm = 0; mm < 2; ++mm)
#pragma unroll
                    for (int bj = 0; bj < 2; ++bj)
#pragma unroll
                        for (int j = 0; j < 4; ++j) { const int m = 2 * mp + mm;
                            const float r0 = bf_lo(ga[mm][bj][j]) * __builtin_amdgcn_rcpf(fmaxf(bf_lo(gb[mm][bj][j]), 1e-30f)), r1 = bf_hi(ga[mm][bj][j]) * __builtin_amdgcn_rcpf(fmaxf(bf_hi(gb[mm][bj][j]), 1e-30f));
                            acc[ai][bj][m][j >> 1][2 * (j & 1)] *= r0; acc[ai][bj][m][j >> 1][2 * (j & 1) + 1] *= r1; }
            }
        }
    }
    __device__ __forceinline__ void operator()(const Acc& acc, const Unit& u, const int wid) const {
        const int lane = fresh_lane(), wr = wid >> 2, wc = wid & 3, fr = lane & 15, fq = lane >> 4;
        const unsigned goff = (unsigned)((wr * 64 + fr) * IN_DIM + wc * 32 + 8 * fq) * 2u, yoff = (unsigned)((wr * 64 + fr) * D + wc * 32 + 8 * fq) * 2u;
        const int hb = (u.hm & 15) == 2 ? HALF : 0, na = ((u.hm & 15) == 1 || (u.hm & 15) == 2) ? 1 : 2;
        u32x4 gb[2][4][2];
#pragma unroll
        for (int ai = 0; ai < 2; ++ai) if (ai < na)
#pragma unroll
            for (int m = 0; m < 4; ++m) { const char* gp = (const char*)(G + (size_t)(u.pm * BM + hb + ai * HALF + m * 16) * IN_DIM + 6144 + u.pn * BM); asm("" : "+s"(gp));
#pragma unroll
                for (int bj = 0; bj < 2; ++bj) gb[ai][m][bj] = *(const GAS u32x4*)(gp + goff + bj * HALF * 2); }
        asm volatile("" ::: "memory");
#pragma unroll
        for (int ai = 0; ai < 2; ++ai) if (ai < na)
#pragma unroll
            for (int m = 0; m < 4; ++m) { char* yp = (char*)(Y + (size_t)(u.pm * BM + hb + ai * HALF + m * 16) * D + u.pn * BM); asm("" : "+s"(yp));
#pragma unroll
                for (int bj = 0; bj < 2; ++bj) { const u32x4 g = gb[ai][m][bj]; const f32x4 v0 = acc[ai][bj][m][0], v1 = acc[ai][bj][m][1];
                    u32x4 w;
                    w.x = cvt_pk_bf16(v0[0] * fmaxf(bf_lo(g[0]), 1e-30f), v0[1] * fmaxf(bf_hi(g[0]), 1e-30f)); w.y = cvt_pk_bf16(v0[2] * fmaxf(bf_lo(g[1]), 1e-30f), v0[3] * fmaxf(bf_hi(g[1]), 1e-30f));
                    w.z = cvt_pk_bf16(v1[0] * fmaxf(bf_lo(g[2]), 1e-30f), v1[1] * fmaxf(bf_hi(g[2]), 1e-30f)); w.w = cvt_pk_bf16(v1[2] * fmaxf(bf_lo(g[3]), 1e-30f), v1[3] * fmaxf(bf_hi(g[3]), 1e-30f));
                    *(GAS u32x4*)(yp + yoff + bj * HALF * 2) = w; } }
    }
};
struct EpiRes {
    static constexpr bool PERM = false, APERM = false; static constexpr int MIDK = 0; static constexpr bool PREF = true;
    const float* xp; const float* xs; float* X; const float* mods_l; int gi; bool first; float* XO;
    bool emit; const float* gvec; const float* scl; float* ss; bf16_t* HBo;
    const LAS float* side;
    __device__ __forceinline__ float prefetch(const Unit& u, const int tid) const {
        const int bv = u.pm < NB_P ? 0 : 1 + ((u.pm - NB_P) >> 4);
        if (tid >= 256) return *(const GAS float*)(mods_l + ((size_t)bv * NMOD + gi) * D + u.pn * BM + (tid - 256));
        if (!emit) return 0.f;
        return *(const GAS float*)(gvec + u.pn * BM + tid) * (*(const GAS float*)(scl + (size_t)bv * NMOD * D + u.pn * BM + tid) + 1.0f);
    }
    __device__ __forceinline__ void produce(const Acc& acc, const Unit& u, const int wid) const {
        const int lane = fresh_lane(), wr = wid >> 2, wc = wid & 3, fr = lane & 15, fq = lane >> 4;
        const int r0 = wr * 64 + fr, c0 = wc * 32 + 4 * fq;
        const unsigned xoff = (unsigned)(r0 * D + c0) * 4u;
        const float* base = first ? (u.pm < NB_P ? xp : xs - (size_t)MP * D) : X;
        char* xt = (char*)(X + (size_t)u.pm * BM * D + u.pn * BM); asm("" : "+s"(xt));
        const __amdgpu_buffer_rsrc_t rs = __builtin_amdgcn_make_buffer_rsrc(xt, 0, 256 * D * 4, 0x00020000);
#pragma unroll
        for (int ai = 0; ai < 2; ++ai) {
            f32x4 b[4][2][2];
#pragma unroll
            for (int m = 0; m < 4; ++m) { const char* bp = (const char*)(base + (size_t)(u.pm * BM + ai * HALF + m * 16) * D + u.pn * BM); asm("" : "+s"(bp));
#pragma unroll
                for (int bj = 0; bj < 2; ++bj)
#pragma unroll
                    for (int n = 0; n < 2; ++n) b[m][bj][n] = *(const GAS f32x4*)(bp + xoff + (bj * HALF + n * 16) * 4); }
            asm volatile("" ::: "memory");
#pragma unroll
            for (int bj = 0; bj < 2; ++bj)
#pragma unroll
                for (int n = 0; n < 2; ++n) { const f32x4 gvx = *(const LAS f32x4*)(side + 256 + c0 + bj * HALF + n * 16);
#pragma unroll
                    for (int m = 0; m < 4; ++m) __builtin_amdgcn_raw_buffer_store_b128(__builtin_bit_cast(u32x4, b[m][bj][n] + gvx * acc[ai][bj][m][n]), rs, xoff, ((ai * HALF + m * 16) * D + bj * HALF + n * 16) * 4, 16); }
            asm volatile("" ::: "memory");
        }
    }
    __device__ __forceinline__ void operator()(const Acc& acc, const Unit& u, const int wid) const {
        const int lane = fresh_lane(), wr = wid >> 2, wc = wid & 3, fr = lane & 15, fq = lane >> 4;
        const int r0 = wr * 64 + fr, c0 = wc * 32 + 4 * fq;
        const unsigned xoff = (unsigned)(r0 * D + c0) * 4u, hoff = (unsigned)(r0 * D + c0) * 2u;
        const int hmode = u.hm & 15;
        const float* base = (first && hmode != 4) ? (u.pm < NB_P ? xp : xs - (size_t)MP * D) : X;
        float* XOu = XO; const bool em = emit;
        const int hb = hmode == 2 ? HALF : 0, na = (hmode == 1 || hmode == 2) ? 1 : 2;
#pragma unroll
        for (int ai = 0; ai < 2; ++ai) if (ai < na) {
            f32x4 b[4][2][2];
#pragma unroll
            for (int m = 0; m < 4; ++m) { const char* bp = (const char*)(base + (size_t)(u.pm * BM + hb + ai * HALF + m * 16) * D + u.pn * BM); asm("" : "+s"(bp));
#pragma unroll
                for (int bj = 0; bj < 2; ++bj)
#pragma unroll
                    for (int n = 0; n < 2; ++n) b[m][bj][n] = *(const GAS f32x4*)(bp + xoff + (bj * HALF + n * 16) * 4); }
            asm volatile("" ::: "memory");
#pragma unroll
            for (int bj = 0; bj < 2; ++bj)
#pragma unroll
                for (int n = 0; n < 2; ++n) { const f32x4 gvx = *(const LAS f32x4*)(side + 256 + c0 + bj * HALF + n * 16);
#pragma unroll
                    for (int m = 0; m < 4; ++m) { char* xq = (char*)(XOu + (size_t)(u.pm * BM + hb + ai * HALF + m * 16) * D + u.pn * BM); asm("" : "+s"(xq));
                        b[m][bj][n] = b[m][bj][n] + gvx * acc[ai][bj][m][n];
                        *(GAS f32x4*)(xq + xoff + (bj * HALF + n * 16) * 4) = b[m][bj][n]; } }
            if (em) {
#pragma unroll
                for (int m = 0; m < 4; ++m) { char* hq = (char*)(HBo + (size_t)(u.pm * BM + hb + ai * HALF + m * 16) * D + u.pn * BM); asm("" : "+s"(hq));
                    float q = 0.f;
#pragma unroll
                    for (int bj = 0; bj < 2; ++bj)
#pragma unroll
                        for (int n = 0; n < 2; ++n) { const f32x4 x = b[m][bj][n], h = x * *(const LAS f32x4*)(side + c0 + bj * HALF + n * 16); q += (x[0] * x[0] + x[1] * x[1]) + (x[2] * x[2] + x[3] * x[3]);
                            u32x2 w; w.x = cvt_pk_bf16(h[0], h[1]); w.y = cvt_pk_bf16(h[2], h[3]); *(GAS u32x2*)(hq + hoff + (bj * HALF + n * 16) * 2) = w; }
                    q += __int_as_float(__builtin_amdgcn_ds_bpermute((lane ^ 16) << 2, __float_as_int(q)));
                    q += __int_as_float(__builtin_amdgcn_ds_bpermute((lane ^ 32) << 2, __float_as_int(q)));
                    if (fq == 0) __hip_atomic_fetch_add((GAS float*)(ss + (size_t)(u.pm * BM + hb + ai * HALF + m * 16) + r0), q, __ATOMIC_RELAXED, __HIP_MEMORY_SCOPE_AGENT); }
            }
            asm volatile("" ::: "memory");
        }
    }
};
struct UpOrder {
    static constexpr int BH_ROWS = FFN; static constexpr bool KSPLIT = false;
    int nM, nN, nwg, G, c; const char* A; const char* B; char* C;
    __device__ __forceinline__ void init(int G_, int c_, const void* A_, const void* B_, void* C_) { nM = M / BM; nN = FFN / 128; nwg = nM * nN; G = G_; c = c_; A = (const char*)A_; B = (const char*)B_; C = (char*)C_; }
    __device__ __forceinline__ bool next(int i, Unit& u) const {
        const long L = (long)i * G + c; if (L >= nwg) return false;
        int wgid = (int)L; { const int q = nwg / NXCD, r = nwg % NXCD, xcd = wgid % NXCD, off = wgid / NXCD; wgid = (xcd < r ? xcd * (q + 1) : r * (q + 1) + (xcd - r) * q) + off; }
        const int nig = WGM * nN, gid = wgid / nig, fm = gid * WGM, gsz = (nM - fm) < WGM ? (nM - fm) : WGM;
        u.pm = fm + ((wgid % nig) % gsz); u.pn = (wgid % nig) / gsz;
        u.a = A + (size_t)u.pm * BM * D * 2; u.b = B + (size_t)u.pn * 128 * D * 2; u.c = C + ((size_t)u.pm * BM * FFN + (size_t)u.pn * 128) * 2; u.hm = 0;
        return true;
    }
};
__device__ __forceinline__ float dpp_shr1(float v) { return __int_as_float(__builtin_amdgcn_update_dpp(0, __float_as_int(v), 0x111, 0xf, 0xf, true)); }
__device__ __forceinline__ float dpp_shl1(float v) { return __int_as_float(__builtin_amdgcn_update_dpp(0, __float_as_int(v), 0x101, 0xf, 0xf, true)); }
struct EpiUpConv {
    static constexpr bool PERM = true, APERM = true; static constexpr int MIDK = 0; static constexpr bool PREF = true;
    const float* cw; const float* cb; float* UH; const float* ss; const float* bias; const LAS float* side;
    __device__ __forceinline__ float prefetch(const Unit& u, const int tid) const {
        const int bv = u.pm < NB_P ? 0 : 1 + ((u.pm - NB_P) >> 4);
        const float* p = tid < 256 ? ss + (size_t)u.pm * BM + tid : bias + (size_t)bv * FFN2 + u.pn * 128 + (tid < 384 ? tid - 256 : FFN + tid - 384);
        return *(const GAS float*)p;
    }
    __device__ __forceinline__ void operator()(const Acc& acc, const Unit& u, const int wid) const {
        const int lane = fresh_lane(), wr = wid >> 2, wc = wid & 3, fr = lane & 15, fq = lane >> 4;
        const int q = 16 * wr + fr, ch0 = 32 * wc + 8 * fq;
        const char* wbase = (const char*)(cw + u.pn * 128); const char* bbase = (const char*)(cb + u.pn * 128); asm("" : "+s"(wbase), "+s"(bbase));
        const unsigned coff = (unsigned)ch0 * 4u;
        float rstd[8];
        { const f32x4 s0 = *(const LAS f32x4*)(side + 8 * q), s1 = *(const LAS f32x4*)(side + 8 * q + 4);
#pragma unroll
          for (int k = 0; k < 4; ++k) { rstd[k] = rsqrtf(s0[k] * (1.0f / D) + RMS_EPS); rstd[4 + k] = rsqrtf(s1[k] * (1.0f / D) + RMS_EPS); } }
        unsigned outp[8][4];
#pragma unroll
        for (int n = 0; n < 2; ++n) {
            const f32x4 wa0 = *(const GAS f32x4*)(wbase + coff + n * 16), wa1 = *(const GAS f32x4*)(wbase + coff + n * 16 + FFN2 * 4), wa2 = *(const GAS f32x4*)(wbase + coff + n * 16 + 2 * FFN2 * 4);
            const f32x4 wg0 = *(const GAS f32x4*)(wbase + coff + n * 16 + FFN * 4), wg1 = *(const GAS f32x4*)(wbase + coff + n * 16 + (FFN2 + FFN) * 4), wg2 = *(const GAS f32x4*)(wbase + coff + n * 16 + (2 * FFN2 + FFN) * 4);
            const f32x4 ba = *(const GAS f32x4*)(bbase + coff + n * 16), bg = *(const GAS f32x4*)(bbase + coff + n * 16 + FFN * 4);
            const f32x4 ua_b = *(const LAS f32x4*)(side + 256 + ch0 + 4 * n), ug_b = *(const LAS f32x4*)(side + 384 + ch0 + 4 * n);
            float keep[8];
#pragma unroll
            for (int e = 0; e < 4; ++e) {
                float ua[8], ug[8];
#pragma unroll
                for (int k = 0; k < 8; ++k) { ua[k] = acc[k >> 2][0][k & 3][n][e] * rstd[k] + ua_b[e]; ug[k] = acc[k >> 2][1][k & 3][n][e] * rstd[k] + ug_b[e]; }
                const float pa = dpp_shr1(ua[7]), na = dpp_shl1(ua[0]), pg = dpp_shr1(ug[7]), ng = dpp_shl1(ug[0]);
#pragma unroll
                for (int k = 0; k < 8; ++k) {
                    const float A = wa0[e] * (k ? ua[k - 1] : pa) + wa1[e] * ua[k] + wa2[e] * (k < 7 ? ua[k + 1] : na) + ba[e];
                    const float Gv = wg0[e] * (k ? ug[k - 1] : pg) + wg1[e] * ug[k] + wg2[e] * (k < 7 ? ug[k + 1] : ng) + bg[e];
                    const float o = Gv * sigmoidf_fast(Gv) * A;
                    if (e & 1) outp[k][2 * n + (e >> 1)] = cvt_pk_bf16(keep[k], o); else keep[k] = o;
                }
            }
        }
        char* cbase = u.c; asm("" : "+s"(cbase));
        const unsigned roff = (unsigned)(8 * q) * (unsigned)(FFN * 2) + (unsigned)ch0 * 2u;
#pragma unroll
        for (int k = 0; k < 8; ++k) {
            const bool skip = (k == 0 && fr == 0) || (k == 7 && fr == 15);
            if (!skip) { u32x4 w; w.x = outp[k][0]; w.y = outp[k][1]; w.z = outp[k][2]; w.w = outp[k][3]; *(GAS u32x4*)(cbase + roff + k * (FFN * 2)) = w; }
        }
        if (fr == 0 || fr == 15) {
            char* ub = (char*)(UH + ((size_t)u.pm * 8 + 4 * wr) * FFN2 + u.pn * 128); asm("" : "+s"(ub));
            const unsigned uoff = (unsigned)(fr == 15 ? 2 * FFN2 * 4 : 0) + coff;
#pragma unroll
            for (int kk = 0; kk < 2; ++kk)
#pragma unroll
                for (int n = 0; n < 2; ++n) {
                    const float rs = fr == 0 ? rstd[kk] : rstd[6 + kk];
                    const f32x4 ua_b = *(const LAS f32x4*)(side + 256 + ch0 + 4 * n), ug_b = *(const LAS f32x4*)(side + 384 + ch0 + 4 * n);
                    const f32x4 va = (fr == 0 ? acc[0][0][kk][n] : acc[1][0][2 + kk][n]) * rs + ua_b, vg = (fr == 0 ? acc[0][1][kk][n] : acc[1][1][2 + kk][n]) * rs + ug_b;
                    *(GAS f32x4*)(ub + uoff + kk * (FFN2 * 4) + n * 16) = va; *(GAS f32x4*)(ub + uoff + kk * (FFN2 * 4) + FFN * 4 + n * 16) = vg; }
        }
    }
};
}

struct Buffers;
struct F1SOrder {
    static constexpr int BH_ROWS = 128; static constexpr bool KSPLIT = false;
    int G, c; const char* DC; const char* QK; char* GTS;
    __device__ __forceinline__ bool next(int i, pg8::Unit& u) const {
        const int L = i * G + c; if (L >= 512) return false;
        const int bg = L >> 5, part = (L >> 4) & 1, nt = L & 15, b = bg >> 2, g = bg & 3;
        u.a = DC + (size_t)part * 256 * 256 * 2; u.b = QK + ((size_t)(MP + b * SEQ_S + nt * 256) * IN_DIM + 3072 + g * 256) * 2;
        u.c = GTS + ((size_t)bg * 256 * 8192 + part * 4096 + nt * 256) * 2; u.pm = part; u.pn = nt; u.hm = 0; return true;
    }
};
struct F1POrder {
    static constexpr int BH_ROWS = 128; static constexpr bool KSPLIT = false;
    int G, c; const char* DC; const char* QK; char* GTP;
    __device__ __forceinline__ bool next(int i, pg8::Unit& u) const {
        const int L = i * G + c; if (L >= 128) return false;
        const int bg = L >> 1, part = L & 1, b = bg >> 2, g = bg & 3;
        u.a = DC + (size_t)part * 256 * 256 * 2; u.b = QK + ((size_t)(b * SEQ_P) * IN_DIM + 3072 + g * 256) * 2;
        u.c = GTP + ((size_t)bg * 256 * 512 + part * 256) * 2; u.pm = part; u.pn = 0; u.hm = 0; return true;
    }
};
struct F2SOrder {
    static constexpr int BH_ROWS = 128; static constexpr bool KSPLIT = false;
    int G, c; const char* DS; const char* U2; char* AF;
    __device__ __forceinline__ bool next(int i, pg8::Unit& u) const {
        const int L = i * G + c; if (L >= 256) return false;
        const int bg = L >> 4, k2 = L & 15, b = bg >> 2, g = bg & 3;
        u.a = DS; u.b = U2 + (size_t)(bg * 16 + k2) * 256 * 512 * 2;
        u.c = AF + ((size_t)(MP + b * SEQ_S + k2) * D + 1024 + g * 256) * 2; u.pm = k2; u.pn = 0; u.hm = 0; return true;
    }
};
struct F2POrder {
    static constexpr int BH_ROWS = 128; static constexpr bool KSPLIT = false;
    int G, c; const char* DP; const char* GTP; char* AF;
    __device__ __forceinline__ bool next(int i, pg8::Unit& u) const {
        const int L = i * G + c; if (L >= 64) return false;
        const int bg = L, b = bg >> 2, g = bg & 3;
        u.a = DP; u.b = GTP + (size_t)bg * 256 * 512 * 2; u.c = AF + ((size_t)(b * SEQ_P) * D + 1024 + g * 256) * 2; u.pm = 0; u.pn = 0; u.hm = 0; return true;
    }
};

namespace att {
#define KSWZ(row, colB) ((row) * 256 + ((colB) ^ (((row) & 7) << 4)))
__device__ __forceinline__ int crow(int r, int hi) { return (r & 3) + 8 * (r >> 2) + 4 * hi; }
__device__ __forceinline__ int v_st(int k, int c) { const int kk = (k & ~0xC) | ((k & 4) << 1) | ((k & 8) >> 1); return ((kk >> 3) * 4 + (c >> 5)) * 512 + ((kk & 7) * 32 + (c & 31)) * 2; }
__device__ __forceinline__ int v_rd_base(int lane) { return ((lane & 3) << 3) | (((lane >> 2) & 3) << 6) | (((lane >> 4) & 1) << 5) | (((lane >> 5) & 1) << 8); }
constexpr int v_rd_off(int d0, int ks, int half) { return d0 * 512 + ks * 4096 + half * 2048; }
template <int OFF> __device__ __forceinline__ s16x4 tr_read(int vb) { s16x4 r; asm volatile("ds_read_b64_tr_b16 %0, %1 offset:%2" : "=&v"(r) : "v"(vb), "i"(OFF) : "memory"); return r; }
template <int D0> __device__ __forceinline__ void pv_one(f32x16& od, int vb, bf16x8 pa0, bf16x8 pa1, bf16x8 pa2, bf16x8 pa3) {
    const s16x4 l0 = tr_read<v_rd_off(D0, 0, 0)>(vb), h0 = tr_read<v_rd_off(D0, 0, 1)>(vb), l1 = tr_read<v_rd_off(D0, 1, 0)>(vb), h1 = tr_read<v_rd_off(D0, 1, 1)>(vb);
    const s16x4 l2 = tr_read<v_rd_off(D0, 2, 0)>(vb), h2 = tr_read<v_rd_off(D0, 2, 1)>(vb), l3 = tr_read<v_rd_off(D0, 3, 0)>(vb), h3 = tr_read<v_rd_off(D0, 3, 1)>(vb);
    asm volatile("s_waitcnt lgkmcnt(0)" ::: "memory"); __builtin_amdgcn_sched_barrier(0);
#define ATT_PK(L, H) (bf16x8){L[0], L[1], L[2], L[3], H[0], H[1], H[2], H[3]}
    od = __builtin_amdgcn_mfma_f32_32x32x16_bf16(pa0, ATT_PK(l0, h0), od, 0, 0, 0);
    od = __builtin_amdgcn_mfma_f32_32x32x16_bf16(pa1, ATT_PK(l1, h1), od, 0, 0, 0);
    od = __builtin_amdgcn_mfma_f32_32x32x16_bf16(pa2, ATT_PK(l2, h2), od, 0, 0, 0);
    od = __builtin_amdgcn_mfma_f32_32x32x16_bf16(pa3, ATT_PK(l3, h3), od, 0, 0, 0);
#undef ATT_PK
}
constexpr int SHM_V = 64 * 128 * 2, SHM_K = 64 * 128 * 2;
constexpr int L_V = 0, L_K = 2 * SHM_V, L_WS = 2 * SHM_V + 2 * SHM_K, L_TAB = L_WS + NWAVES * 64 * 4, L_END = L_TAB + 15 * 128 * 4;
static_assert(L_END <= 131072, "attention LDS");

struct TileSrc { const bf16_t* K0; const bf16_t* V0; int ld0, nt0; const bf16_t* K1; const bf16_t* V1; int ld1, nt1; };

template <bool NA>
__device__ __forceinline__ void attn_unit(LAS char* lds, const int wave0, const bf16_t* Qb, int ldq, const TileSrc T, int kr0, int qrow0, const float* rpb, bf16_t* Ob, int ldo) {
    const int lane = fresh_lane(), wid = fresh_wave(wave0), tid = wid * 64 + lane, r32 = lane & 31, hi = lane >> 5;
    LAS char* V_lds = lds + L_V; LAS char* K_lds = lds + L_K;
    LAS float* ws = (LAS float*)(lds + L_WS) + wid * 64; LAS float* li_l = ws; LAS float* al_l = ws + 32;
    LAS float* tab = (LAS float*)(lds + L_TAB);
    float m_reg = -1e30f, l_reg = 0.f; f32x16 o[4];
#pragma unroll
    for (int d = 0; d < 4; ++d)
#pragma unroll
        for (int r = 0; r < 16; ++r) o[d][r] = 0.f;
    bf16x8 qr[8];
    { const bf16_t* Qw = Qb + (size_t)(wid * 32 + r32) * ldq + hi * 8;
#pragma unroll
      for (int d0 = 0; d0 < 8; ++d0) qr[d0] = *(const GAS bf16x8*)(Qw + d0 * 16); }
    if (NA) { for (int idx = tid; idx < 15 * 128; idx += NTHREADS) { const int dr7 = idx >> 7, dcc = (idx & 127) - 63;
                  tab[idx] = (dcc >= -15 && dcc <= 15) ? ((const GAS float*)rpb)[dr7 * 31 + dcc + 15] * LOG2E : 0.f; } }
    const int sr = tid >> 4, sc = (tid & 15) * 8, vst0 = v_st(sr, sc), vst1 = v_st(32 + sr, sc), kst0 = KSWZ(sr, sc * 2), kst1 = KSWZ(32 + sr, sc * 2);
    const int vb0 = (int)(uintptr_t)(V_lds) + v_rd_base(lane);
    const int NT = T.nt0 + T.nt1;
    bf16x8 vs0, vs1, ks0, ks1;
#define ATT_SLOAD(t) do { const bool g0 = (t) < T.nt0; const int tt = g0 ? (t) : (t) - T.nt0; const int ld = g0 ? T.ld0 : T.ld1; \
        const bf16_t* Kp = (g0 ? T.K0 : T.K1) + (size_t)tt * 64 * ld; const bf16_t* Vp = (g0 ? T.V0 : T.V1) + (size_t)tt * 64 * ld; \
        vs0 = *(const GAS bf16x8*)(Vp + (size_t)sr * ld + sc); vs1 = *(const GAS bf16x8*)(Vp + (size_t)(32 + sr) * ld + sc); \
        ks0 = *(const GAS bf16x8*)(Kp + (size_t)sr * ld + sc); ks1 = *(const GAS bf16x8*)(Kp + (size_t)(32 + sr) * ld + sc); } while (0)
#define ATT_SWRITE(b) do { *(LAS bf16x8*)(V_lds + (b) * SHM_V + vst0) = vs0; *(LAS bf16x8*)(V_lds + (b) * SHM_V + vst1) = vs1; \
        *(LAS bf16x8*)(K_lds + (b) * SHM_K + kst0) = ks0; *(LAS bf16x8*)(K_lds + (b) * SHM_K + kst1) = ks1; } while (0)
    ATT_SLOAD(0); ATT_SWRITE(0);
    __syncthreads();
    const int qrow = qrow0 + (wid >> 1), qc = 32 * (wid & 1) + r32;
    const int r0w = min(max(qrow - 4, 0), GW - 8), c0 = min(max(qc - 8, 0), GW - 16);
    for (int t = 0; t < NT; ++t) {
        const int buf = t & 1;
        if (t + 1 < NT) ATT_SLOAD(t + 1);
        bool active = true; int dr = 0;
        if (NA && t >= T.nt0) { const int kr = kr0 + (t - T.nt0); active = (kr >= r0w) && (kr < r0w + 8); dr = kr - qrow; }
        if (active) {
            f32x16 p0, p1;
#pragma unroll
            for (int r = 0; r < 16; ++r) { p0[r] = 0.f; p1[r] = 0.f; }
            { LAS const char* Ks = K_lds + buf * SHM_K;
              __builtin_amdgcn_s_setprio(1);
#pragma unroll
              for (int d0 = 0; d0 < 8; ++d0) { const int cb = (d0 * 16 + hi * 8) * 2;
                  const bf16x8 b0 = *(LAS const bf16x8*)(Ks + KSWZ(r32, cb)); const bf16x8 b1 = *(LAS const bf16x8*)(Ks + KSWZ(32 + r32, cb));
                  p0 = __builtin_amdgcn_mfma_f32_32x32x16_bf16(b0, qr[d0], p0, 0, 0, 0); p1 = __builtin_amdgcn_mfma_f32_32x32x16_bf16(b1, qr[d0], p1, 0, 0, 0); }
              __builtin_amdgcn_s_setprio(0); }
            if (NA && t >= T.nt0) {
                LAS const float* brow = tab + (dr + 7) * 128 + 63 - qc + 4 * hi;
#pragma unroll
                for (int r = 0; r < 16; ++r) { const int kq = (r & 3) + 8 * (r >> 2); const int kc = kq + 4 * hi;
                    const float b0 = brow[kq], b1 = brow[kq + 32];
                    p0[r] = ((unsigned)(kc - c0) < 16u) ? p0[r] + b0 : -INFINITY; p1[r] = ((unsigned)(kc + 32 - c0) < 16u) ? p1[r] + b1 : -INFINITY; }
            }
            float pmax = p0[0];
#pragma unroll
            for (int r = 1; r < 16; ++r) pmax = fmaxf(pmax, p0[r]);
#pragma unroll
            for (int r = 0; r < 16; ++r) pmax = fmaxf(pmax, p1[r]);
            { auto rr = __builtin_amdgcn_permlane32_swap(__float_as_uint(pmax), __float_as_uint(pmax), false, false); pmax = fmaxf(__uint_as_float(rr[0]), __uint_as_float(rr[1])); }
            const float mn = fmaxf(m_reg, pmax), alpha = __builtin_amdgcn_exp2f(m_reg - mn); m_reg = mn;
            float ps = 0.f;
#pragma unroll
            for (int r = 0; r < 16; ++r) { p0[r] = __builtin_amdgcn_exp2f(p0[r] - mn); p1[r] = __builtin_amdgcn_exp2f(p1[r] - mn); ps += p0[r] + p1[r]; }
            { auto rr = __builtin_amdgcn_permlane32_swap(__float_as_uint(ps), __float_as_uint(ps), false, false); ps = __uint_as_float(rr[0]) + __uint_as_float(rr[1]); }
            l_reg = l_reg * alpha + ps;
            bf16x8 pa0, pa1, pa2, pa3;
#define ATT_PK4(P, BASE, OUT) do { unsigned a0 = cvt_pk_bf16(P[BASE + 0], P[BASE + 1]), a1 = cvt_pk_bf16(P[BASE + 2], P[BASE + 3]);   \
    unsigned b0 = cvt_pk_bf16(P[BASE + 4], P[BASE + 5]), b1 = cvt_pk_bf16(P[BASE + 6], P[BASE + 7]);                              \
    auto r0_ = __builtin_amdgcn_permlane32_swap(a0, b0, false, false); auto r1_ = __builtin_amdgcn_permlane32_swap(a1, b1, false, false); \
    u32x4 w_ = {r0_[0], r1_[0], r0_[1], r1_[1]}; OUT = *reinterpret_cast<bf16x8*>(&w_); } while (0)
            ATT_PK4(p0, 0, pa0); ATT_PK4(p0, 8, pa1); ATT_PK4(p1, 0, pa2); ATT_PK4(p1, 8, pa3);
#undef ATT_PK4
            if (__any(alpha < 1.f)) { if (hi == 0) al_l[r32] = alpha; asm volatile("s_waitcnt lgkmcnt(0)" ::: "memory");
#pragma unroll
                for (int r = 0; r < 16; ++r) { const float a = al_l[crow(r, hi)];
#pragma unroll
                    for (int d = 0; d < 4; ++d) o[d][r] *= a; } }
            const int vb = vb0 + buf * SHM_V;
            __builtin_amdgcn_s_setprio(1);
            pv_one<0>(o[0], vb, pa0, pa1, pa2, pa3); pv_one<1>(o[1], vb, pa0, pa1, pa2, pa3); pv_one<2>(o[2], vb, pa0, pa1, pa2, pa3); pv_one<3>(o[3], vb, pa0, pa1, pa2, pa3);
            __builtin_amdgcn_s_setprio(0);
        }
        if (t + 1 < NT) ATT_SWRITE(buf ^ 1);
        __syncthreads();
    }
#undef ATT_SLOAD
#undef ATT_SWRITE
    if (hi == 0) li_l[r32] = l_reg;
    asm volatile("s_waitcnt lgkmcnt(0)" ::: "memory");
    bf16_t* Ow = Ob + (size_t)(wid * 32) * ldo;
#pragma unroll
    for (int r = 0; r < 16; ++r) { const int orow = crow(r, hi); const float rl = __builtin_amdgcn_rcpf(li_l[orow]);
#pragma unroll
        for (int d0 = 0; d0 < 4; ++d0) ((GAS bf16_t*)Ow)[(size_t)orow * ldo + d0 * 32 + r32] = (bf16_t)(cvt_pk_bf16(o[d0][r] * rl, 0.f) & 0xffffu); }
    __syncthreads();
}
}

__device__ __forceinline__ void dft4(float& r0, float& i0, float& r1, float& i1, float& r2, float& i2, float& r3, float& i3) {
    const float t0r = r0 + r2, t0i = i0 + i2, t1r = r0 - r2, t1i = i0 - i2, t2r = r1 + r3, t2i = i1 + i3, t3r = r1 - r3, t3i = i1 - i3;
    r0 = t0r + t2r; i0 = t0i + t2i; r2 = t0r - t2r; i2 = t0i - t2i; r1 = t1r + t3i; i1 = t1i - t3r; r3 = t1r - t3i; i3 = t1i + t3r;
}
__device__ __forceinline__ void fft16(float (&xr)[16], float (&xi)[16]) {
#pragma unroll
    for (int nb = 0; nb < 4; ++nb) dft4(xr[nb], xi[nb], xr[4 + nb], xi[4 + nb], xr[8 + nb], xi[8 + nb], xr[12 + nb], xi[12 + nb]);
    constexpr float C1 = 0.92387953251128674f, S1 = 0.38268343236508977f, R2 = 0.70710678118654752f;
    constexpr float TC[10] = {1.f, C1, R2, S1, 0.f, 0.f, -R2, 0.f, 0.f, -C1};
    constexpr float TS[10] = {0.f, S1, R2, C1, 1.f, 0.f, R2, 0.f, 0.f, -S1};
#pragma unroll
    for (int nb = 1; nb < 4; ++nb)
#pragma unroll
        for (int ka = 1; ka < 4; ++ka) { const float c = TC[nb * ka], sn = TS[nb * ka]; const float ar = xr[4 * ka + nb], ai = xi[4 * ka + nb];
            xr[4 * ka + nb] = ar * c + ai * sn; xi[4 * ka + nb] = ai * c - ar * sn; }
#pragma unroll
    for (int ka = 0; ka < 4; ++ka) dft4(xr[4 * ka], xi[4 * ka], xr[4 * ka + 1], xi[4 * ka + 1], xr[4 * ka + 2], xi[4 * ka + 2], xr[4 * ka + 3], xi[4 * ka + 3]);
}

struct Args { const float* in[20]; float* out; unsigned char* ws; };
enum { I_XP = 0, I_XS, I_CK, I_CV, I_C, I_CCTX, I_WMOD, I_BMOD, I_N1G, I_WIN, I_RPB, I_WPA, I_WPB, I_WOUT, I_N2G, I_WUP, I_CONVW, I_CONVB, I_WDOWN, I_NFG };

__device__ __forceinline__ void transpose_item(const float* W, int K, int N, bf16_t* WT, int ldt, int nsc, float sc, LAS float* scr, int item, int lane) {
    const int nblk = N >> 6, kb = item / nblk, nb = item - kb * nblk, k0 = kb << 6, n0 = nb << 6;
    f32x4 v[16];
    const float* src = W + (size_t)(k0 + (lane >> 4)) * N + n0 + 4 * (lane & 15);
#pragma unroll
    for (int i = 0; i < 16; ++i) v[i] = *(const f32x4*)(src + (size_t)(4 * i) * N);
#pragma unroll
    for (int i = 0; i < 16; ++i) { LAS float* d = scr + (4 * i + (lane >> 4)) * 65 + 4 * (lane & 15); d[0] = v[i][0]; d[1] = v[i][1]; d[2] = v[i][2]; d[3] = v[i][3]; }
    LDS_WAIT(); asm volatile("" ::: "memory");
    const int c = lane & 7;
#pragma unroll
    for (int j = 0; j < 8; ++j) { const int n = (lane >> 3) + 8 * j; const LAS float* s = scr + (8 * c) * 65 + n; const float f = (n0 + n) < nsc ? sc : 1.0f;
        u32x4 o; o.x = cvt_pk_bf16(s[0 * 65] * f, s[1 * 65] * f); o.y = cvt_pk_bf16(s[2 * 65] * f, s[3 * 65] * f); o.z = cvt_pk_bf16(s[4 * 65] * f, s[5 * 65] * f); o.w = cvt_pk_bf16(s[6 * 65] * f, s[7 * 65] * f);
        *(u32x4*)(WT + (size_t)(n0 + n) * ldt + k0 + 8 * c) = o; }
    LDS_WAIT(); asm volatile("" ::: "memory");
}

__global__ void __launch_bounds__(NTHREADS, 2) fwd(Args args) {
    extern __shared__ __attribute__((aligned(16))) unsigned char lds_raw[];
    LAS unsigned char* lds = (LAS unsigned char*)lds_raw;
    volatile LAS unsigned* MISC = (volatile LAS unsigned*)(lds + MISC_OFF);
    const int G = gridDim.x, bx = blockIdx.x;
    const int vcu = (G % 8 == 0) ? (bx % 8) * (G / 8) + bx / 8 : bx;
    const int NGW = G * NWAVES;
    const int wave0 = __builtin_amdgcn_readfirstlane((int)threadIdx.x >> 6);
#define OPQ_BX() int bxo_ = __builtin_amdgcn_readfirstlane((int)MISC[4]); asm volatile("; opaque virtual block index" : "+s"(bxo_)); const int bx = bxo_
#define PIN_TID() const int lane = fresh_lane(), wave = fresh_wave(wave0), tid = wave * 64 + lane, gw = vcu * NWAVES + wave; (void)gw; (void)tid
    { const int tid = threadIdx.x; if (tid < 64) MISC[tid] = 0u; }
    unsigned char* ws = args.ws;
    __syncthreads();
    XcdBarrier bar = xcd_barrier_post((unsigned*)(ws + WS_CTL) + CW_BAR, MISC);
    if (threadIdx.x == 0) { const unsigned xcc = xb_xcc_id(); MISC[2] = xcc; MISC[3] = xb_add((unsigned*)(ws + WS_CTL) + CW_XRANK + 64 * xcc, 1u); MISC[4] = blockIdx.x; }
#define GRID_BAR() do { XcdBarrier b_ = bar; asm volatile("; pin bar" : "+s"(b_.bar), "+s"(b_.x)); const bool ldr_ = (fresh_wave(wave0) == 0) && (fresh_lane() == 0); for (int rb_ = 0; rb_ < REP_BAR; ++rb_) xcd_barrier(b_, ldr_); } while (0)

    float* X = args.out;
    float* OUTK = args.out + (size_t)M * D; float* OUTV = OUTK + (size_t)NB_P * DEPTH * NH * SEQ_P * HD;
    float* MODS = (float*)(ws + WS_MODS); float* SS = (float*)(ws + WS_SS); float* BIN = (float*)(ws + WS_BIAS); float* BUP = BIN + (size_t)DEPTH * 5 * IN_DIM;
    bf16_t* CKB = (bf16_t*)(ws + WS_CACHE); bf16_t* CVB = CKB + (size_t)NB_S * DEPTH * NH * PAST * HD;
    bf16_t* DC = (bf16_t*)(ws + WS_DC); bf16_t* DP = (bf16_t*)(ws + WS_DP); bf16_t* DS = (bf16_t*)(ws + WS_DS); bf16_t* U2 = (bf16_t*)(ws + WS_UP2);
    bf16_t* HB = (bf16_t*)(ws + WS_H); bf16_t* QK = (bf16_t*)(ws + WS_BIG); float* UH = (float*)(ws + WS_UH);
    bf16_t* AF = (bf16_t*)(ws + WS_AF); bf16_t* GTS = (bf16_t*)(ws + WS_GTS); bf16_t* GTP = (bf16_t*)(ws + WS_GTP);
    float* T1 = (float*)(ws + WS_T1); bf16_t* ACT = (bf16_t*)(ws + WS_ACT); bf16_t* YB = (bf16_t*)(ws + WS_Y);

    for (int rep_ = 0; rep_ < REP_P0; ++rep_) {
        PIN_TID();
#if EN_MODS
        for (int item = bx; item < DEPTH * 48; item += G) {
            const int l = item / 48, nb = item % 48;
            LAS float* sil = (LAS float*)lds; LAS float* red = (LAS float*)(lds + 5 * D * 4);
            for (int idx = tid; idx < 5 * D; idx += NTHREADS) { const int v = idx / D, k = idx % D; const float cv = v == 0 ? args.in[I_CCTX][k] : args.in[I_C][(size_t)(v - 1) * D + k];
                sil[idx] = cv * sigmoidf_fast(cv); }
            __syncthreads();
            f32x4 a5[5];
#pragma unroll
            for (int v = 0; v < 5; ++v) a5[v] = (f32x4){0.f, 0.f, 0.f, 0.f};
            const float* Wp = args.in[I_WMOD] + ((size_t)l * D + wave * 256) * (NMOD * D) + 256 * nb + 4 * lane;
            for (int k8 = 0; k8 < 256; k8 += 8) {
                f32x4 wv[8];
#pragma unroll
                for (int j = 0; j < 8; ++j) wv[j] = *(const f32x4*)(Wp + (size_t)(k8 + j) * (NMOD * D));
#pragma unroll
                for (int j = 0; j < 8; ++j)
#pragma unroll
                    for (int v = 0; v < 5; ++v) a5[v] += sil[v * D + wave * 256 + k8 + j] * wv[j];
            }
#pragma unroll
            for (int v = 0; v < 5; ++v) *(LAS f32x4*)(red + (wave * 5 + v) * 256 + 4 * lane) = a5[v];
            __syncthreads();
            for (int o = tid; o < 5 * 256; o += NTHREADS) { const int v = o >> 8, n = o & 255; float s = args.in[I_BMOD][(size_t)l * NMOD * D + 256 * nb + n];
#pragma unroll
                for (int w = 0; w < 8; ++w) s += red[(w * 5 + v) * 256 + n];
                MODS[((size_t)l * 5 + v) * (NMOD * D) + 256 * nb + n] = s; }
            __syncthreads();
        }
#endif
#if EN_WT
        {
            LAS float* scr = (LAS float*)(lds + wave * (64 * 65 * 4));
            constexpr int I_IN = (D / 64) * (IN_DIM / 64), I_PA = (AD / 64) * (D / 64), I_PB = (FD / 64) * (D / 64), I_OUT = (D / 64) * (D / 64), I_UP = (D / 64) * (FFN2 / 64), I_DOWN = (FFN / 64) * (D / 64);
            constexpr int PER_LAYER = I_IN + I_PA + I_PB + I_OUT + I_UP + I_DOWN;
            for (int it = gw; it < DEPTH * PER_LAYER; it += NGW) {
                const int l = it / PER_LAYER; int r = it - l * PER_LAYER;
                bf16_t* wt = (bf16_t*)(ws + WS_WT + (size_t)l * WT_LAYER);
                if (r < I_IN) { transpose_item(args.in[I_WIN] + (size_t)l * D * IN_DIM, D, IN_DIM, wt + WT_IN / 2, D, AD, QSCALE, scr, r, lane); continue; } r -= I_IN;
                if (r < I_PA) { transpose_item(args.in[I_WPA] + (size_t)l * AD * D, AD, D, wt + WT_PA / 2, AD + FD, 0, 1.f, scr, r, lane); continue; } r -= I_PA;
                if (r < I_PB) { transpose_item(args.in[I_WPB] + (size_t)l * FD * D, FD, D, wt + WT_PA / 2 + AD, AD + FD, 0, 1.f, scr, r, lane); continue; } r -= I_PB;
                if (r < I_OUT) { transpose_item(args.in[I_WOUT] + (size_t)l * D * D, D, D, wt + WT_OUT / 2, D, 0, 1.f, scr, r, lane); continue; } r -= I_OUT;
                if (r < I_UP) { transpose_item(args.in[I_WUP] + (size_t)l * D * FFN2, D, FFN2, wt + WT_UP / 2, D, 0, 1.f, scr, r, lane); continue; } r -= I_UP;
                transpose_item(args.in[I_WDOWN] + (size_t)l * FFN * D, FFN, D, wt + WT_DOWN / 2, FFN, 0, 1.f, scr, r, lane);
            }
        }
#endif
#if EN_MISC
        {
            const size_t n8 = (size_t)NB_S * DEPTH * NH * PAST * HD / 8;
            for (size_t i = (size_t)gw * 64 + lane; i < 2 * n8; i += (size_t)NGW * 64) { const bool isk = i < n8; const size_t j = isk ? i : i - n8;
                const float* s = (isk ? args.in[I_CK] : args.in[I_CV]) + j * 8; const f32x4 a = *(const f32x4*)s, b = *(const f32x4*)(s + 4);
                u32x4 w; w.x = cvt_pk_bf16(a[0], a[1]); w.y = cvt_pk_bf16(a[2], a[3]); w.z = cvt_pk_bf16(b[0], b[1]); w.w = cvt_pk_bf16(b[2], b[3]);
                *(u32x4*)((isk ? CKB : CVB) + j * 8) = w; }
        }
        {
            for (int i = gw * 64 + lane; i < 512 * 256 / 8; i += NGW * 64) { const int j = i >> 5, c0 = (i & 31) * 8; const bool isin = j >= 256; const int jj = j & 255;
                float v[8];
#pragma unroll
                for (int e = 0; e < 8; ++e) { const int mm = (jj * (c0 + e)) & 255; const float x = (float)mm * (1.0f / 128.0f); v[e] = (isin ? -sinpif(x) : cospif(x)) * (1.0f / 16.0f); }
                u32x4 w; w.x = cvt_pk_bf16(v[0], v[1]); w.y = cvt_pk_bf16(v[2], v[3]); w.z = cvt_pk_bf16(v[4], v[5]); w.w = cvt_pk_bf16(v[6], v[7]);
                *(u32x4*)(DC + (size_t)j * 256 + c0) = w; }
            for (int i = gw * 64 + lane; i < 256 * 512 / 8; i += NGW * 64) { const int k1 = i >> 6, c8 = (i & 63) * 8; const bool isin = c8 >= 256; const int n0 = c8 & 255;
                float v[8];
#pragma unroll
                for (int e = 0; e < 8; ++e) { const int mm = (k1 * (n0 + e)) & 255; const float x = (float)mm * (1.0f / 128.0f); v[e] = (isin ? sinpif(x) : cospif(x)) * (1.0f / 16.0f); }
                u32x4 w; w.x = cvt_pk_bf16(v[0], v[1]); w.y = cvt_pk_bf16(v[2], v[3]); w.z = cvt_pk_bf16(v[4], v[5]); w.w = cvt_pk_bf16(v[6], v[7]);
                *(u32x4*)(DP + (size_t)k1 * 512 + c8) = w;
                w.x = cvt_pk_bf16(v[0] * 0.25f, v[1] * 0.25f); w.y = cvt_pk_bf16(v[2] * 0.25f, v[3] * 0.25f); w.z = cvt_pk_bf16(v[4] * 0.25f, v[5] * 0.25f); w.w = cvt_pk_bf16(v[6] * 0.25f, v[7] * 0.25f);
                *(u32x4*)(DS + (size_t)k1 * 512 + c8) = w; }
        }
#endif
    }
    GRID_BAR();

    if (threadIdx.x == 0) {
        unsigned* rk = (unsigned*)(ws + WS_CTL) + CW_XRANK; const unsigned xcc = MISC[2], myrank = MISC[3]; unsigned npop = 0, xidx = 0; bool ok = (G % 8) == 0;
        for (unsigned j = 0; j < 16; ++j) { const unsigned cnt = xb_ld(rk + 64 * j); if (cnt) { ++npop; if (j < xcc) ++xidx; if (cnt != (unsigned)(G / 8)) ok = false; } }
        if (ok && npop == 8) MISC[4] = myrank * 8u + xidx;
    }
    __syncthreads();
    {
        PIN_TID();
#if EN_NORM
        { const float* gvec = args.in[I_N1G];
          for (int row = gw; row < M; row += NGW) {
            const float* src = row < MP ? args.in[I_XP] + (size_t)row * D : args.in[I_XS] + (size_t)(row - MP) * D;
            f32x4 v[8]; float ssq = 0.f;
#pragma unroll
            for (int j = 0; j < 8; ++j) { v[j] = *(const GAS f32x4*)(src + 4 * (lane + 64 * j)); ssq += (v[j][0] * v[j][0] + v[j][1] * v[j][1]) + (v[j][2] * v[j][2] + v[j][3] * v[j][3]); }
            ssq = wave_sum(ssq);
            const int bv = row < MP ? 0 : 1 + ((row - MP) >> 12);
            const float* scp = MODS + ((size_t)bv * NMOD + 1) * D;
#pragma unroll
            for (int j = 0; j < 8; ++j) { const int col = 4 * (lane + 64 * j); const f32x4 g = *(const GAS f32x4*)(gvec + col), sc = *(const GAS f32x4*)(scp + col);
                const f32x4 y = v[j] * g * (sc + 1.0f); u32x2 w; w.x = cvt_pk_bf16(y[0], y[1]); w.y = cvt_pk_bf16(y[2], y[3]); *(GAS u32x2*)(HB + (size_t)row * D + col) = w; }
            if (lane == 0) SS[row] = ssq;
          } }
#endif
#if EN_MISC
        for (int l = 0; l < DEPTH; ++l) {
            LAS float* shl = (LAS float*)lds;
            __syncthreads();
            for (int idx = tid; idx < 2 * 5 * D; idx += NTHREADS) { const int w2 = idx / (5 * D), r = idx - w2 * 5 * D, bv = r / D, k = r - bv * D; shl[idx] = MODS[(((size_t)l * 5 + bv) * NMOD + (w2 ? 3 : 0)) * D + k]; }
            __syncthreads();
            const bf16_t* wt_in = (const bf16_t*)(ws + WS_WT + (size_t)l * WT_LAYER + WT_IN); const bf16_t* wt_up = (const bf16_t*)(ws + WS_WT + (size_t)l * WT_LAYER + WT_UP);
            for (int r = gw; r < IN_DIM + FFN2; r += NGW) {
                const bool isup = r >= IN_DIM; const int n = isup ? r - IN_DIM : r;
                const bf16_t* wrow = (isup ? wt_up : wt_in) + (size_t)n * D; const LAS float* sh = shl + (isup ? 5 * D : 0);
                float a5[5] = {0.f, 0.f, 0.f, 0.f, 0.f};
#pragma unroll
                for (int j = 0; j < 4; ++j) { const int k0 = 512 * j + 8 * lane; const u32x4 w = *(const GAS u32x4*)(wrow + k0);
                    float wf[8];
#pragma unroll
                    for (int e = 0; e < 4; ++e) { wf[2 * e] = bf_lo(w[e]); wf[2 * e + 1] = bf_hi(w[e]); }
#pragma unroll
                    for (int bv = 0; bv < 5; ++bv) { const f32x4 s0 = *(const LAS f32x4*)(sh + bv * D + k0), s1 = *(const LAS f32x4*)(sh + bv * D + k0 + 4);
                        a5[bv] += (wf[0] * s0[0] + wf[1] * s0[1]) + (wf[2] * s0[2] + wf[3] * s0[3]) + (wf[4] * s1[0] + wf[5] * s1[1]) + (wf[6] * s1[2] + wf[7] * s1[3]); } }
#pragma unroll
                for (int bv = 0; bv < 5; ++bv) { const float t = wave_sum(a5[bv]); if (lane == 0) { if (isup) BUP[((size_t)l * 5 + bv) * FFN2 + n] = t; else BIN[((size_t)l * 5 + bv) * IN_DIM + n] = t; } }
            }
        }
        __syncthreads();
#endif
    }
    GRID_BAR();

    for (int l = 0; l < DEPTH; ++l) {
        const float* mods_l = MODS + (size_t)l * 5 * NMOD * D;
        const unsigned char* wt = ws + WS_WT + (size_t)l * WT_LAYER;
#if EN_GIN
        {
            OPQ_BX();
            pg8::TileOrder S; S.init(M, IN_DIM, G, bx, HB, D, wt + WT_IN, D, QK, IN_DIM, 2);
            pg8::EpiIn E{OUTK, OUTV, l, SS + (size_t)(2 * l) * M, BIN + (size_t)l * 5 * IN_DIM, (const LAS float*)(lds + pg8::STAGE_BYTES)};
            for (int rep_ = 0; rep_ < REP_GIN; ++rep_)
            pg8::gemm_phase<pg8::EpiIn, pg8::TileOrder>(lds, wave0, D, D, D, S, E);
        }
#endif
        GRID_BAR();

        {
            OPQ_BX();
#if EN_ATT
            for (int rep_ = 0; rep_ < REP_ATT; ++rep_)
            for (int U = bx; U < 640; U += G) {
                if (U < 512) {
                    const int b = U >> 7, h = (U >> 4) & 7, i4 = U & 15;
                    const int kr0 = max(4 * i4 - 4, 0), ntn = (i4 == 0 || i4 == 15) ? 8 : 11;
                    const size_t rowbase = (size_t)MP + (size_t)b * SEQ_S;
                    att::TileSrc T;
                    T.K0 = CKB + (((size_t)b * DEPTH + l) * NH + h) * PAST * HD; T.V0 = CVB + (((size_t)b * DEPTH + l) * NH + h) * PAST * HD; T.ld0 = HD; T.nt0 = 4;
                    T.K1 = QK + (rowbase + (size_t)kr0 * GW) * IN_DIM + 1024 + h * HD; T.V1 = T.K1 + 1024; T.ld1 = IN_DIM; T.nt1 = ntn;
                    att::attn_unit<true>((LAS char*)lds, wave0, QK + (rowbase + (size_t)i4 * 256) * IN_DIM + h * HD, IN_DIM, T, kr0, 4 * i4,
                                         args.in[I_RPB] + ((size_t)l * NH + h) * 15 * 31, AF + (rowbase + (size_t)i4 * 256) * D + h * HD, D);
                } else {
                    const int bh = U - 512, b = bh >> 3, h = bh & 7;
                    att::TileSrc T;
                    T.K0 = QK + ((size_t)b * SEQ_P) * IN_DIM + 1024 + h * HD; T.V0 = T.K0 + 1024; T.ld0 = IN_DIM; T.nt0 = 4;
                    T.K1 = T.K0; T.V1 = T.V0; T.ld1 = IN_DIM; T.nt1 = 0;
                    att::attn_unit<false>((LAS char*)lds, wave0, QK + ((size_t)b * SEQ_P) * IN_DIM + h * HD, IN_DIM, T, 0, 0, nullptr, AF + ((size_t)b * SEQ_P) * D + h * HD, D);
                }
            }
#endif
#if EN_F1
            for (int rep_ = 0; rep_ < REP_FOUR; ++rep_) {
            { F1SOrder S{G, bx, (const char*)DC, (const char*)QK, (char*)GTS}; pg8::EpiBf16U<8192> E; pg8::gemm_phase<pg8::EpiBf16U<8192>, F1SOrder>(lds, wave0, 256, IN_DIM, 256, S, E); }
            { F1POrder S{G, G - 1 - bx, (const char*)DC, (const char*)QK, (char*)GTP}; pg8::EpiBf16U<512> E; pg8::gemm_phase<pg8::EpiBf16U<512>, F1POrder>(lds, wave0, 256, IN_DIM, 256, S, E); }
            }
#endif
        }
        GRID_BAR();

#if EN_F2
        {
            PIN_TID();
            for (int rep_ = 0; rep_ < REP_FOUR; ++rep_)
            for (int it = gw; it < 16 * 256 * 2; it += NGW) {
                const int row = it >> 1, half = it & 1;
                const char* src = (const char*)GTS + (size_t)row * 8192 * 2 + (unsigned)(half * 256 + lane * 4);
                unsigned zr[16], zi[16];
#pragma unroll
                for (int n2 = 0; n2 < 16; ++n2) { zr[n2] = *(const GAS unsigned*)(src + n2 * 512); zi[n2] = *(const GAS unsigned*)(src + 8192 + n2 * 512); }
                unsigned orr[16], oii[16];
#pragma unroll
                for (int j = 0; j < 2; ++j) {
                    float xr[16], xi[16];
#pragma unroll
                    for (int n2 = 0; n2 < 16; ++n2) { xr[n2] = j ? bf_hi(zr[n2]) : bf_lo(zr[n2]); xi[n2] = j ? bf_hi(zi[n2]) : bf_lo(zi[n2]); }
                    fft16(xr, xi);
                    float s1, c1; sincospif((float)(128 * half + 2 * lane + j) * (1.0f / 2048.0f), &s1, &c1);
                    float wr = 1.f, wi = 0.f;
#pragma unroll
                    for (int k2 = 0; k2 < 16; ++k2) { const int slot = 4 * (k2 & 3) + (k2 >> 2);
                        const float ur = xr[slot] * wr - xi[slot] * wi, ui = xr[slot] * wi + xi[slot] * wr;
                        if (j == 0) { orr[k2] = __float_as_uint(ur); oii[k2] = __float_as_uint(ui); }
                        else { orr[k2] = cvt_pk_bf16(__uint_as_float(orr[k2]), ur); oii[k2] = cvt_pk_bf16(__uint_as_float(oii[k2]), ui); }
                        const float nwr = wr * c1 + wi * s1, nwi = wi * c1 - wr * s1; wr = nwr; wi = nwi; }
                }
                const int bg = row >> 8, c = row & 255;
                char* dst = (char*)U2 + ((size_t)(bg * 16) * 256 + c) * 512 * 2 + (unsigned)(half * 256 + lane * 4);
#pragma unroll
                for (int k2 = 0; k2 < 16; ++k2) { *(GAS unsigned*)(dst + (size_t)k2 * 256 * 512 * 2) = orr[k2]; *(GAS unsigned*)(dst + (size_t)k2 * 256 * 512 * 2 + 512) = oii[k2]; }
            }
        }
#endif
        GRID_BAR();

#if EN_F2
        {
            OPQ_BX();
            for (int rep_ = 0; rep_ < REP_FOUR; ++rep_) {
            { F2SOrder S{G, bx, (const char*)DS, (const char*)U2, (char*)AF}; pg8::EpiBf16U<16 * D> E; pg8::gemm_phase<pg8::EpiBf16U<16 * D>, F2SOrder>(lds, wave0, 512, 512, 512, S, E); }
            { F2POrder S{G, G - 1 - bx, (const char*)DP, (const char*)GTP, (char*)AF}; pg8::EpiBf16U<D> E; pg8::gemm_phase<pg8::EpiBf16U<D>, F2POrder>(lds, wave0, 512, 512, 512, S, E); }
            }
        }
#endif
        GRID_BAR();

#if EN_PAB
        {
            OPQ_BX();
            for (int rep_ = 0; rep_ < REP_PAB; ++rep_) {
            pg8::TileOrder S; S.init(M, D, G, bx, AF, D, wt + WT_PA, AD + FD, YB, D, 2); S.half_tail(); pg8::EpiPab E{QK, YB}; pg8::gemm_phase<pg8::EpiPab, pg8::TileOrder>(lds, wave0, D, AD + FD, AD + FD, S, E);
            }
        }
#endif
        GRID_BAR();

#if EN_OUT
        {
            OPQ_BX();
            pg8::TileOrder S; S.init(M, D, G, bx, YB, D, wt + WT_OUT, D, X, D, 4); S.half_tail();
            pg8::EpiRes E{args.in[I_XP], args.in[I_XS], X, mods_l, 2, l == 0, X, true, args.in[I_N2G] + (size_t)l * D, mods_l + 4 * D, SS + (size_t)(2 * l + 1) * M, HB, (const LAS float*)(lds + pg8::STAGE_BYTES)};
            for (int rep_ = 1; rep_ < REP_OUT; ++rep_) { pg8::EpiRes E2{args.in[I_XP], args.in[I_XS], X, mods_l, 2, l == 0, (float*)QK, false, nullptr, nullptr, nullptr, nullptr, (const LAS float*)(lds + pg8::STAGE_BYTES)}; pg8::gemm_phase<pg8::EpiRes, pg8::TileOrder>(lds, wave0, D, D, D, S, E2); }
            pg8::gemm_phase<pg8::EpiRes, pg8::TileOrder>(lds, wave0, D, D, D, S, E);
        }
#endif
        GRID_BAR();

#if EN_UP
        {
            OPQ_BX();
            pg8::UpOrder S; S.init(G, bx, HB, wt + WT_UP, ACT);
            pg8::EpiUpConv E{args.in[I_CONVW] + (size_t)l * 3 * FFN2, args.in[I_CONVB] + (size_t)l * FFN2, UH, SS + (size_t)(2 * l + 1) * M, BUP + (size_t)l * 5 * FFN2, (const LAS float*)(lds + pg8::STAGE_BYTES)};
            for (int rep_ = 0; rep_ < REP_UP; ++rep_)
            pg8::gemm_phase<pg8::EpiUpConv, pg8::UpOrder>(lds, wave0, D, D, D, S, E);
        }
#endif
        GRID_BAR();

#if EN_CONV
        {
            PIN_TID();
            const float* cw = args.in[I_CONVW] + (size_t)l * 3 * FFN2; const float* cb = args.in[I_CONVB] + (size_t)l * FFN2;
            for (int rep_ = 0; rep_ < REP_THIN; ++rep_)
            for (int it = gw; it < (M / 256) * 4 * 11; it += NGW) {
                const int pm = it / 44, rem = it - pm * 44, t = rem / 11, cc = rem - t * 11, j0 = cc * 512 + lane * 8;
                const int row = pm * 256 + (t == 0 ? 0 : t == 1 ? 127 : t == 2 ? 128 : 255);
                const int seqmask = row < MP ? (SEQ_P - 1) : (SEQ_S - 1);
                const int sc_ = t == 0 ? 0 : t == 1 ? 3 : t == 2 ? 4 : 7;
                const bool zprev = (t == 0) && ((row & seqmask) == 0), znext = (t == 3) && ((row & seqmask) == seqmask);
                const float* pc = UH + ((size_t)pm * 8 + sc_) * FFN2 + j0;
                const float* pp = (t == 0) ? UH + ((size_t)(pm - 1) * 8 + 7) * FFN2 + j0 : pc - FFN2;
                const float* pn = (t == 3) ? UH + ((size_t)(pm + 1) * 8 + 0) * FFN2 + j0 : pc + FFN2;
                float o[8];
#pragma unroll
                for (int h = 0; h < 2; ++h) {
                    const f32x4 z4 = {0.f, 0.f, 0.f, 0.f};
                    const f32x4 ap = zprev ? z4 : *(const GAS f32x4*)(pp + 4 * h), ac = *(const GAS f32x4*)(pc + 4 * h), an = znext ? z4 : *(const GAS f32x4*)(pn + 4 * h);
                    const f32x4 gp = zprev ? z4 : *(const GAS f32x4*)(pp + FFN + 4 * h), gc = *(const GAS f32x4*)(pc + FFN + 4 * h), gn = znext ? z4 : *(const GAS f32x4*)(pn + FFN + 4 * h);
                    const f32x4 wa0 = *(const GAS f32x4*)(cw + j0 + 4 * h), wa1 = *(const GAS f32x4*)(cw + FFN2 + j0 + 4 * h), wa2 = *(const GAS f32x4*)(cw + 2 * FFN2 + j0 + 4 * h), ba = *(const GAS f32x4*)(cb + j0 + 4 * h);
                    const f32x4 wg0 = *(const GAS f32x4*)(cw + FFN + j0 + 4 * h), wg1 = *(const GAS f32x4*)(cw + FFN2 + FFN + j0 + 4 * h), wg2 = *(const GAS f32x4*)(cw + 2 * FFN2 + FFN + j0 + 4 * h), bg = *(const GAS f32x4*)(cb + FFN + j0 + 4 * h);
#pragma unroll
                    for (int e = 0; e < 4; ++e) { const float A = wa0[e] * ap[e] + wa1[e] * ac[e] + wa2[e] * an[e] + ba[e], Gv = wg0[e] * gp[e] + wg1[e] * gc[e] + wg2[e] * gn[e] + bg[e];
                        o[4 * h + e] = Gv * sigmoidf_fast(Gv) * A; }
                }
                u32x4 w; w.x = cvt_pk_bf16(o[0], o[1]); w.y = cvt_pk_bf16(o[2], o[3]); w.z = cvt_pk_bf16(o[4], o[5]); w.w = cvt_pk_bf16(o[6], o[7]);
                *(GAS u32x4*)(ACT + (size_t)row * FFN + j0) = w;
            }
        }
#endif
        GRID_BAR();

#if EN_DOWN
        {
            OPQ_BX();
            pg8::TileOrder S; S.init(M, D, G, bx, ACT, FFN, wt + WT_DOWN, FFN, X, D, 4); S.split_tail(40, (unsigned*)(ws + WS_CTL) + CW_FLAG + (size_t)l * 128 * 16);
            const int ln = l + 1 < DEPTH ? l + 1 : l;
            pg8::EpiRes E{args.in[I_XP], args.in[I_XS], X, mods_l, 5, false, X, l + 1 < DEPTH, args.in[I_N1G] + (size_t)ln * D, MODS + (size_t)ln * 5 * NMOD * D + 1 * D, SS + (size_t)(2 * ln) * M, HB, (const LAS float*)(lds + pg8::STAGE_BYTES)};
            for (int rep_ = 1; rep_ < REP_DOWN; ++rep_) { pg8::EpiRes E2{args.in[I_XP], args.in[I_XS], X, mods_l, 5, false, (float*)QK, false, nullptr, nullptr, nullptr, nullptr, (const LAS float*)(lds + pg8::STAGE_BYTES)}; pg8::gemm_phase<pg8::EpiRes, pg8::TileOrder>(lds, wave0, FFN, FFN, FFN, S, E2); }
            pg8::gemm_phase<pg8::EpiRes, pg8::TileOrder>(lds, wave0, FFN, FFN, FFN, S, E);
        }
#endif
        GRID_BAR();
    }

#if EN_FINAL
    {
        PIN_TID();
        const float* gvec = args.in[I_NFG];
        for (int row = gw; row < M; row += NGW) {
            float* src = X + (size_t)row * D;
            f32x4 v[8]; float ss = 0.f;
#pragma unroll
            for (int j = 0; j < 8; ++j) { v[j] = *(const f32x4*)(src + 4 * (lane + 64 * j)); ss += (v[j][0] * v[j][0] + v[j][1] * v[j][1]) + (v[j][2] * v[j][2] + v[j][3] * v[j][3]); }
            const float rstd = rsqrtf(wave_sum(ss) * (1.0f / D) + RMS_EPS);
#pragma unroll
            for (int j = 0; j < 8; ++j) { const int col = 4 * (lane + 64 * j); const f32x4 g = *(const f32x4*)(gvec + col); *(f32x4*)(src + col) = (v[j] * rstd) * g; }
        }
    }
#endif
}

extern "C" void kernel_launch(void* const* d_in, const int* in_sizes, int n_in, void* d_out, int out_size, void* d_ws, size_t ws_size, hipStream_t stream) {
    static int grid = 0;
    if (grid == 0) {
        if (n_in != 20 || in_sizes[0] != MP * D || in_sizes[1] != MS * D || ws_size < WS_END) {
            fprintf(stderr, "kernel_launch: shape mismatch: n_in %d in0 %d in1 %d out %d ws %zu (need >= %zu); nothing launched\n", n_in, n_in > 0 ? in_sizes[0] : -1, n_in > 1 ? in_sizes[1] : -1, out_size, ws_size, (size_t)WS_END); grid = -1; return; }
        int dev = 0, cus = 0, per_cu = 0;
        if (hipGetDevice(&dev) != hipSuccess || hipDeviceGetAttribute(&cus, hipDeviceAttributeMultiprocessorCount, dev) != hipSuccess) { fprintf(stderr, "kernel_launch: device query failed\n"); grid = -1; return; }
        if (hipFuncSetAttribute((const void*)fwd, hipFuncAttributeMaxDynamicSharedMemorySize, LDS_BYTES) != hipSuccess) { fprintf(stderr, "kernel_launch: hipFuncSetAttribute failed\n"); grid = -1; return; }
        if (hipOccupancyMaxActiveBlocksPerMultiprocessor(&per_cu, (const void*)fwd, NTHREADS, LDS_BYTES) != hipSuccess || per_cu < 1)
            fprintf(stderr, "kernel_launch: note: occupancy query reports %d workgroups per CU\n", per_cu);
        (void)hipGetLastError();
        grid = cus;
    }
    if (grid < 0) return;
    if (hipMemsetAsync((char*)d_ws + WS_CTL, 0, CTL_ZERO_BYTES, stream) != hipSuccess) { fprintf(stderr, "kernel_launch: memset failed\n"); return; }
    Args a{};
    for (int i = 0; i < 20; ++i) a.in[i] = (const float*)d_in[i];
    a.out = (float*)d_out; a.ws = (unsigned char*)d_ws;
    hipLaunchKernelGGL(fwd, dim3(grid), dim3(NTHREADS), LDS_BYTES, stream, a);
    const hipError_t le = hipPeekAtLastError();
    if (le != hipSuccess) fprintf(stderr, "kernel_launch: launch failed: %s\n", hipGetErrorName(le));
}
```

```cpp
#include <hip/hip_runtime.h>
#include <cstdio>
#include <cstdint>

#define GAS __attribute__((address_space(1)))
#define LAS __attribute__((address_space(3)))
typedef unsigned short bf16_t;
typedef short bf16x8 __attribute__((ext_vector_type(8)));
typedef short s16x4 __attribute__((ext_vector_type(4)));
typedef float f32x4 __attribute__((ext_vector_type(4)));
typedef float f32x2 __attribute__((ext_vector_type(2)));
typedef float f32x16 __attribute__((ext_vector_type(16)));
typedef unsigned u32x4 __attribute__((ext_vector_type(4)));
typedef unsigned u32x2 __attribute__((ext_vector_type(2)));

#ifndef EN_MODS
#define EN_MODS 1
#endif
#ifndef EN_WT
#define EN_WT 1
#endif
#ifndef EN_MISC
#define EN_MISC 1
#endif
#ifndef EN_NORM
#define EN_NORM 1
#endif
#ifndef EN_GIN
#define EN_GIN 1
#endif
#ifndef EN_ATT
#define EN_ATT 1
#endif
#ifndef EN_F1
#define EN_F1 1
#endif
#ifndef EN_F2
#define EN_F2 1
#endif
#ifndef EN_PAB
#define EN_PAB 1
#endif
#ifndef EN_OUT
#define EN_OUT 1
#endif
#ifndef EN_UP
#define EN_UP 1
#endif
#ifndef EN_CONV
#define EN_CONV 1
#endif
#ifndef EN_DOWN
#define EN_DOWN 1
#endif
#ifndef EN_FINAL
#define EN_FINAL 1
#endif
#ifndef REP_P0
#define REP_P0 1
#endif
#ifndef REP_ATT
#define REP_ATT 1
#endif
#ifndef REP_THIN
#define REP_THIN 1
#endif
#ifndef REP_GIN
#define REP_GIN 1
#endif
#ifndef REP_BAR
#define REP_BAR 1
#endif
#ifndef REP_OUT
#define REP_OUT 1
#endif
#ifndef REP_DOWN
#define REP_DOWN 1
#endif
#ifndef REP_PAB
#define REP_PAB 1
#endif
#ifndef REP_FOUR
#define REP_FOUR 1
#endif
#ifndef REP_UP
#define REP_UP 1
#endif
constexpr int D = 2048, NB_P = 16, SEQ_P = 256, DEPTH = 4, NB_S = 4, SEQ_S = 4096, PAST = 256;
constexpr int MP = NB_P * SEQ_P;
constexpr int MS = NB_S * SEQ_S;
constexpr int M = MP + MS;
constexpr int NH = 8, HD = 128, AD = 1024, FD = 1024, FFN = 5632, FFN2 = 11264, IN_DIM = 8192, NMOD = 6;
constexpr int GW = 64;
constexpr float RMS_EPS = 1e-6f;
constexpr float QSCALE = 0.08838834764831845f * 1.4426950408889634f;
constexpr float LOG2E = 1.4426950408889634f;

constexpr size_t MiB = 1u << 20;
constexpr size_t WS_CTL = 0, CTL_ZERO_BYTES = 2 * MiB;
constexpr size_t WS_SS = 1 * MiB;
constexpr size_t WS_MODS = 2 * MiB;
constexpr size_t WS_BIAS = 3 * MiB;
constexpr size_t WS_CACHE = 5 * MiB;
constexpr size_t WS_DC = 21 * MiB;
constexpr size_t WS_DP = WS_DC + 256 * 1024;
constexpr size_t WS_DS = WS_DP + 256 * 1024;
constexpr size_t WS_UP2 = 22 * MiB;
constexpr size_t WS_WT = 86 * MiB;
constexpr size_t WT_IN = 0, WT_PA = (size_t)IN_DIM * D * 2, WT_PB = WT_PA + (size_t)D * AD * 2, WT_OUT = WT_PB + (size_t)D * FD * 2,
                 WT_UP = WT_OUT + (size_t)D * D * 2, WT_DOWN = WT_UP + (size_t)FFN2 * D * 2, WT_LAYER = WT_DOWN + (size_t)D * FFN * 2;
static_assert(WT_LAYER == 114 * MiB, "weight copy size");
constexpr size_t WS_H = WS_WT + 4 * WT_LAYER;
constexpr size_t WS_BIG = WS_H + 80 * MiB;
constexpr size_t WS_UH = WS_BIG + 320 * MiB;
constexpr size_t WS_AF = WS_BIG + 440 * MiB;
constexpr size_t WS_GTS = WS_AF + 80 * MiB;
constexpr size_t WS_GTP = WS_GTS + 64 * MiB;
constexpr size_t WS_T1 = WS_GTP + 16 * MiB;
constexpr size_t WS_ACT = WS_AF;
constexpr size_t WS_Y = WS_T1 + 160 * MiB;
constexpr size_t WS_END = WS_Y + 80 * MiB;
static_assert(WS_END <= 1536 * MiB, "workspace map");
static_assert((size_t)M * FFN * 2 <= 320 * MiB, "act overlay");

constexpr int CW_FLAG = 65536;
constexpr int CW_PANEL = 98304;
constexpr int CW_XRANK = 32768;
constexpr int CW_BAR = 4096;

constexpr int LDS_BYTES = 147456;
constexpr int MISC_OFF = LDS_BYTES - 256;
constexpr int NWAVES = 8, NTHREADS = 512;

#define LDS_WAIT() asm volatile("s_waitcnt lgkmcnt(0)" ::: "memory")
#define VM_WAIT() asm volatile("s_waitcnt vmcnt(0)" ::: "memory")
__device__ __forceinline__ unsigned cvt_pk_bf16(float lo, float hi) { unsigned r; asm volatile("v_cvt_pk_bf16_f32 %0, %1, %2" : "=v"(r) : "v"(lo), "v"(hi)); return r; }
__device__ __forceinline__ float bf_lo(unsigned w) { return __uint_as_float(w << 16); }
__device__ __forceinline__ float bf_hi(unsigned w) { return __uint_as_float(w & 0xffff0000u); }
__device__ __forceinline__ float sigmoidf_fast(float x) { return __builtin_amdgcn_rcpf(1.0f + __expf(-x)); }
template <int CTRL> __device__ __forceinline__ float dpp_add(float v) { return v + __int_as_float(__builtin_amdgcn_update_dpp(0, __float_as_int(v), CTRL, 0xf, 0xf, true)); }
__device__ __forceinline__ float wave_sum(float v) {
    v = dpp_add<0xB1>(v);
    v = dpp_add<0x4E>(v);
    v = dpp_add<0x141>(v);
    v = dpp_add<0x140>(v);
    const float s0 = __int_as_float(__builtin_amdgcn_readlane(__float_as_int(v), 0)), s1 = __int_as_float(__builtin_amdgcn_readlane(__float_as_int(v), 16));
    const float s2 = __int_as_float(__builtin_amdgcn_readlane(__float_as_int(v), 32)), s3 = __int_as_float(__builtin_amdgcn_readlane(__float_as_int(v), 48));
    return (s0 + s1) + (s2 + s3);
}
__device__ __forceinline__ int fresh_wave(int w) { asm volatile("; opaque wave index" : "+s"(w)); return w; }
__device__ __forceinline__ int fresh_lane() { int l; asm volatile("v_mbcnt_lo_u32_b32 %0, -1, 0\n\tv_mbcnt_hi_u32_b32 %0, -1, %0" : "=v"(l)); return l; }

#define XB_TMO      128
#define XB_XCNT(j)  (256  + 64 * (j))
#define XB_XSUB(j)  (1280 + 64 * (j))
#define XB_XGEN(j)  (2304 + 64 * (j))
#define XB_TOP      3328
#define XB_TOPGEN   3392
#define XCD_BAR_WORDS 3456
#define XB_SPIN_CAP (1u << 18)
__device__ __forceinline__ unsigned xb_ld(unsigned* p)              { return __hip_atomic_load((GAS unsigned*)p, __ATOMIC_RELAXED, __HIP_MEMORY_SCOPE_AGENT); }
__device__ __forceinline__ unsigned xb_add(unsigned* p, unsigned v) { return __hip_atomic_fetch_add((GAS unsigned*)p, v, __ATOMIC_RELAXED, __HIP_MEMORY_SCOPE_AGENT); }
__device__ __forceinline__ unsigned xb_xcc_id() { return (unsigned)__builtin_amdgcn_s_getreg((3 << 11) | 20) & 0xFu; }
#define XB_SPIN(cond, bar) do { unsigned _sp = 0; while (cond) { __builtin_amdgcn_s_sleep(1); \
    if ((++_sp & 255u) == 0u) { if (xb_ld(&(bar)[XB_TMO])) break; if (_sp > XB_SPIN_CAP) { xb_add(&(bar)[XB_TMO], 1u); break; } } } } while (0)
struct XcdBarrier { unsigned* bar; unsigned x; volatile LAS unsigned* st; };
__device__ __forceinline__ XcdBarrier xcd_barrier_post(unsigned* bar, volatile LAS unsigned* st) {
    XcdBarrier b; b.bar = bar; b.x = xb_xcc_id(); b.st = st;
    if (threadIdx.x == 0) (void)xb_add(&bar[XB_XCNT(b.x)], 1u);
    return b;
}
__device__ __forceinline__ void xcd_barrier_complete(unsigned* bar, unsigned x, unsigned& nloc, unsigned& nx) {
    const unsigned G = gridDim.x * gridDim.y * gridDim.z;
    unsigned sum, cnt, mine, sp = 0u;
    for (;;) {
        sum = 0u; cnt = 0u; mine = 0u;
#pragma unroll
        for (unsigned j = 0; j < 16; ++j) { const unsigned c = xb_ld(&bar[XB_XCNT(j)]); sum += c; cnt += (c > 0u) ? 1u : 0u; mine = (j == x) ? c : mine; }
        if (sum == G) break;
        __builtin_amdgcn_s_sleep(1);
        if ((++sp & 255u) == 0u) { if (xb_ld(&bar[XB_TMO])) break; if (sp > XB_SPIN_CAP) { xb_add(&bar[XB_TMO], 1u); break; } }
    }
    nloc = mine > 0u ? mine : 1u; nx = cnt > 0u ? cnt : 1u;
}
__device__ __forceinline__ void xcd_barrier(const XcdBarrier& b, const bool leader_thread) {
    asm volatile("s_waitcnt vmcnt(0)" ::: "memory");
    __syncthreads();
    if (leader_thread) {
        unsigned* bar = b.bar;
        __builtin_amdgcn_s_waitcnt(0);
        unsigned nloc = b.st[0], nx = b.st[1];
        if (nloc == 0u) { xcd_barrier_complete(bar, b.x, nloc, nx); b.st[0] = nloc; b.st[1] = nx; }
        const unsigned old = xb_add(&bar[XB_XSUB(b.x)], 1u);
        const unsigned gen = old / nloc;
        if (old + 1u == (gen + 1u) * nloc) {
            __builtin_amdgcn_fence(__ATOMIC_RELEASE, "agent");
            asm volatile("s_waitcnt vmcnt(0)" ::: "memory");
            const unsigned og = xb_add(&bar[XB_TOP], 1u);
            const unsigned tg = og / nx;
            if (og + 1u == (tg + 1u) * nx) xb_add(&bar[XB_TOPGEN], 1u);
            else XB_SPIN(xb_ld(&bar[XB_TOPGEN]) == tg, bar);
            __builtin_amdgcn_fence(__ATOMIC_ACQUIRE, "agent");
            xb_add(&bar[XB_XGEN(b.x)], 1u);
            asm volatile("s_waitcnt vmcnt(0)" ::: "memory");
        } else {
            XB_SPIN(xb_ld(&bar[XB_XGEN(b.x)]) == gen, bar);
            __builtin_amdgcn_fence(__ATOMIC_ACQUIRE, "agent");
            asm volatile("s_waitcnt vmcnt(0)" ::: "memory");
        }
    }
    __syncthreads();
}

namespace pg8 {
constexpr int BM = 256, BK = 64, HALF = 128, HTB = HALF * BK * 2, STAGE_BYTES = 8 * HTB, NXCD = 8, WGM = 8;
__host__ __device__ __forceinline__ int lds_byte(int r, int c) { const int st = (r >> 4) * 2 + (c >> 5), rr = r & 15, cc = c & 31, ob = rr * 64 + cc * 2; return st * 1024 + (ob ^ (((ob >> 9) & 1) << 5)); }
__host__ __device__ __forceinline__ void stage_rc(int b, int& R, int& C) { const int st = b / 1024, sb = b % 1024, swz = sb ^ (((sb >> 9) & 1) << 5); R = (st >> 1) * 16 + swz / 64; C = (st & 1) * 32 + (swz % 64) / 2; }
__host__ __device__ __forceinline__ int perm32(int rho) { const int n = rho >> 4, i = rho & 15; return 8 * (i >> 2) + 4 * n + (i & 3); }

struct Unit { const char* a; const char* b; char* c; int pm, pn, hm; };

struct TileOrder {
    static constexpr int BH_ROWS = 128; static constexpr bool KSPLIT = true, MERGED = false;
    int nM, nN, nwg, G, c; const char* A; const char* B; char* C; size_t astep, bstep, cstep; int ldc, cesz; int tail, ktp; size_t khalf; unsigned* flags;
    __device__ __forceinline__ void init(int M_, int N_, int G_, int c_, const void* A_, int lda, const void* B_, int ldb, void* C_, int ldc_, int cesz_) {
        nM = M_ / BM; nN = N_ / BM; nwg = nM * nN; G = G_; c = c_; A = (const char*)A_; B = (const char*)B_; C = (char*)C_;
        astep = (size_t)BM * lda * 2; bstep = (size_t)BM * ldb * 2; ldc = ldc_; cesz = cesz_; cstep = (size_t)BM * ldc_ * cesz_; tail = 0; ktp = 0; khalf = 0; flags = nullptr;
    }
    __device__ __forceinline__ void half_tail() { if (G == 256 && nwg == 640) tail = 1; }
    __device__ __forceinline__ void split_tail(int ktp_, unsigned* flags_) { if (G == 256 && nwg == 640) { tail = 2; ktp = ktp_; khalf = (size_t)ktp_ * (BK * 2); flags = flags_; } }
    __device__ __forceinline__ bool next(int i, Unit& u) const {
        int wgid; u.hm = 0;
        if (tail && i >= 2) { if (i > 2) return false;
            const int xcd = c % NXCD, k = c / NXCD, j = k >> 1; wgid = xcd * (nwg / NXCD) + 64 + j;
            u.hm = (tail == 1) ? 1 + (k & 1) : ((3 + (k & 1)) | ((xcd * 16 + j) << 4)); }
        else { const long L = (long)i * G + c; if (L >= nwg) return false;
            wgid = (int)L; { const int q = nwg / NXCD, r = nwg % NXCD, xcd = wgid % NXCD, off = wgid / NXCD; wgid = (xcd < r ? xcd * (q + 1) : r * (q + 1) + (xcd - r) * q) + off; } }
        const int nig = WGM * nN, gid = wgid / nig, fm = gid * WGM, gsz = (nM - fm) < WGM ? (nM - fm) : WGM;
        u.pm = fm + ((wgid % nig) % gsz); u.pn = (wgid % nig) / gsz;
        const size_t ko = ((u.hm & 15) == 4) ? khalf : 0;
        u.a = A + (size_t)u.pm * astep + ((u.hm & 15) == 2 ? astep / 2 : 0) + ko; u.b = B + (size_t)u.pn * bstep + ko; u.c = C + (size_t)u.pm * cstep + (size_t)u.pn * BM * cesz;
        return true;
    }
};

template <class Epi, class Sched, bool ALIGN_EPI = true>
__device__ __forceinline__ void gemm_phase(LAS unsigned char* lds, const int wave0, const int lda, const int ldb, const int K, const Sched& S, const Epi& E) {
    const int lane = fresh_lane(), wid = fresh_wave(wave0), tid = wid * 64 + lane, wr = wid >> 2, wc = wid & 3, fr = lane & 15, fq = lane >> 4;
    const int nt = K / BK;
    unsigned voffA[2], voffB[2];
#pragma unroll
    for (int i = 0; i < 2; ++i) { int R, C; stage_rc(tid * 16 + i * 8192, R, C); const int Rb = Epi::PERM ? ((R & ~31) + perm32(R & 31)) : R;
        const int Ra = Epi::APERM ? (8 * (16 * (R >> 6) + (R & 15)) + ((R >> 4) & 3)) : R;
        voffA[i] = (unsigned)(Ra * lda + C) * 2u; voffB[i] = (unsigned)(Rb * ldb + C) * 2u; }
    const size_t kstep = (size_t)(BK * 2);
    const size_t hstepA = (size_t)(Epi::APERM ? 4 : HALF) * lda * 2, hstepB = (size_t)Sched::BH_ROWS * ldb * 2;
    const unsigned ldsw = (unsigned)wid * 1024u;
    const int aoff = lds_byte(wr * 64 + fr, fq * 8), boff = lds_byte(wc * 32 + fr, fq * 8);
#define PG8_SA(b, h) (((b) * 2 + (h)) * HTB)
#define PG8_SB(b, h) ((4 + (b) * 2 + (h)) * HTB)
#ifndef PG8_AUX_A
#define PG8_AUX_A 0
#endif
#ifndef PG8_AUX_B
#define PG8_AUX_B 0
#endif
#define PG8_STAGE(bufoff, gbase, voff) do { const GAS char* gb_ = (const GAS char*)(gbase); asm("" : "+s"(gb_));   _Pragma("unroll") for (int _i = 0; _i < 2; ++_i) { asm("" : "+v"((voff)[_i]));   \
        __builtin_amdgcn_global_load_lds((const GAS unsigned*)(gb_ + (voff)[_i]), (LAS unsigned*)(lds + (bufoff) + ldsw + _i * 8192), 16, 0, PG8_AUX_A); } } while (0)
#define PG8_STAGEB(bufoff, gbase, voff) do { const GAS char* gb_ = (const GAS char*)(gbase); asm("" : "+s"(gb_));   _Pragma("unroll") for (int _i = 0; _i < 2; ++_i) { asm("" : "+v"((voff)[_i]));   \
        __builtin_amdgcn_global_load_lds((const GAS unsigned*)(gb_ + (voff)[_i]), (LAS unsigned*)(lds + (bufoff) + ldsw + _i * 8192), 16, 0, PG8_AUX_B); } } while (0)
#define PG8_LDA(dst, b, h) do { _Pragma("unroll") for (int m = 0; m < 4; ++m) _Pragma("unroll") for (int k = 0; k < 2; ++k) dst[m][k] = *(const LAS bf16x8*)(lds + PG8_SA(b, h) + aoff + m * 2048 + k * 1024); } while (0)
#define PG8_LDB(dst, b, h) do { _Pragma("unroll") for (int n = 0; n < 2; ++n) _Pragma("unroll") for (int k = 0; k < 2; ++k) dst[n][k] = *(const LAS bf16x8*)(lds + PG8_SB(b, h) + boff + n * 2048 + k * 1024); } while (0)
#define PG8_MMA(ai, bj, At, Bt) do { __builtin_amdgcn_s_setprio(1); _Pragma("unroll") for (int m = 0; m < 4; ++m) _Pragma("unroll") for (int n = 0; n < 2; ++n) _Pragma("unroll") for (int k = 0; k < 2; ++k) \
        acc[ai][bj][m][n] = __builtin_amdgcn_mfma_f32_16x16x32_bf16(Bt[n][k], At[m][k], acc[ai][bj][m][n], 0, 0, 0); __builtin_amdgcn_s_setprio(0); } while (0)
#define PG8_WAIT_V(n) asm volatile("s_waitcnt vmcnt(" #n ")" ::: "memory")
#define PG8_WAIT_L(n) asm volatile("s_waitcnt lgkmcnt(" #n ")" ::: "memory")
#define PG8_BAR __builtin_amdgcn_s_barrier()
#define PG8_SCHED __builtin_amdgcn_sched_barrier(0)
    Unit cur, nxt; int ui = 0;
    if (!S.next(0, cur)) return;
    f32x4 acc[2][2][4][2];
#pragma unroll
    for (int a = 0; a < 2; ++a)
#pragma unroll
        for (int b = 0; b < 2; ++b)
#pragma unroll
            for (int m = 0; m < 4; ++m)
#pragma unroll
                for (int n = 0; n < 2; ++n) acc[a][b][m][n] = (f32x4){0.f, 0.f, 0.f, 0.f};
    bf16x8 At[4][2], B0[2][2], B1[2][2];
    const char* cA = cur.a; const char* cB = cur.b;
    PG8_STAGEB(PG8_SB(0, 0), cB, voffB); PG8_STAGEB(PG8_SB(0, 1), cB + hstepB, voffB); PG8_STAGE(PG8_SA(0, 0), cA, voffA); PG8_STAGE(PG8_SA(0, 1), cA + hstepA, voffA);
    if (wr == 1) PG8_BAR;
    PG8_WAIT_V(2); PG8_BAR;
    PG8_STAGEB(PG8_SB(1, 0), cB + kstep, voffB); PG8_STAGE(PG8_SA(1, 0), cA + kstep, voffA); PG8_STAGEB(PG8_SB(1, 1), cB + hstepB + kstep, voffB);
    PG8_WAIT_V(6); PG8_BAR;
    for (;;) {
        const bool has_next = S.next(ui + 1, nxt);
        const char* nA = has_next ? nxt.a : cA; const char* nB = has_next ? nxt.b : cB;
        const int hmode = cur.hm & 15;
        const bool full = (hmode == 0) || (hmode >= 3);
        int unt = nt; if constexpr (Sched::KSPLIT) { if (hmode == 3) unt = S.ktp; else if (hmode == 4) unt = nt - S.ktp; }
        float pf = 0.f;
        for (int t = 0; t < unt; t += 2) {
            const bool last = (t == unt - 2);
            const char* a1 = cA + (size_t)(t + 1) * kstep;
            const char* a2 = last ? nA : cA + (size_t)(t + 2) * kstep; const char* b2 = last ? nB : cB + (size_t)(t + 2) * kstep;
            const char* a3 = a2 + kstep; const char* b3 = b2 + kstep;
            if constexpr (Sched::MERGED) { if (last && has_next && (nxt.hm & 0x1000)) { S.wait_panel(nxt, wid); PG8_BAR; } }
            if constexpr (Epi::MIDK > 0) { if (t == Epi::MIDK) E.mid(acc, cur, wid); }
            if constexpr (Epi::PREF) { if (last) pf = E.prefetch(cur, tid); }
            PG8_LDB(B0, 0, 0); PG8_LDB(B1, 0, 1); PG8_SCHED; PG8_LDA(At, 0, 0); PG8_STAGE(PG8_SA(1, 1), a1 + hstepA, voffA);
            PG8_WAIT_V(8); PG8_WAIT_L(0); PG8_BAR; PG8_MMA(0, 0, At, B0); PG8_MMA(0, 1, At, B1); PG8_BAR; PG8_SCHED;
            if (full) PG8_LDA(At, 0, 1); PG8_STAGEB(PG8_SB(0, 0), b2, voffB); PG8_STAGEB(PG8_SB(0, 1), b2 + hstepB, voffB); PG8_STAGE(PG8_SA(0, 0), a2, voffA);
            PG8_WAIT_V(8); PG8_WAIT_L(0); PG8_BAR; if (full) { PG8_MMA(1, 0, At, B0); PG8_MMA(1, 1, At, B1); } PG8_BAR; PG8_SCHED;
            PG8_LDB(B0, 1, 0); PG8_LDB(B1, 1, 1); PG8_SCHED; PG8_LDA(At, 1, 0); PG8_STAGE(PG8_SA(0, 1), a2 + hstepA, voffA);
            PG8_WAIT_V(8); PG8_WAIT_L(0); PG8_BAR; PG8_MMA(0, 0, At, B0); PG8_MMA(0, 1, At, B1); PG8_BAR; PG8_SCHED;
            if (full) PG8_LDA(At, 1, 1); PG8_STAGEB(PG8_SB(1, 0), b3, voffB); PG8_STAGEB(PG8_SB(1, 1), b3 + hstepB, voffB); PG8_STAGE(PG8_SA(1, 0), a3, voffA);
            PG8_WAIT_V(8); PG8_WAIT_L(0); PG8_BAR; if (full) { PG8_MMA(1, 0, At, B0); PG8_MMA(1, 1, At, B1); } PG8_BAR; PG8_SCHED;
        }
        if constexpr (ALIGN_EPI) { if (wr == 0) PG8_BAR; }
        if constexpr (Epi::PREF) { static_assert(ALIGN_EPI, "the side-buffer exchange needs both halves in the epilogue together");
            *(LAS float*)(lds + STAGE_BYTES + tid * 4) = pf; PG8_WAIT_L(0); PG8_BAR; }
        if constexpr (Sched::KSPLIT) {
            if (hmode == 3) {
                E.produce(acc, cur, wid);
                PG8_WAIT_V(0); PG8_BAR;
                if (wid == 0 && fresh_lane() == 0) __hip_atomic_store((GAS unsigned*)(S.flags + (size_t)(cur.hm >> 4) * 16), 1u, __ATOMIC_RELAXED, __HIP_MEMORY_SCOPE_AGENT);
            } else {
                if (hmode == 4) {
                    if (wid == 0) { GAS unsigned* fp = (GAS unsigned*)(S.flags + (size_t)(cur.hm >> 4) * 16); unsigned sp = 0;
                        while ((unsigned)__builtin_amdgcn_readfirstlane(__hip_atomic_load(fp, __ATOMIC_RELAXED, __HIP_MEMORY_SCOPE_AGENT)) != 1u) { __builtin_amdgcn_s_sleep(2); if (++sp > (1u << 20)) break; }
                        __builtin_amdgcn_fence(__ATOMIC_ACQUIRE, "agent"); PG8_WAIT_V(0); }
                    PG8_BAR;
                }
                E(acc, cur, wid);
            }
        } else { E(acc, cur, wid);
            if constexpr (Sched::MERGED) { if (!(cur.hm & 0x1000)) { PG8_WAIT_V(0); if (fresh_lane() == 0) S.publish(cur); } } }
        if (!has_next) break;
#pragma unroll
        for (int a = 0; a < 2; ++a)
#pragma unroll
            for (int b = 0; b < 2; ++b)
#pragma unroll
                for (int m = 0; m < 4; ++m)
#pragma unroll
                    for (int n = 0; n < 2; ++n) acc[a][b][m][n] = (f32x4){0.f, 0.f, 0.f, 0.f};
        cur = nxt; cA = nA; cB = nB; ++ui;
        if constexpr (ALIGN_EPI) { if (wr == 1) PG8_BAR; }
    }
    PG8_WAIT_V(0);
    if constexpr (!ALIGN_EPI) { if (wr == 0) PG8_BAR; }
    PG8_BAR;
#undef PG8_SA
#undef PG8_SB
#undef PG8_STAGE
#undef PG8_STAGEB
#undef PG8_LDA
#undef PG8_LDB
#undef PG8_MMA
#undef PG8_WAIT_V
#undef PG8_WAIT_L
#undef PG8_BAR
#undef PG8_SCHED
}

typedef f32x4 Acc[2][2][4][2];

template <int LDC> struct EpiBf16U {
    static constexpr bool PERM = true, APERM = false; static constexpr int MIDK = 0; static constexpr bool PREF = false;
    __device__ __forceinline__ void operator()(const Acc& acc, const Unit& u, const int wid) const {
        const int lane = fresh_lane(), wr = wid >> 2, wc = wid & 3, fr = lane & 15, fq = lane >> 4;
        const unsigned loff = (unsigned)((wr * 64 + fr) * LDC + wc * 32 + 8 * fq) * 2u;
#pragma unroll
        for (int ai = 0; ai < 2; ++ai)
#pragma unroll
            for (int m = 0; m < 4; ++m) { char* rowp = u.c + (size_t)(ai * HALF + m * 16) * LDC * 2; asm("" : "+s"(rowp));
#pragma unroll
                for (int bj = 0; bj < 2; ++bj) { const f32x4 v0 = acc[ai][bj][m][0], v1 = acc[ai][bj][m][1];
                    u32x4 w; w.x = cvt_pk_bf16(v0[0], v0[1]); w.y = cvt_pk_bf16(v0[2], v0[3]); w.z = cvt_pk_bf16(v1[0], v1[1]); w.w = cvt_pk_bf16(v1[2], v1[3]);
                    *(GAS u32x4*)(rowp + loff + bj * HALF * 2) = w; } }
    }
};
struct EpiIn {
    static constexpr bool PERM = true, APERM = false; static constexpr int MIDK = 0; static constexpr bool PREF = true;
    float* outk; float* outv; int layer; const float* ss; const float* bias; const LAS float* side;
    __device__ __forceinline__ void produce(const Acc&, const Unit&, const int) const {}
    __device__ __forceinline__ float prefetch(const Unit& u, const int tid) const {
        const int bv = u.pm < NB_P ? 0 : 1 + ((u.pm - NB_P) >> 4);
        const float* p = tid < 256 ? ss + (size_t)u.pm * BM + tid : bias + (size_t)bv * IN_DIM + u.pn * BM + (tid - 256);
        return *(const GAS float*)p;
    }
    __device__ __forceinline__ void operator()(const Acc& acc, const Unit& u, const int wid) const {
        const int lane = fresh_lane(), wr = wid >> 2, wc = wid & 3, fr = lane & 15, fq = lane >> 4;
        const bool sig = u.pn >= 16, kv = (u.pm < NB_P) && (u.pn >= 4) && (u.pn < 12);
        const int r0 = wr * 64 + fr, c0 = wc * 32 + 8 * fq;
        const unsigned loff = (unsigned)(r0 * IN_DIM + c0) * 2u, koff = (unsigned)(r0 * HD + c0) * 4u;
        float rstd[2][4]; f32x4 bb[2][2];
        {
#pragma unroll
          for (int ai = 0; ai < 2; ++ai)
#pragma unroll
              for (int m = 0; m < 4; ++m) rstd[ai][m] = side[r0 + ai * HALF + m * 16];
#pragma unroll
          for (int bj = 0; bj < 2; ++bj)
#pragma unroll
              for (int n = 0; n < 2; ++n) bb[bj][n] = *(const LAS f32x4*)(side + 256 + c0 + bj * HALF + 4 * n);
#pragma unroll
          for (int ai = 0; ai < 2; ++ai)
#pragma unroll
              for (int m = 0; m < 4; ++m) rstd[ai][m] = rsqrtf(rstd[ai][m] * (1.0f / D) + RMS_EPS); }
#pragma unroll
        for (int ai = 0; ai < 2; ++ai)
#pragma unroll
            for (int m = 0; m < 4; ++m) { char* rowp = u.c + (size_t)(ai * HALF + m * 16) * IN_DIM * 2; asm("" : "+s"(rowp));
#pragma unroll
                for (int bj = 0; bj < 2; ++bj) { f32x4 v0 = acc[ai][bj][m][0] * rstd[ai][m] + bb[bj][0], v1 = acc[ai][bj][m][1] * rstd[ai][m] + bb[bj][1];
                    if (sig) {
#pragma unroll
                        for (int j = 0; j < 4; ++j) { v0[j] = sigmoidf_fast(v0[j]); v1[j] = sigmoidf_fast(v1[j]); } }
                    u32x4 w; w.x = cvt_pk_bf16(v0[0], v0[1]); w.y = cvt_pk_bf16(v0[2], v0[3]); w.z = cvt_pk_bf16(v1[0], v1[1]); w.w = cvt_pk_bf16(v1[2], v1[3]);
                    *(GAS u32x4*)(rowp + loff + bj * HALF * 2) = w;
                    if (kv) { const int colt = u.pn * BM + bj * HALF; const bool isv = colt >= 2048; const int head = (colt - (isv ? 2048 : 1024)) >> 7;
                        char* dst = (char*)((isv ? outv : outk) + ((((size_t)u.pm * DEPTH + layer) * NH + head) * SEQ_P + (ai * HALF + m * 16)) * HD); asm("" : "+s"(dst));
                        *(GAS f32x4*)(dst + koff) = v0; *(GAS f32x4*)(dst + koff + 16) = v1; } } }
    }
};
struct EpiPab {
    static constexpr bool PERM = true, APERM = false; static constexpr int MIDK = 16; static constexpr bool PREF = false;
    const bf16_t* G; bf16_t* Y;
    __device__ __forceinline__ void produce(const Acc&, const Unit&, const int) const {}
    __device__ __forceinline__ void mid(Acc& acc, const Unit& u, const int wid) const {
        const int lane = fresh_lane(), wr = wid >> 2, wc = wid & 3, fr = lane & 15, fq = lane >> 4;
        const unsigned goff = (unsigned)((wr * 64 + fr) * IN_DIM + wc * 32 + 8 * fq) * 2u;
        const int hb = (u.hm & 15) == 2 ? HALF : 0, na = ((u.hm & 15) == 1 || (u.hm & 15) == 2) ? 1 : 2;
#pragma unroll
        for (int ai = 0; ai < 2; ++ai) if (ai < na) {
#pragma unroll
            for (int mp = 0; mp < 2; ++mp) {
                u32x4 ga[2][2], gb[2][2];
#pragma unroll
                for (int mm = 0; mm < 2; ++mm) { const int m = 2 * mp + mm; const char* gp = (const char*)(G + (size_t)(u.pm * BM + hb + ai * HALF + m * 16) * IN_DIM + 4096 + u.pn * BM); asm("" : "+s"(gp));
#pragma unroll
                    for (int bj = 0; bj < 2; ++bj) { ga[mm][bj] = *(const GAS u32x4*)(gp + goff + bj * HALF * 2); gb[mm][bj] = *(const GAS u32x4*)(gp + goff + bj * HALF * 2 + 2048 * 2); } }
                asm volatile("" ::: "memory");
#pragma unroll
                for (int mm = 0; mm < 2; ++mm)
#pragma unroll
                    for (int bj = 0; bj < 2; ++bj)
#pragma unroll
                        for (int j = 0; j < 4; ++j) { const int m = 2 * mp + mm;
                            const float r0 = bf_lo(ga[mm][bj][j]) * __builtin_amdgcn_rcpf(fmaxf(bf_lo(gb[mm][bj][j]), 1e-30f)), r1 = bf_hi(ga[mm][bj][j]) * __builtin_amdgcn_rcpf(fmaxf(bf_hi(gb[mm][bj][j]), 1e-30f));
                            acc[ai][bj][m][j >> 1][2 * (j & 1)] *= r0; acc[ai][bj][m][j >> 1][2 * (j & 1) + 1] *= r1; }
            }
        }
    }
    __device__ __forceinline__ void operator()(const Acc& acc, const Unit& u, const int wid) const {
        const int lane = fresh_lane(), wr = wid >> 2, wc = wid & 3, fr = lane & 15, fq = lane >> 4;
        const unsigned goff = (unsigned)((wr * 64 + fr) * IN_DIM + wc * 32 + 8 * fq) * 2u, yoff = (unsigned)((wr * 64 + fr) * D + wc * 32 + 8 * fq) * 2u;
        const int hb = (u.hm & 15) == 2 ? HALF : 0, na = ((u.hm & 15) == 1 || (u.hm & 15) == 2) ? 1 : 2;
        u32x4 gb[2][4][2];
#pragma unroll
        for (int ai = 0; ai < 2; ++ai) if (ai < na)
#pragma unroll
            for (int m = 0; m < 4; ++m) { const char* gp = (const char*)(G + (size_t)(u.pm * BM + hb + ai * HALF + m * 16) * IN_DIM + 6144 + u.pn * BM); asm("" : "+s"(gp));
#pragma unroll
                for (int bj = 0; bj < 2; ++bj) gb[ai][m][bj] = *(const GAS u32x4*)(gp + goff + bj * HALF * 2); }
        asm volatile("" ::: "memory");
#pragma unroll
        for (int ai = 0; ai < 2; ++ai) if (ai < na)
#pragma unroll
            for (int m = 0; m < 4; ++m) { char* yp = (char*)(Y + (size_t)(u.pm * BM + hb + ai * HALF + m * 16) * D + u.pn * BM); asm("" : "+s"(yp));
#pragma unroll
                for (int bj = 0; bj < 2; ++bj) { const u32x4 g = gb[ai][m][bj]; const f32x4 v0 = acc[ai][bj][m][0], v1 = acc[ai][bj][m][1];
                    u32x4 w;
                    w.x = cvt_pk_bf16(v0[0] * fmaxf(bf_lo(g[0]), 1e-30f), v0[1] * fmaxf(bf_hi(g[0]), 1e-30f)); w.y = cvt_pk_bf16(v0[2] * fmaxf(bf_lo(g[1]), 1e-30f), v0[3] * fmaxf(bf_hi(g[1]), 1e-30f));
                    w.z = cvt_pk_bf16(v1[0] * fmaxf(bf_lo(g[2]), 1e-30f), v1[1] * fmaxf(bf_hi(g[2]), 1e-30f)); w.w = cvt_pk_bf16(v1[2] * fmaxf(bf_lo(g[3]), 1e-30f), v1[3] * fmaxf(bf_hi(g[3]), 1e-30f));
                    *(GAS u32x4*)(yp + yoff + bj * HALF * 2) = w; } }
    }
};
struct EpiRes {
    static constexpr bool PERM = true, APERM = false; static constexpr int MIDK = 0; static constexpr bool PREF = true;
    const float* xp; const float* xs; float* X; const float* mods_l; int gi; bool first; float* XO;
    bool emit; const float* gvec; const float* scl; float* ss; bf16_t* HBo;
    const LAS float* side;
    __device__ __forceinline__ float prefetch(const Unit& u, const int tid) const {
        const int bv = u.pm < NB_P ? 0 : 1 + ((u.pm - NB_P) >> 4);
        if (tid >= 256) return *(const GAS float*)(mods_l + ((size_t)bv * NMOD + gi) * D + u.pn * BM + (tid - 256));
        if (!emit) return 0.f;
        return *(const GAS float*)(gvec + u.pn * BM + tid) * (*(const GAS float*)(scl + (size_t)bv * NMOD * D + u.pn * BM + tid) + 1.0f);
    }
    __device__ __forceinline__ void produce(const Acc& acc, const Unit& u, const int wid) const {
        const int lane = fresh_lane(), wr = wid >> 2, wc = wid & 3, fr = lane & 15, fq = lane >> 4;
        const int r0 = wr * 64 + fr, c0 = wc * 32 + 8 * fq;
        const unsigned xoff = (unsigned)(r0 * D + c0) * 4u;
        const float* base = first ? (u.pm < NB_P ? xp : xs - (size_t)MP * D) : X;
        char* xt = (char*)(X + (size_t)u.pm * BM * D + u.pn * BM); asm("" : "+s"(xt));
        const __amdgpu_buffer_rsrc_t rs = __builtin_amdgcn_make_buffer_rsrc(xt, 0, 256 * D * 4, 0x00020000);
#pragma unroll
        for (int ai = 0; ai < 2; ++ai) {
            f32x4 b[4][2][2];
#pragma unroll
            for (int m = 0; m < 4; ++m) { const char* bp = (const char*)(base + (size_t)(u.pm * BM + ai * HALF + m * 16) * D + u.pn * BM); asm("" : "+s"(bp));
#pragma unroll
                for (int bj = 0; bj < 2; ++bj)
#pragma unroll
                    for (int n = 0; n < 2; ++n) b[m][bj][n] = *(const GAS f32x4*)(bp + xoff + (bj * HALF + n * 4) * 4); }
            asm volatile("" ::: "memory");
#pragma unroll
            for (int bj = 0; bj < 2; ++bj)
#pragma unroll
                for (int n = 0; n < 2; ++n) { const f32x4 gvx = *(const LAS f32x4*)(side + 256 + c0 + bj * HALF + n * 4);
#pragma unroll
                    for (int m = 0; m < 4; ++m) __builtin_amdgcn_raw_buffer_store_b128(__builtin_bit_cast(u32x4, b[m][bj][n] + gvx * acc[ai][bj][m][n]), rs, xoff, ((ai * HALF + m * 16) * D + bj * HALF + n * 4) * 4, 16); }
            asm volatile("" ::: "memory");
        }
    }
    __device__ __forceinline__ void operator()(const Acc& acc, const Unit& u, const int wid) const {
        const int lane = fresh_lane(), wr = wid >> 2, wc = wid & 3, fr = lane & 15, fq = lane >> 4;
        const int r0 = wr * 64 + fr, c0 = wc * 32 + 8 * fq;
        const unsigned xoff = (unsigned)(r0 * D + c0) * 4u, hoff = (unsigned)(r0 * D + c0) * 2u;
        const int hmode = u.hm & 15;
        const float* base = (first && hmode != 4) ? (u.pm < NB_P ? xp : xs - (size_t)MP * D) : X;
        float* XOu = XO; const bool em = emit;
        const int hb = hmode == 2 ? HALF : 0, na = (hmode == 1 || hmode == 2) ? 1 : 2;
#pragma unroll
        for (int ai = 0; ai < 2; ++ai) if (ai < na) {
            f32x4 b[4][2][2];
#pragma unroll
            for (int m = 0; m < 4; ++m) { const char* bp = (const char*)(base + (size_t)(u.pm * BM + hb + ai * HALF + m * 16) * D + u.pn * BM); asm("" : "+s"(bp));
#pragma unroll
                for (int bj = 0; bj < 2; ++bj)
#pragma unroll
                    for (int n = 0; n < 2; ++n) b[m][bj][n] = *(const GAS f32x4*)(bp + xoff + (bj * HALF + n * 4) * 4); }
            asm volatile("" ::: "memory");
#pragma unroll
            for (int bj = 0; bj < 2; ++bj)
#pragma unroll
                for (int n = 0; n < 2; ++n) { const f32x4 gvx = *(const LAS f32x4*)(side + 256 + c0 + bj * HALF + n * 4);
#pragma unroll
                    for (int m = 0; m < 4; ++m) { char* xq = (char*)(XOu + (size_t)(u.pm * BM + hb + ai * HALF + m * 16) * D + u.pn * BM); asm("" : "+s"(xq));
                        b[m][bj][n] = b[m][bj][n] + gvx * acc[ai][bj][m][n];
                        *(GAS f32x4*)(xq + xoff + (bj * HALF + n * 4) * 4) = b[m][bj][n]; } }
            if (em) {
#pragma unroll
                for (int m = 0; m < 4; ++m) { char* hq = (char*)(HBo + (size_t)(u.pm * BM + hb + ai * HALF + m * 16) * D + u.pn * BM); asm("" : "+s"(hq));
                    float q = 0.f;
#pragma unroll
                    for (int bj = 0; bj < 2; ++bj)
#pragma unroll
                        for (int n = 0; n < 2; ++n) { const f32x4 x = b[m][bj][n], h = x * *(const LAS f32x4*)(side + c0 + bj * HALF + n * 4); q += (x[0] * x[0] + x[1] * x[1]) + (x[2] * x[2] + x[3] * x[3]);
                            u32x2 w; w.x = cvt_pk_bf16(h[0], h[1]); w.y = cvt_pk_bf16(h[2], h[3]); *(GAS u32x2*)(hq + hoff + (bj * HALF + n * 4) * 2) = w; }
                    q += __int_as_float(__builtin_amdgcn_ds_bpermute((lane ^ 16) << 2, __float_as_int(q)));
                    q += __int_as_float(__builtin_amdgcn_ds_bpermute((lane ^ 32) << 2, __float_as_int(q)));
                    if (fq == 0) __hip_atomic_fetch_add((GAS float*)(ss + (size_t)(u.pm * BM + hb + ai * HALF + m * 16) + r0), q, __ATOMIC_RELAXED, __HIP_MEMORY_SCOPE_AGENT); }
            }
            asm volatile("" ::: "memory");
        }
    }
};
struct UpOrder {
    static constexpr int BH_ROWS = FFN; static constexpr bool KSPLIT = false, MERGED = false;
    int nM, nN, nwg, G, c; const char* A; const char* B; char* C;
    __device__ __forceinline__ void init(int G_, int c_, const void* A_, const void* B_, void* C_) { nM = M / BM; nN = FFN / 128; nwg = nM * nN; G = G_; c = c_; A = (const char*)A_; B = (const char*)B_; C = (char*)C_; }
    __device__ __forceinline__ bool next(int i, Unit& u) const {
        const long L = (long)i * G + c; if (L >= nwg) return false;
        int wgid = (int)L; { const int q = nwg / NXCD, r = nwg % NXCD, xcd = wgid % NXCD, off = wgid / NXCD; wgid = (xcd < r ? xcd * (q + 1) : r * (q + 1) + (xcd - r) * q) + off; }
        const int nig = WGM * nN, gid = wgid / nig, fm = gid * WGM, gsz = (nM - fm) < WGM ? (nM - fm) : WGM;
        u.pm = fm + ((wgid % nig) % gsz); u.pn = (wgid % nig) / gsz;
        u.a = A + (size_t)u.pm * BM * D * 2; u.b = B + (size_t)u.pn * 128 * D * 2; u.c = C + ((size_t)u.pm * BM * FFN + (size_t)u.pn * 128) * 2; u.hm = 0;
        return true;
    }
};
__device__ __forceinline__ float dpp_shr1(float v) { return __int_as_float(__builtin_amdgcn_update_dpp(0, __float_as_int(v), 0x111, 0xf, 0xf, true)); }
__device__ __forceinline__ float dpp_shl1(float v) { return __int_as_float(__builtin_amdgcn_update_dpp(0, __float_as_int(v), 0x101, 0xf, 0xf, true)); }
struct EpiUpConv {
    static constexpr bool PERM = true, APERM = true; static constexpr int MIDK = 0; static constexpr bool PREF = true;
    const float* cw; const float* cb; float* UH; const float* ss; const float* bias; const LAS float* side;
    __device__ __forceinline__ float prefetch(const Unit& u, const int tid) const {
        const int bv = u.pm < NB_P ? 0 : 1 + ((u.pm - NB_P) >> 4);
        const float* p = tid < 256 ? ss + (size_t)u.pm * BM + tid : bias + (size_t)bv * FFN2 + u.pn * 128 + (tid < 384 ? tid - 256 : FFN + tid - 384);
        return *(const GAS float*)p;
    }
    __device__ __forceinline__ void operator()(const Acc& acc, const Unit& u, const int wid) const {
        const int lane = fresh_lane(), wr = wid >> 2, wc = wid & 3, fr = lane & 15, fq = lane >> 4;
        const int q = 16 * wr + fr, ch0 = 32 * wc + 8 * fq;
        const char* wbase = (const char*)(cw + u.pn * 128); const char* bbase = (const char*)(cb + u.pn * 128); asm("" : "+s"(wbase), "+s"(bbase));
        const unsigned coff = (unsigned)ch0 * 4u;
        float rstd[8];
        { const f32x4 s0 = *(const LAS f32x4*)(side + 8 * q), s1 = *(const LAS f32x4*)(side + 8 * q + 4);
#pragma unroll
          for (int k = 0; k < 4; ++k) { rstd[k] = rsqrtf(s0[k] * (1.0f / D) + RMS_EPS); rstd[4 + k] = rsqrtf(s1[k] * (1.0f / D) + RMS_EPS); } }
        unsigned outp[8][4];
#pragma unroll
        for (int n = 0; n < 2; ++n) {
            const f32x4 wa0 = *(const GAS f32x4*)(wbase + coff + n * 16), wa1 = *(const GAS f32x4*)(wbase + coff + n * 16 + FFN2 * 4), wa2 = *(const GAS f32x4*)(wbase + coff + n * 16 + 2 * FFN2 * 4);
            const f32x4 wg0 = *(const GAS f32x4*)(wbase + coff + n * 16 + FFN * 4), wg1 = *(const GAS f32x4*)(wbase + coff + n * 16 + (FFN2 + FFN) * 4), wg2 = *(const GAS f32x4*)(wbase + coff + n * 16 + (2 * FFN2 + FFN) * 4);
            const f32x4 ba = *(const GAS f32x4*)(bbase + coff + n * 16), bg = *(const GAS f32x4*)(bbase + coff + n * 16 + FFN * 4);
            const f32x4 ua_b = *(const LAS f32x4*)(side + 256 + ch0 + 4 * n), ug_b = *(const LAS f32x4*)(side + 384 + ch0 + 4 * n);
            float keep[8];
#pragma unroll
            for (int e = 0; e < 4; ++e) {
                float ua[8], ug[8];
#pragma unroll
                for (int k = 0; k < 8; ++k) { ua[k] = acc[k >> 2][0][k & 3][n][e] * rstd[k] + ua_b[e]; ug[k] = acc[k >> 2][1][k & 3][n][e] * rstd[k] + ug_b[e]; }
                const float pa = dpp_shr1(ua[7]), na = dpp_shl1(ua[0]), pg = dpp_shr1(ug[7]), ng = dpp_shl1(ug[0]);
#pragma unroll
                for (int k = 0; k < 8; ++k) {
                    const float A = wa0[e] * (k ? ua[k - 1] : pa) + wa1[e] * ua[k] + wa2[e] * (k < 7 ? ua[k + 1] : na) + ba[e];
                    const float Gv = wg0[e] * (k ? ug[k - 1] : pg) + wg1[e] * ug[k] + wg2[e] * (k < 7 ? ug[k + 1] : ng) + bg[e];
                    const float o = Gv * sigmoidf_fast(Gv) * A;
                    if (e & 1) outp[k][2 * n + (e >> 1)] = cvt_pk_bf16(keep[k], o); else keep[k] = o;
                }
            }
        }
        char* cbase = u.c; asm("" : "+s"(cbase));
        const unsigned roff = (unsigned)(8 * q) * (unsigned)(FFN * 2) + (unsigned)ch0 * 2u;
#pragma unroll
        for (int k = 0; k < 8; ++k) {
            const bool skip = (k == 0 && fr == 0) || (k == 7 && fr == 15);
            if (!skip) { u32x4 w; w.x = outp[k][0]; w.y = outp[k][1]; w.z = outp[k][2]; w.w = outp[k][3]; *(GAS u32x4*)(cbase + roff + k * (FFN * 2)) = w; }
        }
        if (fr == 0 || fr == 15) {
            char* ub = (char*)(UH + ((size_t)u.pm * 8 + 4 * wr) * FFN2 + u.pn * 128); asm("" : "+s"(ub));
            const unsigned uoff = (unsigned)(fr == 15 ? 2 * FFN2 * 4 : 0) + coff;
#pragma unroll
            for (int kk = 0; kk < 2; ++kk)
#pragma unroll
                for (int n = 0; n < 2; ++n) {
                    const float rs = fr == 0 ? rstd[kk] : rstd[6 + kk];
                    const f32x4 ua_b = *(const LAS f32x4*)(side + 256 + ch0 + 4 * n), ug_b = *(const LAS f32x4*)(side + 384 + ch0 + 4 * n);
                    const f32x4 va = (fr == 0 ? acc[0][0][kk][n] : acc[1][0][2 + kk][n]) * rs + ua_b, vg = (fr == 0 ? acc[0][1][kk][n] : acc[1][1][2 + kk][n]) * rs + ug_b;
                    *(GAS f32x4*)(ub + uoff + kk * (FFN2 * 4) + n * 16) = va; *(GAS f32x4*)(ub + uoff + kk * (FFN2 * 4) + FFN * 4 + n * 16) = vg; }
        }
    }
};

struct PabOutOrder {
    static constexpr int BH_ROWS = 128; static constexpr bool KSPLIT = false, MERGED = true;
    int c; const char* AF; const char* Wpab; const char* YB; const char* Wout; unsigned* cnt;
    __device__ __forceinline__ bool next(int i, Unit& u) const {
        if (i >= 5) return false;
        const int xcd = c & 7, s = 32 * i + (c >> 3), kind = s >= 80, j = kind ? s - 80 : s;
        u.pm = 10 * xcd + (j >> 3); u.pn = j & 7; u.hm = kind ? 0x1000 : 0; u.c = nullptr;
        u.a = (kind ? YB : AF) + (size_t)u.pm * BM * D * 2; u.b = (kind ? Wout : Wpab) + (size_t)u.pn * BM * D * 2;
        return true;
    }
    __device__ __forceinline__ void publish(const Unit& u) const { __hip_atomic_fetch_add((GAS unsigned*)(cnt + u.pm * 16), 1u, __ATOMIC_RELAXED, __HIP_MEMORY_SCOPE_AGENT); }
    __device__ __forceinline__ void wait_panel(const Unit& u, const int wid) const {
        if (wid == 0) { GAS unsigned* fp = (GAS unsigned*)(cnt + u.pm * 16); unsigned sp = 0;
            while ((unsigned)__builtin_amdgcn_readfirstlane(__hip_atomic_load(fp, __ATOMIC_RELAXED, __HIP_MEMORY_SCOPE_AGENT)) < 64u) { __builtin_amdgcn_s_sleep(2); if (++sp > (1u << 20)) break; }
            __builtin_amdgcn_fence(__ATOMIC_ACQUIRE, "agent"); asm volatile("s_waitcnt vmcnt(0)" ::: "memory"); }
    }
};
struct EpiPabOut {
    static constexpr bool PERM = true, APERM = false; static constexpr int MIDK = 16; static constexpr bool PREF = true; static constexpr int NPF = 1;
    EpiPab P; EpiRes R;
    __device__ __forceinline__ void produce(const Acc&, const Unit&, const int) const {}
    __device__ __forceinline__ float prefetch(const Unit& u, const int tid) const { return (u.hm & 0x1000) ? R.prefetch(u, tid) : 0.f; }
    __device__ __forceinline__ void mid(Acc& acc, const Unit& u, const int wid) const { if (!(u.hm & 0x1000)) P.mid(acc, u, wid); }
    __device__ __forceinline__ void operator()(const Acc& acc, const Unit& u, const int wid) const { if (u.hm & 0x1000) R(acc, u, wid); else P(acc, u, wid); }
};
}

struct Buffers;
struct F1SOrder {
    static constexpr int BH_ROWS = 128; static constexpr bool KSPLIT = false, MERGED = false;
    int G, c; const char* DC; const char* QK; char* GTS;
    __device__ __forceinline__ bool next(int i, pg8::Unit& u) const {
        const int L = i * G + c; if (L >= 512) return false;
        const int bg = L >> 5, part = (L >> 4) & 1, nt = L & 15, b = bg >> 2, g = bg & 3;
        u.a = DC + (size_t)part * 256 * 256 * 2; u.b = QK + ((size_t)(MP + b * SEQ_S + nt * 256) * IN_DIM + 3072 + g * 256) * 2;
        u.c = GTS + ((size_t)bg * 256 * 8192 + part * 4096 + nt * 256) * 2; u.pm = part; u.pn = nt; u.hm = 0; return true;
    }
};
struct F1POrder {
    static constexpr int BH_ROWS = 128; static constexpr bool KSPLIT = false, MERGED = false;
    int G, c; const char* DC; const char* QK; char* GTP;
    __device__ __forceinline__ bool next(int i, pg8::Unit& u) const {
        const int L = i * G + c; if (L >= 128) return false;
        const int bg = L >> 1, part = L & 1, b = bg >> 2, g = bg & 3;
        u.a = DC + (size_t)part * 256 * 256 * 2; u.b = QK + ((size_t)(b * SEQ_P) * IN_DIM + 3072 + g * 256) * 2;
        u.c = GTP + ((size_t)bg * 256 * 512 + part * 256) * 2; u.pm = part; u.pn = 0; u.hm = 0; return true;
    }
};
struct F2SOrder {
    static constexpr int BH_ROWS = 128; static constexpr bool KSPLIT = false, MERGED = false;
    int G, c; const char* DS; const char* U2; char* AF;
    __device__ __forceinline__ bool next(int i, pg8::Unit& u) const {
        const int L = i * G + c; if (L >= 256) return false;
        const int bg = L >> 4, k2 = L & 15, b = bg >> 2, g = bg & 3;
        u.a = DS; u.b = U2 + (size_t)(bg * 16 + k2) * 256 * 512 * 2;
        u.c = AF + ((size_t)(MP + b * SEQ_S + k2) * D + 1024 + g * 256) * 2; u.pm = k2; u.pn = 0; u.hm = 0; return true;
    }
};
struct F2POrder {
    static constexpr int BH_ROWS = 128; static constexpr bool KSPLIT = false, MERGED = false;
    int G, c; const char* DP; const char* GTP; char* AF;
    __device__ __forceinline__ bool next(int i, pg8::Unit& u) const {
        const int L = i * G + c; if (L >= 64) return false;
        const int bg = L, b = bg >> 2, g = bg & 3;
        u.a = DP; u.b = GTP + (size_t)bg * 256 * 512 * 2; u.c = AF + ((size_t)(b * SEQ_P) * D + 1024 + g * 256) * 2; u.pm = 0; u.pn = 0; u.hm = 0; return true;
    }
};

namespace att {
#define KSWZ(row, colB) ((row) * 256 + ((colB) ^ (((row) & 7) << 4)))
__device__ __forceinline__ int crow(int r, int hi) { return (r & 3) + 8 * (r >> 2) + 4 * hi; }
__device__ __forceinline__ int v_st(int k, int c) { const int kk = (k & ~0xC) | ((k & 4) << 1) | ((k & 8) >> 1); return ((kk >> 3) * 4 + (c >> 5)) * 512 + ((kk & 7) * 32 + (c & 31)) * 2; }
__device__ __forceinline__ int v_rd_base(int lane) { return ((lane & 3) << 3) | (((lane >> 2) & 3) << 6) | (((lane >> 4) & 1) << 5) | (((lane >> 5) & 1) << 8); }
constexpr int v_rd_off(int d0, int ks, int half) { return d0 * 512 + ks * 4096 + half * 2048; }
template <int OFF> __device__ __forceinline__ s16x4 tr_read(int vb) { s16x4 r; asm volatile("ds_read_b64_tr_b16 %0, %1 offset:%2" : "=&v"(r) : "v"(vb), "i"(OFF) : "memory"); return r; }
template <int D0> __device__ __forceinline__ void pv_one(f32x16& od, int vb, bf16x8 pa0, bf16x8 pa1, bf16x8 pa2, bf16x8 pa3) {
    const s16x4 l0 = tr_read<v_rd_off(D0, 0, 0)>(vb), h0 = tr_read<v_rd_off(D0, 0, 1)>(vb), l1 = tr_read<v_rd_off(D0, 1, 0)>(vb), h1 = tr_read<v_rd_off(D0, 1, 1)>(vb);
    const s16x4 l2 = tr_read<v_rd_off(D0, 2, 0)>(vb), h2 = tr_read<v_rd_off(D0, 2, 1)>(vb), l3 = tr_read<v_rd_off(D0, 3, 0)>(vb), h3 = tr_read<v_rd_off(D0, 3, 1)>(vb);
    asm volatile("s_waitcnt lgkmcnt(0)" ::: "memory"); __builtin_amdgcn_sched_barrier(0);
#define ATT_PK(L, H) (bf16x8){L[0], L[1], L[2], L[3], H[0], H[1], H[2], H[3]}
    od = __builtin_amdgcn_mfma_f32_32x32x16_bf16(pa0, ATT_PK(l0, h0), od, 0, 0, 0);
    od = __builtin_amdgcn_mfma_f32_32x32x16_bf16(pa1, ATT_PK(l1, h1), od, 0, 0, 0);
    od = __builtin_amdgcn_mfma_f32_32x32x16_bf16(pa2, ATT_PK(l2, h2), od, 0, 0, 0);
    od = __builtin_amdgcn_mfma_f32_32x32x16_bf16(pa3, ATT_PK(l3, h3), od, 0, 0, 0);
#undef ATT_PK
}
constexpr int SHM_V = 64 * 128 * 2, SHM_K = 64 * 128 * 2;
constexpr int L_V = 0, L_K = 2 * SHM_V, L_WS = 2 * SHM_V + 2 * SHM_K, L_TAB = L_WS + NWAVES * 64 * 4, L_END = L_TAB + 15 * 128 * 4;
static_assert(L_END <= 131072, "attention LDS");

struct TileSrc { const bf16_t* K0; const bf16_t* V0; int ld0, nt0; const bf16_t* K1; const bf16_t* V1; int ld1, nt1; };

template <bool NA>
__device__ __forceinline__ void attn_unit(LAS char* lds, const int wave0, const bf16_t* Qb, int ldq, const TileSrc T, int kr0, int qrow0, const float* rpb, bf16_t* Ob, int ldo) {
    const int lane = fresh_lane(), wid = fresh_wave(wave0), tid = wid * 64 + lane, r32 = lane & 31, hi = lane >> 5;
    LAS char* V_lds = lds + L_V; LAS char* K_lds = lds + L_K;
    LAS float* ws = (LAS float*)(lds + L_WS) + wid * 64; LAS float* li_l = ws; LAS float* al_l = ws + 32;
    LAS float* tab = (LAS float*)(lds + L_TAB);
    float m_reg = -1e30f, l_reg = 0.f; f32x16 o[4];
#pragma unroll
    for (int d = 0; d < 4; ++d)
#pragma unroll
        for (int r = 0; r < 16; ++r) o[d][r] = 0.f;
    bf16x8 qr[8];
    { const bf16_t* Qw = Qb + (size_t)(wid * 32 + r32) * ldq + hi * 8;
#pragma unroll
      for (int d0 = 0; d0 < 8; ++d0) qr[d0] = *(const GAS bf16x8*)(Qw + d0 * 16); }
    if (NA) { for (int idx = tid; idx < 15 * 128; idx += NTHREADS) { const int dr7 = idx >> 7, dcc = (idx & 127) - 63;
                  tab[idx] = (dcc >= -15 && dcc <= 15) ? ((const GAS float*)rpb)[dr7 * 31 + dcc + 15] * LOG2E : 0.f; } }
    const int sr = tid >> 4, sc = (tid & 15) * 8, vst0 = v_st(sr, sc), vst1 = v_st(32 + sr, sc), kst0 = KSWZ(sr, sc * 2), kst1 = KSWZ(32 + sr, sc * 2);
    const int vb0 = (int)(uintptr_t)(V_lds) + v_rd_base(lane);
    const int NT = T.nt0 + T.nt1;
    bf16x8 vs0, vs1, ks0, ks1;
#define ATT_SLOAD(t) do { const bool g0 = (t) < T.nt0; const int tt = g0 ? (t) : (t) - T.nt0; const int ld = g0 ? T.ld0 : T.ld1; \
        const bf16_t* Kp = (g0 ? T.K0 : T.K1) + (size_t)tt * 64 * ld; const bf16_t* Vp = (g0 ? T.V0 : T.V1) + (size_t)tt * 64 * ld; \
        vs0 = *(const GAS bf16x8*)(Vp + (size_t)sr * ld + sc); vs1 = *(const GAS bf16x8*)(Vp + (size_t)(32 + sr) * ld + sc); \
        ks0 = *(const GAS bf16x8*)(Kp + (size_t)sr * ld + sc); ks1 = *(const GAS bf16x8*)(Kp + (size_t)(32 + sr) * ld + sc); } while (0)
#define ATT_SWRITE(b) do { *(LAS bf16x8*)(V_lds + (b) * SHM_V + vst0) = vs0; *(LAS bf16x8*)(V_lds + (b) * SHM_V + vst1) = vs1; \
        *(LAS bf16x8*)(K_lds + (b) * SHM_K + kst0) = ks0; *(LAS bf16x8*)(K_lds + (b) * SHM_K + kst1) = ks1; } while (0)
    ATT_SLOAD(0); ATT_SWRITE(0);
    __syncthreads();
    const int qrow = qrow0 + (wid >> 1), qc = 32 * (wid & 1) + r32;
    const int r0w = min(max(qrow - 4, 0), GW - 8), c0 = min(max(qc - 8, 0), GW - 16);
    for (int t = 0; t < NT; ++t) {
        const int buf = t & 1;
        if (t + 1 < NT) ATT_SLOAD(t + 1);
        bool active = true; int dr = 0;
        if (NA && t >= T.nt0) { const int kr = kr0 + (t - T.nt0); active = (kr >= r0w) && (kr < r0w + 8); dr = kr - qrow; }
        if (active) {
            f32x16 p0, p1;
#pragma unroll
            for (int r = 0; r < 16; ++r) { p0[r] = 0.f; p1[r] = 0.f; }
            { LAS const char* Ks = K_lds + buf * SHM_K;
              __builtin_amdgcn_s_setprio(1);
#pragma unroll
              for (int d0 = 0; d0 < 8; ++d0) { const int cb = (d0 * 16 + hi * 8) * 2;
                  const bf16x8 b0 = *(LAS const bf16x8*)(Ks + KSWZ(r32, cb)); const bf16x8 b1 = *(LAS const bf16x8*)(Ks + KSWZ(32 + r32, cb));
                  p0 = __builtin_amdgcn_mfma_f32_32x32x16_bf16(b0, qr[d0], p0, 0, 0, 0); p1 = __builtin_amdgcn_mfma_f32_32x32x16_bf16(b1, qr[d0], p1, 0, 0, 0); }
              __builtin_amdgcn_s_setprio(0); }
            if (NA && t >= T.nt0) {
                LAS const float* brow = tab + (dr + 7) * 128 + 63 - qc + 4 * hi;
#pragma unroll
                for (int r = 0; r < 16; ++r) { const int kq = (r & 3) + 8 * (r >> 2); const int kc = kq + 4 * hi;
                    const float b0 = brow[kq], b1 = brow[kq + 32];
                    p0[r] = ((unsigned)(kc - c0) < 16u) ? p0[r] + b0 : -INFINITY; p1[r] = ((unsigned)(kc + 32 - c0) < 16u) ? p1[r] + b1 : -INFINITY; }
            }
            float pmax = p0[0];
#pragma unroll
            for (int r = 1; r < 16; ++r) pmax = fmaxf(pmax, p0[r]);
#pragma unroll
            for (int r = 0; r < 16; ++r) pmax = fmaxf(pmax, p1[r]);
            { auto rr = __builtin_amdgcn_permlane32_swap(__float_as_uint(pmax), __float_as_uint(pmax), false, false); pmax = fmaxf(__uint_as_float(rr[0]), __uint_as_float(rr[1])); }
            const float mn = fmaxf(m_reg, pmax), alpha = __builtin_amdgcn_exp2f(m_reg - mn); m_reg = mn;
            float ps = 0.f;
#pragma unroll
            for (int r = 0; r < 16; ++r) { p0[r] = __builtin_amdgcn_exp2f(p0[r] - mn); p1[r] = __builtin_amdgcn_exp2f(p1[r] - mn); ps += p0[r] + p1[r]; }
            { auto rr = __builtin_amdgcn_permlane32_swap(__float_as_uint(ps), __float_as_uint(ps), false, false); ps = __uint_as_float(rr[0]) + __uint_as_float(rr[1]); }
            l_reg = l_reg * alpha + ps;
            bf16x8 pa0, pa1, pa2, pa3;
#define ATT_PK4(P, BASE, OUT) do { unsigned a0 = cvt_pk_bf16(P[BASE + 0], P[BASE + 1]), a1 = cvt_pk_bf16(P[BASE + 2], P[BASE + 3]);   \
    unsigned b0 = cvt_pk_bf16(P[BASE + 4], P[BASE + 5]), b1 = cvt_pk_bf16(P[BASE + 6], P[BASE + 7]);                              \
    auto r0_ = __builtin_amdgcn_permlane32_swap(a0, b0, false, false); auto r1_ = __builtin_amdgcn_permlane32_swap(a1, b1, false, false); \
    u32x4 w_ = {r0_[0], r1_[0], r0_[1], r1_[1]}; OUT = *reinterpret_cast<bf16x8*>(&w_); } while (0)
            ATT_PK4(p0, 0, pa0); ATT_PK4(p0, 8, pa1); ATT_PK4(p1, 0, pa2); ATT_PK4(p1, 8, pa3);
#undef ATT_PK4
            if (__any(alpha < 1.f)) { if (hi == 0) al_l[r32] = alpha; asm volatile("s_waitcnt lgkmcnt(0)" ::: "memory");
#pragma unroll
                for (int r = 0; r < 16; ++r) { const float a = al_l[crow(r, hi)];
#pragma unroll
                    for (int d = 0; d < 4; ++d) o[d][r] *= a; } }
            const int vb = vb0 + buf * SHM_V;
            __builtin_amdgcn_s_setprio(1);
            pv_one<0>(o[0], vb, pa0, pa1, pa2, pa3); pv_one<1>(o[1], vb, pa0, pa1, pa2, pa3); pv_one<2>(o[2], vb, pa0, pa1, pa2, pa3); pv_one<3>(o[3], vb, pa0, pa1, pa2, pa3);
            __builtin_amdgcn_s_setprio(0);
        }
        if (t + 1 < NT) ATT_SWRITE(buf ^ 1);
        __syncthreads();
    }
#undef ATT_SLOAD
#undef ATT_SWRITE
    if (hi == 0) li_l[r32] = l_reg;
    asm volatile("s_waitcnt lgkmcnt(0)" ::: "memory");
    bf16_t* Ow = Ob + (size_t)(wid * 32) * ldo;
#pragma unroll
    for (int r = 0; r < 16; ++r) { const int orow = crow(r, hi); const float rl = __builtin_amdgcn_rcpf(li_l[orow]);
#pragma unroll
        for (int d0 = 0; d0 < 4; ++d0) ((GAS bf16_t*)Ow)[(size_t)orow * ldo + d0 * 32 + r32] = (bf16_t)(cvt_pk_bf16(o[d0][r] * rl, 0.f) & 0xffffu); }
    __syncthreads();
}
}

__device__ __forceinline__ void dft4(float& r0, float& i0, float& r1, float& i1, float& r2, float& i2, float& r3, float& i3) {
    const float t0r = r0 + r2, t0i = i0 + i2, t1r = r0 - r2, t1i = i0 - i2, t2r = r1 + r3, t2i = i1 + i3, t3r = r1 - r3, t3i = i1 - i3;
    r0 = t0r + t2r; i0 = t0i + t2i; r2 = t0r - t2r; i2 = t0i - t2i; r1 = t1r + t3i; i1 = t1i - t3r; r3 = t1r - t3i; i3 = t1i + t3r;
}
__device__ __forceinline__ void fft16(float (&xr)[16], float (&xi)[16]) {
#pragma unroll
    for (int nb = 0; nb < 4; ++nb) dft4(xr[nb], xi[nb], xr[4 + nb], xi[4 + nb], xr[8 + nb], xi[8 + nb], xr[12 + nb], xi[12 + nb]);
    constexpr float C1 = 0.92387953251128674f, S1 = 0.38268343236508977f, R2 = 0.70710678118654752f;
    constexpr float TC[10] = {1.f, C1, R2, S1, 0.f, 0.f, -R2, 0.f, 0.f, -C1};
    constexpr float TS[10] = {0.f, S1, R2, C1, 1.f, 0.f, R2, 0.f, 0.f, -S1};
#pragma unroll
    for (int nb = 1; nb < 4; ++nb)
#pragma unroll
        for (int ka = 1; ka < 4; ++ka) { const float c = TC[nb * ka], sn = TS[nb * ka]; const float ar = xr[4 * ka + nb], ai = xi[4 * ka + nb];
            xr[4 * ka + nb] = ar * c + ai * sn; xi[4 * ka + nb] = ai * c - ar * sn; }
#pragma unroll
    for (int ka = 0; ka < 4; ++ka) dft4(xr[4 * ka], xi[4 * ka], xr[4 * ka + 1], xi[4 * ka + 1], xr[4 * ka + 2], xi[4 * ka + 2], xr[4 * ka + 3], xi[4 * ka + 3]);
}

struct Args { const float* in[20]; float* out; unsigned char* ws; };
enum { I_XP = 0, I_XS, I_CK, I_CV, I_C, I_CCTX, I_WMOD, I_BMOD, I_N1G, I_WIN, I_RPB, I_WPA, I_WPB, I_WOUT, I_N2G, I_WUP, I_CONVW, I_CONVB, I_WDOWN, I_NFG };

__device__ __forceinline__ void transpose_item(const float* W, int K, int N, bf16_t* WT, int ldt, int nsc, float sc, LAS float* scr, int item, int lane) {
    const int nblk = N >> 6, kb = item / nblk, nb = item - kb * nblk, k0 = kb << 6, n0 = nb << 6;
    f32x4 v[16];
    const float* src = W + (size_t)(k0 + (lane >> 4)) * N + n0 + 4 * (lane & 15);
#pragma unroll
    for (int i = 0; i < 16; ++i) v[i] = *(const f32x4*)(src + (size_t)(4 * i) * N);
#pragma unroll
    for (int i = 0; i < 16; ++i) { LAS float* d = scr + (4 * i + (lane >> 4)) * 65 + 4 * (lane & 15); d[0] = v[i][0]; d[1] = v[i][1]; d[2] = v[i][2]; d[3] = v[i][3]; }
    LDS_WAIT(); asm volatile("" ::: "memory");
    const int c = lane & 7;
#pragma unroll
    for (int j = 0; j < 8; ++j) { const int n = (lane >> 3) + 8 * j; const LAS float* s = scr + (8 * c) * 65 + n; const float f = (n0 + n) < nsc ? sc : 1.0f;
        u32x4 o; o.x = cvt_pk_bf16(s[0 * 65] * f, s[1 * 65] * f); o.y = cvt_pk_bf16(s[2 * 65] * f, s[3 * 65] * f); o.z = cvt_pk_bf16(s[4 * 65] * f, s[5 * 65] * f); o.w = cvt_pk_bf16(s[6 * 65] * f, s[7 * 65] * f);
        *(u32x4*)(WT + (size_t)(n0 + n) * ldt + k0 + 8 * c) = o; }
    LDS_WAIT(); asm volatile("" ::: "memory");
}

__global__ void __launch_bounds__(NTHREADS, 2) fwd(Args args) {
    extern __shared__ __attribute__((aligned(16))) unsigned char lds_raw[];
    LAS unsigned char* lds = (LAS unsigned char*)lds_raw;
    volatile LAS unsigned* MISC = (volatile LAS unsigned*)(lds + MISC_OFF);
    const int G = gridDim.x, bx = blockIdx.x;
    const int vcu = (G % 8 == 0) ? (bx % 8) * (G / 8) + bx / 8 : bx;
    const int NGW = G * NWAVES;
    const int wave0 = __builtin_amdgcn_readfirstlane((int)threadIdx.x >> 6);
#define OPQ_BX() unsigned mo_ = MISC_OFF + 16; asm volatile("; opaque LDS offset" : "+v"(mo_)); int bxo_ = __builtin_amdgcn_readfirstlane((int)*(volatile LAS unsigned*)(lds + mo_)); asm volatile("; opaque virtual block index" : "+s"(bxo_)); const int bx = bxo_
#define PIN_TID() const int lane = fresh_lane(), wave = fresh_wave(wave0), tid = wave * 64 + lane, gw = vcu * NWAVES + wave; (void)gw; (void)tid
    { const int tid = threadIdx.x; if (tid < 64) MISC[tid] = 0u; }
    unsigned char* ws = args.ws;
    __syncthreads();
    XcdBarrier bar = xcd_barrier_post((unsigned*)(ws + WS_CTL) + CW_BAR, MISC);
    if (threadIdx.x == 0) { const unsigned xcc = xb_xcc_id(); MISC[2] = xcc; MISC[3] = xb_add((unsigned*)(ws + WS_CTL) + CW_XRANK + 64 * xcc, 1u); MISC[4] = blockIdx.x; }
#define GRID_BAR() do { XcdBarrier b_ = bar; asm volatile("; pin bar" : "+s"(b_.bar), "+s"(b_.x)); const bool ldr_ = (fresh_wave(wave0) == 0) && (fresh_lane() == 0); for (int rb_ = 0; rb_ < REP_BAR; ++rb_) xcd_barrier(b_, ldr_); } while (0)

    float* X = args.out;
    float* OUTK = args.out + (size_t)M * D; float* OUTV = OUTK + (size_t)NB_P * DEPTH * NH * SEQ_P * HD;
    float* MODS = (float*)(ws + WS_MODS); float* SS = (float*)(ws + WS_SS); float* BIN = (float*)(ws + WS_BIAS); float* BUP = BIN + (size_t)DEPTH * 5 * IN_DIM;
    bf16_t* CKB = (bf16_t*)(ws + WS_CACHE); bf16_t* CVB = CKB + (size_t)NB_S * DEPTH * NH * PAST * HD;
    bf16_t* DC = (bf16_t*)(ws + WS_DC); bf16_t* DP = (bf16_t*)(ws + WS_DP); bf16_t* DS = (bf16_t*)(ws + WS_DS); bf16_t* U2 = (bf16_t*)(ws + WS_UP2);
    bf16_t* HB = (bf16_t*)(ws + WS_H); bf16_t* QK = (bf16_t*)(ws + WS_BIG); float* UH = (float*)(ws + WS_UH);
    bf16_t* AF = (bf16_t*)(ws + WS_AF); bf16_t* GTS = (bf16_t*)(ws + WS_GTS); bf16_t* GTP = (bf16_t*)(ws + WS_GTP);
    float* T1 = (float*)(ws + WS_T1); bf16_t* ACT = (bf16_t*)(ws + WS_ACT); bf16_t* YB = (bf16_t*)(ws + WS_Y);

    for (int rep_ = 0; rep_ < REP_P0; ++rep_) {
        PIN_TID();
#if EN_MODS
        for (int item = bx; item < DEPTH * 48; item += G) {
            const int l = item / 48, nb = item % 48;
            LAS float* sil = (LAS float*)lds; LAS float* red = (LAS float*)(lds + 5 * D * 4);
            for (int idx = tid; idx < 5 * D; idx += NTHREADS) { const int v = idx / D, k = idx % D; const float cv = v == 0 ? args.in[I_CCTX][k] : args.in[I_C][(size_t)(v - 1) * D + k];
                sil[idx] = cv * sigmoidf_fast(cv); }
            __syncthreads();
            f32x4 a5[5];
#pragma unroll
            for (int v = 0; v < 5; ++v) a5[v] = (f32x4){0.f, 0.f, 0.f, 0.f};
            const float* Wp = args.in[I_WMOD] + ((size_t)l * D + wave * 256) * (NMOD * D) + 256 * nb + 4 * lane;
            for (int k8 = 0; k8 < 256; k8 += 8) {
                f32x4 wv[8];
#pragma unroll
                for (int j = 0; j < 8; ++j) wv[j] = *(const f32x4*)(Wp + (size_t)(k8 + j) * (NMOD * D));
#pragma unroll
                for (int j = 0; j < 8; ++j)
#pragma unroll
                    for (int v = 0; v < 5; ++v) a5[v] += sil[v * D + wave * 256 + k8 + j] * wv[j];
            }
#pragma unroll
            for (int v = 0; v < 5; ++v) *(LAS f32x4*)(red + (wave * 5 + v) * 256 + 4 * lane) = a5[v];
            __syncthreads();
            for (int o = tid; o < 5 * 256; o += NTHREADS) { const int v = o >> 8, n = o & 255; float s = args.in[I_BMOD][(size_t)l * NMOD * D + 256 * nb + n];
#pragma unroll
                for (int w = 0; w < 8; ++w) s += red[(w * 5 + v) * 256 + n];
                MODS[((size_t)l * 5 + v) * (NMOD * D) + 256 * nb + n] = s; }
            __syncthreads();
        }
#endif
#if EN_WT
        {
            LAS float* scr = (LAS float*)(lds + wave * (64 * 65 * 4));
            constexpr int I_IN = (D / 64) * (IN_DIM / 64), I_PA = (AD / 64) * (D / 64), I_PB = (FD / 64) * (D / 64), I_OUT = (D / 64) * (D / 64), I_UP = (D / 64) * (FFN2 / 64), I_DOWN = (FFN / 64) * (D / 64);
            constexpr int PER_LAYER = I_IN + I_PA + I_PB + I_OUT + I_UP + I_DOWN;
            for (int it = gw; it < DEPTH * PER_LAYER; it += NGW) {
                const int l = it / PER_LAYER; int r = it - l * PER_LAYER;
                bf16_t* wt = (bf16_t*)(ws + WS_WT + (size_t)l * WT_LAYER);
                if (r < I_IN) { transpose_item(args.in[I_WIN] + (size_t)l * D * IN_DIM, D, IN_DIM, wt + WT_IN / 2, D, AD, QSCALE, scr, r, lane); continue; } r -= I_IN;
                if (r < I_PA) { transpose_item(args.in[I_WPA] + (size_t)l * AD * D, AD, D, wt + WT_PA / 2, AD + FD, 0, 1.f, scr, r, lane); continue; } r -= I_PA;
                if (r < I_PB) { transpose_item(args.in[I_WPB] + (size_t)l * FD * D, FD, D, wt + WT_PA / 2 + AD, AD + FD, 0, 1.f, scr, r, lane); continue; } r -= I_PB;
                if (r < I_OUT) { transpose_item(args.in[I_WOUT] + (size_t)l * D * D, D, D, wt + WT_OUT / 2, D, 0, 1.f, scr, r, lane); continue; } r -= I_OUT;
                if (r < I_UP) { transpose_item(args.in[I_WUP] + (size_t)l * D * FFN2, D, FFN2, wt + WT_UP / 2, D, 0, 1.f, scr, r, lane); continue; } r -= I_UP;
                transpose_item(args.in[I_WDOWN] + (size_t)l * FFN * D, FFN, D, wt + WT_DOWN / 2, FFN, 0, 1.f, scr, r, lane);
            }
        }
#endif
#if EN_MISC
        {
            const size_t n8 = (size_t)NB_S * DEPTH * NH * PAST * HD / 8;
            for (size_t i = (size_t)gw * 64 + lane; i < 2 * n8; i += (size_t)NGW * 64) { const bool isk = i < n8; const size_t j = isk ? i : i - n8;
                const float* s = (isk ? args.in[I_CK] : args.in[I_CV]) + j * 8; const f32x4 a = *(const f32x4*)s, b = *(const f32x4*)(s + 4);
                u32x4 w; w.x = cvt_pk_bf16(a[0], a[1]); w.y = cvt_pk_bf16(a[2], a[3]); w.z = cvt_pk_bf16(b[0], b[1]); w.w = cvt_pk_bf16(b[2], b[3]);
                *(u32x4*)((isk ? CKB : CVB) + j * 8) = w; }
        }
        {
            for (int i = gw * 64 + lane; i < 512 * 256 / 8; i += NGW * 64) { const int j = i >> 5, c0 = (i & 31) * 8; const bool isin = j >= 256; const int jj = j & 255;
                float v[8];
#pragma unroll
                for (int e = 0; e < 8; ++e) { const int mm = (jj * (c0 + e)) & 255; const float x = (float)mm * (1.0f / 128.0f); v[e] = (isin ? -sinpif(x) : cospif(x)) * (1.0f / 16.0f); }
                u32x4 w; w.x = cvt_pk_bf16(v[0], v[1]); w.y = cvt_pk_bf16(v[2], v[3]); w.z = cvt_pk_bf16(v[4], v[5]); w.w = cvt_pk_bf16(v[6], v[7]);
                *(u32x4*)(DC + (size_t)j * 256 + c0) = w; }
            for (int i = gw * 64 + lane; i < 256 * 512 / 8; i += NGW * 64) { const int k1 = i >> 6, c8 = (i & 63) * 8; const bool isin = c8 >= 256; const int n0 = c8 & 255;
                float v[8];
#pragma unroll
                for (int e = 0; e < 8; ++e) { const int mm = (k1 * (n0 + e)) & 255; const float x = (float)mm * (1.0f / 128.0f); v[e] = (isin ? sinpif(x) : cospif(x)) * (1.0f / 16.0f); }
                u32x4 w; w.x = cvt_pk_bf16(v[0], v[1]); w.y = cvt_pk_bf16(v[2], v[3]); w.z = cvt_pk_bf16(v[4], v[5]); w.w = cvt_pk_bf16(v[6], v[7]);
                *(u32x4*)(DP + (size_t)k1 * 512 + c8) = w;
                w.x = cvt_pk_bf16(v[0] * 0.25f, v[1] * 0.25f); w.y = cvt_pk_bf16(v[2] * 0.25f, v[3] * 0.25f); w.z = cvt_pk_bf16(v[4] * 0.25f, v[5] * 0.25f); w.w = cvt_pk_bf16(v[6] * 0.25f, v[7] * 0.25f);
                *(u32x4*)(DS + (size_t)k1 * 512 + c8) = w; }
        }
#endif
    }
    GRID_BAR();

    if (threadIdx.x == 0) {
        unsigned* rk = (unsigned*)(ws + WS_CTL) + CW_XRANK; const unsigned xcc = MISC[2], myrank = MISC[3]; unsigned npop = 0, xidx = 0; bool ok = (G % 8) == 0;
        for (unsigned j = 0; j < 16; ++j) { const unsigned cnt = xb_ld(rk + 64 * j); if (cnt) { ++npop; if (j < xcc) ++xidx; if (cnt != (unsigned)(G / 8)) ok = false; } }
        if (ok && npop == 8) { MISC[4] = myrank * 8u + xidx; MISC[5] = 1u; }
    }
    __syncthreads();
    {
        PIN_TID();
#if EN_NORM
        { const float* gvec = args.in[I_N1G];
          for (int row = gw; row < M; row += NGW) {
            const float* src = row < MP ? args.in[I_XP] + (size_t)row * D : args.in[I_XS] + (size_t)(row - MP) * D;
            f32x4 v[8]; float ssq = 0.f;
#pragma unroll
            for (int j = 0; j < 8; ++j) { v[j] = *(const GAS f32x4*)(src + 4 * (lane + 64 * j)); ssq += (v[j][0] * v[j][0] + v[j][1] * v[j][1]) + (v[j][2] * v[j][2] + v[j][3] * v[j][3]); }
            ssq = wave_sum(ssq);
            const int bv = row < MP ? 0 : 1 + ((row - MP) >> 12);
            const float* scp = MODS + ((size_t)bv * NMOD + 1) * D;
#pragma unroll
            for (int j = 0; j < 8; ++j) { const int col = 4 * (lane + 64 * j); const f32x4 g = *(const GAS f32x4*)(gvec + col), sc = *(const GAS f32x4*)(scp + col);
                const f32x4 y = v[j] * g * (sc + 1.0f); u32x2 w; w.x = cvt_pk_bf16(y[0], y[1]); w.y = cvt_pk_bf16(y[2], y[3]); *(GAS u32x2*)(HB + (size_t)row * D + col) = w; }
            if (lane == 0) SS[row] = ssq;
          } }
#endif
#if EN_MISC
        for (int l = 0; l < DEPTH; ++l) {
            LAS float* shl = (LAS float*)lds;
            __syncthreads();
            for (int idx = tid; idx < 2 * 5 * D; idx += NTHREADS) { const int w2 = idx / (5 * D), r = idx - w2 * 5 * D, bv = r / D, k = r - bv * D; shl[idx] = MODS[(((size_t)l * 5 + bv) * NMOD + (w2 ? 3 : 0)) * D + k]; }
            __syncthreads();
            const bf16_t* wt_in = (const bf16_t*)(ws + WS_WT + (size_t)l * WT_LAYER + WT_IN); const bf16_t* wt_up = (const bf16_t*)(ws + WS_WT + (size_t)l * WT_LAYER + WT_UP);
            for (int r = gw; r < IN_DIM + FFN2; r += NGW) {
                const bool isup = r >= IN_DIM; const int n = isup ? r - IN_DIM : r;
                const bf16_t* wrow = (isup ? wt_up : wt_in) + (size_t)n * D; const LAS float* sh = shl + (isup ? 5 * D : 0);
                float a5[5] = {0.f, 0.f, 0.f, 0.f, 0.f};
#pragma unroll
                for (int j = 0; j < 4; ++j) { const int k0 = 512 * j + 8 * lane; const u32x4 w = *(const GAS u32x4*)(wrow + k0);
                    float wf[8];
#pragma unroll
                    for (int e = 0; e < 4; ++e) { wf[2 * e] = bf_lo(w[e]); wf[2 * e + 1] = bf_hi(w[e]); }
#pragma unroll
                    for (int bv = 0; bv < 5; ++bv) { const f32x4 s0 = *(const LAS f32x4*)(sh + bv * D + k0), s1 = *(const LAS f32x4*)(sh + bv * D + k0 + 4);
                        a5[bv] += (wf[0] * s0[0] + wf[1] * s0[1]) + (wf[2] * s0[2] + wf[3] * s0[3]) + (wf[4] * s1[0] + wf[5] * s1[1]) + (wf[6] * s1[2] + wf[7] * s1[3]); } }
#pragma unroll
                for (int bv = 0; bv < 5; ++bv) { const float t = wave_sum(a5[bv]); if (lane == 0) { if (isup) BUP[((size_t)l * 5 + bv) * FFN2 + n] = t; else BIN[((size_t)l * 5 + bv) * IN_DIM + n] = t; } }
            }
        }
        __syncthreads();
#endif
    }
    GRID_BAR();

    for (int l = 0; l < DEPTH; ++l) {
        const float* mods_l = MODS + (size_t)l * 5 * NMOD * D;
        const unsigned char* wt = ws + WS_WT + (size_t)l * WT_LAYER;
#if EN_GIN
        {
            OPQ_BX();
            pg8::TileOrder S; S.init(M, IN_DIM, G, bx, HB, D, wt + WT_IN, D, QK, IN_DIM, 2);
            pg8::EpiIn E{OUTK, OUTV, l, SS + (size_t)(2 * l) * M, BIN + (size_t)l * 5 * IN_DIM, (const LAS float*)(lds + pg8::STAGE_BYTES)};
            for (int rep_ = 0; rep_ < REP_GIN; ++rep_)
            pg8::gemm_phase<pg8::EpiIn, pg8::TileOrder>(lds, wave0, D, D, D, S, E);
        }
#endif
        GRID_BAR();

        {
            OPQ_BX();
#if EN_ATT
            for (int rep_ = 0; rep_ < REP_ATT; ++rep_)
            for (int U = bx; U < 640; U += G) {
                if (U < 512) {
                    const int b = U >> 7, h = (U >> 4) & 7, i4 = U & 15;
                    const int kr0 = max(4 * i4 - 4, 0), ntn = (i4 == 0 || i4 == 15) ? 8 : 11;
                    const size_t rowbase = (size_t)MP + (size_t)b * SEQ_S;
                    att::TileSrc T;
                    T.K0 = CKB + (((size_t)b * DEPTH + l) * NH + h) * PAST * HD; T.V0 = CVB + (((size_t)b * DEPTH + l) * NH + h) * PAST * HD; T.ld0 = HD; T.nt0 = 4;
                    T.K1 = QK + (rowbase + (size_t)kr0 * GW) * IN_DIM + 1024 + h * HD; T.V1 = T.K1 + 1024; T.ld1 = IN_DIM; T.nt1 = ntn;
                    att::attn_unit<true>((LAS char*)lds, wave0, QK + (rowbase + (size_t)i4 * 256) * IN_DIM + h * HD, IN_DIM, T, kr0, 4 * i4,
                                         args.in[I_RPB] + ((size_t)l * NH + h) * 15 * 31, AF + (rowbase + (size_t)i4 * 256) * D + h * HD, D);
                } else {
                    const int bh = U - 512, b = bh >> 3, h = bh & 7;
                    att::TileSrc T;
                    T.K0 = QK + ((size_t)b * SEQ_P) * IN_DIM + 1024 + h * HD; T.V0 = T.K0 + 1024; T.ld0 = IN_DIM; T.nt0 = 4;
                    T.K1 = T.K0; T.V1 = T.V0; T.ld1 = IN_DIM; T.nt1 = 0;
                    att::attn_unit<false>((LAS char*)lds, wave0, QK + ((size_t)b * SEQ_P) * IN_DIM + h * HD, IN_DIM, T, 0, 0, nullptr, AF + ((size_t)b * SEQ_P) * D + h * HD, D);
                }
            }
#endif
#if EN_F1
            for (int rep_ = 0; rep_ < REP_FOUR; ++rep_) {
            { F1SOrder S{G, bx, (const char*)DC, (const char*)QK, (char*)GTS}; pg8::EpiBf16U<8192> E; pg8::gemm_phase<pg8::EpiBf16U<8192>, F1SOrder>(lds, wave0, 256, IN_DIM, 256, S, E); }
            { F1POrder S{G, G - 1 - bx, (const char*)DC, (const char*)QK, (char*)GTP}; pg8::EpiBf16U<512> E; pg8::gemm_phase<pg8::EpiBf16U<512>, F1POrder>(lds, wave0, 256, IN_DIM, 256, S, E); }
            }
#endif
        }
        GRID_BAR();

#if EN_F2
        {
            PIN_TID();
            for (int rep_ = 0; rep_ < REP_FOUR; ++rep_)
            for (int it = gw; it < 16 * 256 * 2; it += NGW) {
                const int row = it >> 1, half = it & 1;
                const char* src = (const char*)GTS + (size_t)row * 8192 * 2 + (unsigned)(half * 256 + lane * 4);
                unsigned zr[16], zi[16];
#pragma unroll
                for (int n2 = 0; n2 < 16; ++n2) { zr[n2] = *(const GAS unsigned*)(src + n2 * 512); zi[n2] = *(const GAS unsigned*)(src + 8192 + n2 * 512); }
                unsigned orr[16], oii[16];
#pragma unroll
                for (int j = 0; j < 2; ++j) {
                    float xr[16], xi[16];
#pragma unroll
                    for (int n2 = 0; n2 < 16; ++n2) { xr[n2] = j ? bf_hi(zr[n2]) : bf_lo(zr[n2]); xi[n2] = j ? bf_hi(zi[n2]) : bf_lo(zi[n2]); }
                    fft16(xr, xi);
                    float s1, c1; sincospif((float)(128 * half + 2 * lane + j) * (1.0f / 2048.0f), &s1, &c1);
                    float wr = 1.f, wi = 0.f;
#pragma unroll
                    for (int k2 = 0; k2 < 16; ++k2) { const int slot = 4 * (k2 & 3) + (k2 >> 2);
                        const float ur = xr[slot] * wr - xi[slot] * wi, ui = xr[slot] * wi + xi[slot] * wr;
                        if (j == 0) { orr[k2] = __float_as_uint(ur); oii[k2] = __float_as_uint(ui); }
                        else { orr[k2] = cvt_pk_bf16(__uint_as_float(orr[k2]), ur); oii[k2] = cvt_pk_bf16(__uint_as_float(oii[k2]), ui); }
                        const float nwr = wr * c1 + wi * s1, nwi = wi * c1 - wr * s1; wr = nwr; wi = nwi; }
                }
                const int bg = row >> 8, c = row & 255;
                char* dst = (char*)U2 + ((size_t)(bg * 16) * 256 + c) * 512 * 2 + (unsigned)(half * 256 + lane * 4);
#pragma unroll
                for (int k2 = 0; k2 < 16; ++k2) { *(GAS unsigned*)(dst + (size_t)k2 * 256 * 512 * 2) = orr[k2]; *(GAS unsigned*)(dst + (size_t)k2 * 256 * 512 * 2 + 512) = oii[k2]; }
            }
        }
#endif
        GRID_BAR();

#if EN_F2
        {
            OPQ_BX();
            for (int rep_ = 0; rep_ < REP_FOUR; ++rep_) {
            { F2SOrder S{G, bx, (const char*)DS, (const char*)U2, (char*)AF}; pg8::EpiBf16U<16 * D> E; pg8::gemm_phase<pg8::EpiBf16U<16 * D>, F2SOrder>(lds, wave0, 512, 512, 512, S, E); }
            { F2POrder S{G, G - 1 - bx, (const char*)DP, (const char*)GTP, (char*)AF}; pg8::EpiBf16U<D> E; pg8::gemm_phase<pg8::EpiBf16U<D>, F2POrder>(lds, wave0, 512, 512, 512, S, E); }
            }
        }
#endif
        GRID_BAR();

        unsigned mo5_ = MISC_OFF + 20; asm volatile("; opaque LDS offset" : "+v"(mo5_));
        const bool merged_ok = (G == 256) && (__builtin_amdgcn_readfirstlane((int)*(volatile LAS unsigned*)(lds + mo5_)) != 0);
        if (merged_ok) {
            OPQ_BX();
            pg8::PabOutOrder S{bx, (const char*)AF, (const char*)(wt + WT_PA), (const char*)YB, (const char*)(wt + WT_OUT), (unsigned*)(ws + WS_CTL) + CW_PANEL + (size_t)l * 80 * 16};
            pg8::EpiPabOut E{pg8::EpiPab{QK, YB},
                             pg8::EpiRes{args.in[I_XP], args.in[I_XS], X, mods_l, 2, l == 0, X, true, args.in[I_N2G] + (size_t)l * D, mods_l + 4 * D, SS + (size_t)(2 * l + 1) * M, HB, (const LAS float*)(lds + pg8::STAGE_BYTES)}};
            pg8::gemm_phase<pg8::EpiPabOut, pg8::PabOutOrder>(lds, wave0, D, D, D, S, E);
        } else {
#if EN_PAB
        {
            OPQ_BX();
            for (int rep_ = 0; rep_ < REP_PAB; ++rep_) {
            pg8::TileOrder S; S.init(M, D, G, bx, AF, D, wt + WT_PA, AD + FD, YB, D, 2); S.half_tail(); pg8::EpiPab E{QK, YB}; pg8::gemm_phase<pg8::EpiPab, pg8::TileOrder>(lds, wave0, D, AD + FD, AD + FD, S, E);
            }
        }
#endif
        GRID_BAR();

#if EN_OUT
        {
            OPQ_BX();
            pg8::TileOrder S; S.init(M, D, G, bx, YB, D, wt + WT_OUT, D, X, D, 4); S.half_tail();
            pg8::EpiRes E{args.in[I_XP], args.in[I_XS], X, mods_l, 2, l == 0, X, true, args.in[I_N2G] + (size_t)l * D, mods_l + 4 * D, SS + (size_t)(2 * l + 1) * M, HB, (const LAS float*)(lds + pg8::STAGE_BYTES)};
            for (int rep_ = 1; rep_ < REP_OUT; ++rep_) { pg8::EpiRes E2{args.in[I_XP], args.in[I_XS], X, mods_l, 2, l == 0, (float*)QK, false, nullptr, nullptr, nullptr, nullptr, (const LAS float*)(lds + pg8::STAGE_BYTES)}; pg8::gemm_phase<pg8::EpiRes, pg8::TileOrder>(lds, wave0, D, D, D, S, E2); }
            pg8::gemm_phase<pg8::EpiRes, pg8::TileOrder>(lds, wave0, D, D, D, S, E);
        }
#endif
        }
        GRID_BAR();

#if EN_UP
        {
            OPQ_BX();
            pg8::UpOrder S; S.init(G, bx, HB, wt + WT_UP, ACT);
            pg8::EpiUpConv E{args.in[I_CONVW] + (size_t)l * 3 * FFN2, args.in[I_CONVB] + (size_t)l * FFN2, UH, SS + (size_t)(2 * l + 1) * M, BUP + (size_t)l * 5 * FFN2, (const LAS float*)(lds + pg8::STAGE_BYTES)};
            for (int rep_ = 0; rep_ < REP_UP; ++rep_)
            pg8::gemm_phase<pg8::EpiUpConv, pg8::UpOrder>(lds, wave0, D, D, D, S, E);
        }
#endif
        GRID_BAR();

#if EN_CONV
        {
            PIN_TID();
            const float* cw = args.in[I_CONVW] + (size_t)l * 3 * FFN2; const float* cb = args.in[I_CONVB] + (size_t)l * FFN2;
            for (int rep_ = 0; rep_ < REP_THIN; ++rep_)
            for (int it = gw; it < (M / 256) * 4 * 11; it += NGW) {
                const int pm = it / 44, rem = it - pm * 44, t = rem / 11, cc = rem - t * 11, j0 = cc * 512 + lane * 8;
                const int row = pm * 256 + (t == 0 ? 0 : t == 1 ? 127 : t == 2 ? 128 : 255);
                const int seqmask = row < MP ? (SEQ_P - 1) : (SEQ_S - 1);
                const int sc_ = t == 0 ? 0 : t == 1 ? 3 : t == 2 ? 4 : 7;
                const bool zprev = (t == 0) && ((row & seqmask) == 0), znext = (t == 3) && ((row & seqmask) == seqmask);
                const float* pc = UH + ((size_t)pm * 8 + sc_) * FFN2 + j0;
                const float* pp = (t == 0) ? UH + ((size_t)(pm - 1) * 8 + 7) * FFN2 + j0 : pc - FFN2;
                const float* pn = (t == 3) ? UH + ((size_t)(pm + 1) * 8 + 0) * FFN2 + j0 : pc + FFN2;
                float o[8];
#pragma unroll
                for (int h = 0; h < 2; ++h) {
                    const f32x4 z4 = {0.f, 0.f, 0.f, 0.f};
                    const f32x4 ap = zprev ? z4 : *(const GAS f32x4*)(pp + 4 * h), ac = *(const GAS f32x4*)(pc + 4 * h), an = znext ? z4 : *(const GAS f32x4*)(pn + 4 * h);
                    const f32x4 gp = zprev ? z4 : *(const GAS f32x4*)(pp + FFN + 4 * h), gc = *(const GAS f32x4*)(pc + FFN + 4 * h), gn = znext ? z4 : *(const GAS f32x4*)(pn + FFN + 4 * h);
                    const f32x4 wa0 = *(const GAS f32x4*)(cw + j0 + 4 * h), wa1 = *(const GAS f32x4*)(cw + FFN2 + j0 + 4 * h), wa2 = *(const GAS f32x4*)(cw + 2 * FFN2 + j0 + 4 * h), ba = *(const GAS f32x4*)(cb + j0 + 4 * h);
                    const f32x4 wg0 = *(const GAS f32x4*)(cw + FFN + j0 + 4 * h), wg1 = *(const GAS f32x4*)(cw + FFN2 + FFN + j0 + 4 * h), wg2 = *(const GAS f32x4*)(cw + 2 * FFN2 + FFN + j0 + 4 * h), bg = *(const GAS f32x4*)(cb + FFN + j0 + 4 * h);
#pragma unroll
                    for (int e = 0; e < 4; ++e) { const float A = wa0[e] * ap[e] + wa1[e] * ac[e] + wa2[e] * an[e] + ba[e], Gv = wg0[e] * gp[e] + wg1[e] * gc[e] + wg2[e] * gn[e] + bg[e];
                        o[4 * h + e] = Gv * sigmoidf_fast(Gv) * A; }
                }
                u32x4 w; w.x = cvt_pk_bf16(o[0], o[1]); w.y = cvt_pk_bf16(o[2], o[3]); w.z = cvt_pk_bf16(o[4], o[5]); w.w = cvt_pk_bf16(o[6], o[7]);
                *(GAS u32x4*)(ACT + (size_t)row * FFN + j0) = w;
            }
        }
#endif
        GRID_BAR();

#if EN_DOWN
        {
            OPQ_BX();
            pg8::TileOrder S; S.init(M, D, G, bx, ACT, FFN, wt + WT_DOWN, FFN, X, D, 4); S.split_tail(40, (unsigned*)(ws + WS_CTL) + CW_FLAG + (size_t)l * 128 * 16);
            const int ln = l + 1 < DEPTH ? l + 1 : l;
            pg8::EpiRes E{args.in[I_XP], args.in[I_XS], X, mods_l, 5, false, X, l + 1 < DEPTH, args.in[I_N1G] + (size_t)ln * D, MODS + (size_t)ln * 5 * NMOD * D + 1 * D, SS + (size_t)(2 * ln) * M, HB, (const LAS float*)(lds + pg8::STAGE_BYTES)};
            for (int rep_ = 1; rep_ < REP_DOWN; ++rep_) { pg8::EpiRes E2{args.in[I_XP], args.in[I_XS], X, mods_l, 5, false, (float*)QK, false, nullptr, nullptr, nullptr, nullptr, (const LAS float*)(lds + pg8::STAGE_BYTES)}; pg8::gemm_phase<pg8::EpiRes, pg8::TileOrder>(lds, wave0, FFN, FFN, FFN, S, E2); }
            pg8::gemm_phase<pg8::EpiRes, pg8::TileOrder>(lds, wave0, FFN, FFN, FFN, S, E);
        }
#endif
        GRID_BAR();
    }

#if EN_FINAL
    {
        PIN_TID();
        const float* gvec = args.in[I_NFG];
        for (int row = gw; row < M; row += NGW) {
            float* src = X + (size_t)row * D;
            f32x4 v[8]; float ss = 0.f;
#pragma unroll
            for (int j = 0; j < 8; ++j) { v[j] = *(const f32x4*)(src + 4 * (lane + 64 * j)); ss += (v[j][0] * v[j][0] + v[j][1] * v[j][1]) + (v[j][2] * v[j][2] + v[j][3] * v[j][3]); }
            const float rstd = rsqrtf(wave_sum(ss) * (1.0f / D) + RMS_EPS);
#pragma unroll
            for (int j = 0; j < 8; ++j) { const int col = 4 * (lane + 64 * j); const f32x4 g = *(const f32x4*)(gvec + col); *(f32x4*)(src + col) = (v[j] * rstd) * g; }
        }
    }
#endif
}

extern "C" void kernel_launch(void* const* d_in, const int* in_sizes, int n_in, void* d_out, int out_size, void* d_ws, size_t ws_size, hipStream_t stream) {
    static int grid = 0;
    if (grid == 0) {
        if (n_in != 20 || in_sizes[0] != MP * D || in_sizes[1] != MS * D || ws_size < WS_END) {
            fprintf(stderr, "kernel_launch: shape mismatch: n_in %d in0 %d in1 %d out %d ws %zu (need >= %zu); nothing launched\n", n_in, n_in > 0 ? in_sizes[0] : -1, n_in > 1 ? in_sizes[1] : -1, out_size, ws_size, (size_t)WS_END); grid = -1; return; }
        int dev = 0, cus = 0, per_cu = 0;
        if (hipGetDevice(&dev) != hipSuccess || hipDeviceGetAttribute(&cus, hipDeviceAttributeMultiprocessorCount, dev) != hipSuccess) { fprintf(stderr, "kernel_launch: device query failed\n"); grid = -1; return; }
        if (hipFuncSetAttribute((const void*)fwd, hipFuncAttributeMaxDynamicSharedMemorySize, LDS_BYTES) != hipSuccess) { fprintf(stderr, "kernel_launch: hipFuncSetAttribute failed\n"); grid = -1; return; }
        if (hipOccupancyMaxActiveBlocksPerMultiprocessor(&per_cu, (const void*)fwd, NTHREADS, LDS_BYTES) != hipSuccess || per_cu < 1)
            fprintf(stderr, "kernel_launch: note: occupancy query reports %d workgroups per CU\n", per_cu);
        (void)hipGetLastError();
        grid = cus;
    }
    if (grid < 0) return;
    if (hipMemsetAsync((char*)d_ws + WS_CTL, 0, CTL_ZERO_BYTES, stream) != hipSuccess) { fprintf(stderr, "kernel_launch: memset failed\n"); return; }
    Args a{};
    for (int i = 0; i < 20; ++i) a.in[i] = (const float*)d_in[i];
    a.out = (float*)d_out; a.ws = (unsigned char*)d_ws;
    hipLaunchKernelGGL(fwd, dim3(grid), dim3(NTHREADS), LDS_BYTES, stream, a);
    const hipError_t le = hipPeekAtLastError();
    if (le != hipSuccess) fprintf(stderr, "kernel_launch: launch failed: %s\n", hipGetErrorName(le));
}
```

```cpp
#include <hip/hip_runtime.h>
#include <cstdio>
#include <cstdint>

#define GAS __attribute__((address_space(1)))
#define LAS __attribute__((address_space(3)))
typedef unsigned short bf16_t;
typedef short bf16x8 __attribute__((ext_vector_type(8)));
typedef short s16x4 __attribute__((ext_vector_type(4)));
typedef float f32x4 __attribute__((ext_vector_type(4)));
typedef float f32x2 __attribute__((ext_vector_type(2)));
typedef float f32x16 __attribute__((ext_vector_type(16)));
typedef unsigned u32x4 __attribute__((ext_vector_type(4)));
typedef unsigned u32x2 __attribute__((ext_vector_type(2)));

#ifndef EN_MODS
#define EN_MODS 1
#endif
#ifndef EN_WT
#define EN_WT 1
#endif
#ifndef EN_MISC
#define EN_MISC 1
#endif
#ifndef EN_NORM
#define EN_NORM 1
#endif
#ifndef EN_GIN
#define EN_GIN 1
#endif
#ifndef EN_ATT
#define EN_ATT 1
#endif
#ifndef EN_F1
#define EN_F1 1
#endif
#ifndef EN_F2
#define EN_F2 1
#endif
#ifndef EN_PAB
#define EN_PAB 1
#endif
#ifndef EN_OUT
#define EN_OUT 1
#endif
#ifndef EN_UP
#define EN_UP 1
#endif
#ifndef EN_CONV
#define EN_CONV 1
#endif
#ifndef EN_DOWN
#define EN_DOWN 1
#endif
#ifndef EN_FINAL
#define EN_FINAL 1
#endif
#ifndef REP_P0
#define REP_P0 1
#endif
#ifndef FOUR_MERGE
#define FOUR_MERGE 0
#endif
#ifndef FOUR_KEEPBAR
#define FOUR_KEEPBAR 0
#endif
#ifndef REP_ATT
#define REP_ATT 1
#endif
#ifndef REP_THIN
#define REP_THIN 1
#endif
#ifndef REP_GIN
#define REP_GIN 1
#endif
#ifndef REP_BAR
#define REP_BAR 1
#endif
#ifndef REP_OUT
#define REP_OUT 1
#endif
#ifndef REP_DOWN
#define REP_DOWN 1
#endif
#ifndef REP_PAB
#define REP_PAB 1
#endif
#ifndef REP_FOUR
#define REP_FOUR 1
#endif
#ifndef REP_UP
#define REP_UP 1
#endif
constexpr int D = 2048, NB_P = 16, SEQ_P = 256, DEPTH = 4, NB_S = 4, SEQ_S = 4096, PAST = 256;
constexpr int MP = NB_P * SEQ_P;
constexpr int MS = NB_S * SEQ_S;
constexpr int M = MP + MS;
constexpr int NH = 8, HD = 128, AD = 1024, FD = 1024, FFN = 5632, FFN2 = 11264, IN_DIM = 8192, NMOD = 6;
constexpr int GW = 64;
constexpr float RMS_EPS = 1e-6f;
constexpr float QSCALE = 0.08838834764831845f * 1.4426950408889634f;
constexpr float LOG2E = 1.4426950408889634f;

constexpr size_t MiB = 1u << 20;
constexpr size_t WS_CTL = 0, CTL_ZERO_BYTES = 2 * MiB;
constexpr size_t WS_SS = 1 * MiB;
constexpr size_t WS_MODS = 2 * MiB;
constexpr size_t WS_BIAS = 3 * MiB;
constexpr size_t WS_CACHE = 5 * MiB;
constexpr size_t WS_DC = 21 * MiB;
constexpr size_t WS_DP = WS_DC + 256 * 1024;
constexpr size_t WS_DS = WS_DP + 256 * 1024;
constexpr size_t WS_UP2 = 22 * MiB;
constexpr size_t WS_WT = 86 * MiB;
constexpr size_t WT_IN = 0, WT_PA = (size_t)IN_DIM * D * 2, WT_PB = WT_PA + (size_t)D * AD * 2, WT_OUT = WT_PB + (size_t)D * FD * 2,
                 WT_UP = WT_OUT + (size_t)D * D * 2, WT_DOWN = WT_UP + (size_t)FFN2 * D * 2, WT_LAYER = WT_DOWN + (size_t)D * FFN * 2;
static_assert(WT_LAYER == 114 * MiB, "weight copy size");
constexpr size_t WS_H = WS_WT + 4 * WT_LAYER;
constexpr size_t WS_BIG = WS_H + 80 * MiB;
constexpr size_t WS_UH = WS_BIG + 320 * MiB;
constexpr size_t WS_AF = WS_BIG + 440 * MiB;
constexpr size_t WS_GTS = WS_AF + 80 * MiB;
constexpr size_t WS_GTP = WS_GTS + 64 * MiB;
constexpr size_t WS_T1 = WS_GTP + 16 * MiB;
constexpr size_t WS_ACT = WS_AF;
constexpr size_t WS_Y = WS_T1 + 160 * MiB;
constexpr size_t WS_END = WS_Y + 80 * MiB;
static_assert(WS_END <= 1536 * MiB, "workspace map");
static_assert((size_t)M * FFN * 2 <= 320 * MiB, "act overlay");

constexpr int CW_FLAG = 65536;
constexpr int CW_FOUR = 131072;
constexpr int CW_PANEL = 98304;
constexpr int CW_XRANK = 32768;
constexpr int CW_BAR = 4096;

constexpr int LDS_BYTES = 163840;
constexpr int MISC_OFF = LDS_BYTES - 256;
constexpr int NWAVES = 8, NTHREADS = 512;

#define LDS_WAIT() asm volatile("s_waitcnt lgkmcnt(0)" ::: "memory")
#define VM_WAIT() asm volatile("s_waitcnt vmcnt(0)" ::: "memory")
__device__ __forceinline__ unsigned cvt_pk_bf16(float lo, float hi) { unsigned r; asm volatile("v_cvt_pk_bf16_f32 %0, %1, %2" : "=v"(r) : "v"(lo), "v"(hi)); return r; }
__device__ __forceinline__ float bf_lo(unsigned w) { return __uint_as_float(w << 16); }
__device__ __forceinline__ float bf_hi(unsigned w) { return __uint_as_float(w & 0xffff0000u); }
__device__ __forceinline__ float sigmoidf_fast(float x) { return __builtin_amdgcn_rcpf(1.0f + __expf(-x)); }
template <int CTRL> __device__ __forceinline__ float dpp_add(float v) { return v + __int_as_float(__builtin_amdgcn_update_dpp(0, __float_as_int(v), CTRL, 0xf, 0xf, true)); }
__device__ __forceinline__ float wave_sum(float v) {
    v = dpp_add<0xB1>(v);
    v = dpp_add<0x4E>(v);
    v = dpp_add<0x141>(v);
    v = dpp_add<0x140>(v);
    const float s0 = __int_as_float(__builtin_amdgcn_readlane(__float_as_int(v), 0)), s1 = __int_as_float(__builtin_amdgcn_readlane(__float_as_int(v), 16));
    const float s2 = __int_as_float(__builtin_amdgcn_readlane(__float_as_int(v), 32)), s3 = __int_as_float(__builtin_amdgcn_readlane(__float_as_int(v), 48));
    return (s0 + s1) + (s2 + s3);
}
__device__ __forceinline__ int fresh_wave(int w) { asm volatile("; opaque wave index" : "+s"(w)); return w; }
__device__ __forceinline__ int fresh_lane() { int l; asm volatile("v_mbcnt_lo_u32_b32 %0, -1, 0\n\tv_mbcnt_hi_u32_b32 %0, -1, %0" : "=v"(l)); return l; }

#define XB_TMO      128
#define XB_XCNT(j)  (256  + 64 * (j))
#define XB_XSUB(j)  (1280 + 64 * (j))
#define XB_XGEN(j)  (2304 + 64 * (j))
#define XB_TOP      3328
#define XB_TOPGEN   3392
#define XCD_BAR_WORDS 3456
#define XB_SPIN_CAP (1u << 18)
__device__ __forceinline__ unsigned xb_ld(unsigned* p)              { return __hip_atomic_load((GAS unsigned*)p, __ATOMIC_RELAXED, __HIP_MEMORY_SCOPE_AGENT); }
__device__ __forceinline__ unsigned xb_add(unsigned* p, unsigned v) { return __hip_atomic_fetch_add((GAS unsigned*)p, v, __ATOMIC_RELAXED, __HIP_MEMORY_SCOPE_AGENT); }
__device__ __forceinline__ unsigned xb_xcc_id() { return (unsigned)__builtin_amdgcn_s_getreg((3 << 11) | 20) & 0xFu; }
#define XB_SPIN(cond, bar) do { unsigned _sp = 0; while (cond) { __builtin_amdgcn_s_sleep(1); \
    if ((++_sp & 255u) == 0u) { if (xb_ld(&(bar)[XB_TMO])) break; if (_sp > XB_SPIN_CAP) { xb_add(&(bar)[XB_TMO], 1u); break; } } } } while (0)
struct XcdBarrier { unsigned* bar; unsigned x; volatile LAS unsigned* st; };
__device__ __forceinline__ XcdBarrier xcd_barrier_post(unsigned* bar, volatile LAS unsigned* st) {
    XcdBarrier b; b.bar = bar; b.x = xb_xcc_id(); b.st = st;
    if (threadIdx.x == 0) (void)xb_add(&bar[XB_XCNT(b.x)], 1u);
    return b;
}
__device__ __forceinline__ void xcd_barrier_complete(unsigned* bar, unsigned x, unsigned& nloc, unsigned& nx) {
    const unsigned G = gridDim.x * gridDim.y * gridDim.z;
    unsigned sum, cnt, mine, sp = 0u;
    for (;;) {
        sum = 0u; cnt = 0u; mine = 0u;
#pragma unroll
        for (unsigned j = 0; j < 16; ++j) { const unsigned c = xb_ld(&bar[XB_XCNT(j)]); sum += c; cnt += (c > 0u) ? 1u : 0u; mine = (j == x) ? c : mine; }
        if (sum == G) break;
        __builtin_amdgcn_s_sleep(1);
        if ((++sp & 255u) == 0u) { if (xb_ld(&bar[XB_TMO])) break; if (sp > XB_SPIN_CAP) { xb_add(&bar[XB_TMO], 1u); break; } }
    }
    nloc = mine > 0u ? mine : 1u; nx = cnt > 0u ? cnt : 1u;
}
__device__ __forceinline__ void xcd_barrier(const XcdBarrier& b, const bool leader_thread) {
    asm volatile("s_waitcnt vmcnt(0)" ::: "memory");
    __syncthreads();
    if (leader_thread) {
        unsigned* bar = b.bar;
        __builtin_amdgcn_s_waitcnt(0);
        unsigned nloc = b.st[0], nx = b.st[1];
        if (nloc == 0u) { xcd_barrier_complete(bar, b.x, nloc, nx); b.st[0] = nloc; b.st[1] = nx; }
        const unsigned old = xb_add(&bar[XB_XSUB(b.x)], 1u);
        const unsigned gen = old / nloc;
        if (old + 1u == (gen + 1u) * nloc) {
            __builtin_amdgcn_fence(__ATOMIC_RELEASE, "agent");
            asm volatile("s_waitcnt vmcnt(0)" ::: "memory");
            const unsigned og = xb_add(&bar[XB_TOP], 1u);
            const unsigned tg = og / nx;
            if (og + 1u == (tg + 1u) * nx) xb_add(&bar[XB_TOPGEN], 1u);
            else XB_SPIN(xb_ld(&bar[XB_TOPGEN]) == tg, bar);
            __builtin_amdgcn_fence(__ATOMIC_ACQUIRE, "agent");
            xb_add(&bar[XB_XGEN(b.x)], 1u);
            asm volatile("s_waitcnt vmcnt(0)" ::: "memory");
        } else {
            XB_SPIN(xb_ld(&bar[XB_XGEN(b.x)]) == gen, bar);
            __builtin_amdgcn_fence(__ATOMIC_ACQUIRE, "agent");
            asm volatile("s_waitcnt vmcnt(0)" ::: "memory");
        }
    }
    __syncthreads();
}

namespace pg8 {
constexpr int BM = 256, BK = 64, HALF = 128, HTB = HALF * BK * 2, STAGE_BYTES = 8 * HTB, NXCD = 8, WGM = 8;
__host__ __device__ __forceinline__ int lds_byte(int r, int c) { const int st = (r >> 4) * 2 + (c >> 5), rr = r & 15, cc = c & 31, ob = rr * 64 + cc * 2; return st * 1024 + (ob ^ (((ob >> 9) & 1) << 5)); }
__host__ __device__ __forceinline__ void stage_rc(int b, int& R, int& C) { const int st = b / 1024, sb = b % 1024, swz = sb ^ (((sb >> 9) & 1) << 5); R = (st >> 1) * 16 + swz / 64; C = (st & 1) * 32 + (swz % 64) / 2; }
__host__ __device__ __forceinline__ int perm32(int rho) { const int n = rho >> 4, i = rho & 15; return 8 * (i >> 2) + 4 * n + (i & 3); }

struct Unit { const char* a; const char* b; char* c; int pm, pn, hm; };

struct TileOrder {
    static constexpr int BH_ROWS = 128; static constexpr bool KSPLIT = true, MERGED = false;
    int nM, nN, nwg, G, c; const char* A; const char* B; char* C; size_t astep, bstep, cstep; int ldc, cesz; int tail, ktp; size_t khalf; unsigned* flags;
    __device__ __forceinline__ void init(int M_, int N_, int G_, int c_, const void* A_, int lda, const void* B_, int ldb, void* C_, int ldc_, int cesz_) {
        nM = M_ / BM; nN = N_ / BM; nwg = nM * nN; G = G_; c = c_; A = (const char*)A_; B = (const char*)B_; C = (char*)C_;
        astep = (size_t)BM * lda * 2; bstep = (size_t)BM * ldb * 2; ldc = ldc_; cesz = cesz_; cstep = (size_t)BM * ldc_ * cesz_; tail = 0; ktp = 0; khalf = 0; flags = nullptr;
    }
    __device__ __forceinline__ void half_tail() { if (G == 256 && nwg == 640) tail = 1; }
    __device__ __forceinline__ void split_tail(int ktp_, unsigned* flags_) { if (G == 256 && nwg == 640) { tail = 2; ktp = ktp_; khalf = (size_t)ktp_ * (BK * 2); flags = flags_; } }
    __device__ __forceinline__ bool next(int i, Unit& u) const {
        int wgid; u.hm = 0;
        if (tail && i >= 2) { if (i > 2) return false;
            const int xcd = c % NXCD, k = c / NXCD, j = k >> 1; wgid = xcd * (nwg / NXCD) + 64 + j;
            u.hm = (tail == 1) ? 1 + (k & 1) : ((3 + (k & 1)) | ((xcd * 16 + j) << 4)); }
        else { const long L = (long)i * G + c; if (L >= nwg) return false;
            wgid = (int)L; { const int q = nwg / NXCD, r = nwg % NXCD, xcd = wgid % NXCD, off = wgid / NXCD; wgid = (xcd < r ? xcd * (q + 1) : r * (q + 1) + (xcd - r) * q) + off; } }
        const int nig = WGM * nN, gid = wgid / nig, fm = gid * WGM, gsz = (nM - fm) < WGM ? (nM - fm) : WGM;
        u.pm = fm + ((wgid % nig) % gsz); u.pn = (wgid % nig) / gsz;
        const size_t ko = ((u.hm & 15) == 4) ? khalf : 0;
        u.a = A + (size_t)u.pm * astep + ((u.hm & 15) == 2 ? astep / 2 : 0) + ko; u.b = B + (size_t)u.pn * bstep + ko; u.c = C + (size_t)u.pm * cstep + (size_t)u.pn * BM * cesz;
        return true;
    }
};

template <class Epi, class Sched, bool ALIGN_EPI = true>
__device__ __forceinline__ void gemm_phase(LAS unsigned char* lds, const int wave0, const int lda, const int ldb, const int K, const Sched& S, const Epi& E) {
    const int lane = fresh_lane(), wid = fresh_wave(wave0), tid = wid * 64 + lane, wr = wid >> 2, wc = wid & 3, fr = lane & 15, fq = lane >> 4;
    const int nt = K / BK;
    unsigned voffA[2], voffB[2];
#pragma unroll
    for (int i = 0; i < 2; ++i) { int R, C; stage_rc(tid * 16 + i * 8192, R, C); const int Rb = Epi::PERM ? ((R & ~31) + perm32(R & 31)) : R;
        const int Ra = Epi::APERM ? (8 * (16 * (R >> 6) + (R & 15)) + ((R >> 4) & 3)) : R;
        voffA[i] = (unsigned)(Ra * lda + C) * 2u; voffB[i] = (unsigned)(Rb * ldb + C) * 2u; }
    const size_t kstep = (size_t)(BK * 2);
    const size_t hstepA = (size_t)(Epi::APERM ? 4 : HALF) * lda * 2, hstepB = (size_t)Sched::BH_ROWS * ldb * 2;
    const unsigned ldsw = (unsigned)wid * 1024u;
    const int aoff = lds_byte(wr * 64 + fr, fq * 8), boff = lds_byte(wc * 32 + fr, fq * 8);
#define PG8_SA(b, h) (((b) * 2 + (h)) * HTB)
#define PG8_SB(b, h) ((4 + (b) * 2 + (h)) * HTB)
#ifndef PG8_AUX_A
#define PG8_AUX_A 0
#endif
#ifndef PG8_AUX_B
#define PG8_AUX_B 0
#endif
#define PG8_STAGE(bufoff, gbase, voff) do { const GAS char* gb_ = (const GAS char*)(gbase); asm("" : "+s"(gb_));   _Pragma("unroll") for (int _i = 0; _i < 2; ++_i) { asm("" : "+v"((voff)[_i]));   \
        __builtin_amdgcn_global_load_lds((const GAS unsigned*)(gb_ + (voff)[_i]), (LAS unsigned*)(lds + (bufoff) + ldsw + _i * 8192), 16, 0, PG8_AUX_A); } } while (0)
#define PG8_STAGEB(bufoff, gbase, voff) do { const GAS char* gb_ = (const GAS char*)(gbase); asm("" : "+s"(gb_));   _Pragma("unroll") for (int _i = 0; _i < 2; ++_i) { asm("" : "+v"((voff)[_i]));   \
        __builtin_amdgcn_global_load_lds((const GAS unsigned*)(gb_ + (voff)[_i]), (LAS unsigned*)(lds + (bufoff) + ldsw + _i * 8192), 16, 0, PG8_AUX_B); } } while (0)
#define PG8_LDA(dst, b, h) do { _Pragma("unroll") for (int m = 0; m < 4; ++m) _Pragma("unroll") for (int k = 0; k < 2; ++k) dst[m][k] = *(const LAS bf16x8*)(lds + PG8_SA(b, h) + aoff + m * 2048 + k * 1024); } while (0)
#define PG8_LDB(dst, b, h) do { _Pragma("unroll") for (int n = 0; n < 2; ++n) _Pragma("unroll") for (int k = 0; k < 2; ++k) dst[n][k] = *(const LAS bf16x8*)(lds + PG8_SB(b, h) + boff + n * 2048 + k * 1024); } while (0)
#define PG8_MMA(ai, bj, At, Bt) do { __builtin_amdgcn_s_setprio(1); _Pragma("unroll") for (int m = 0; m < 4; ++m) _Pragma("unroll") for (int n = 0; n < 2; ++n) _Pragma("unroll") for (int k = 0; k < 2; ++k) \
        acc[ai][bj][m][n] = __builtin_amdgcn_mfma_f32_16x16x32_bf16(Bt[n][k], At[m][k], acc[ai][bj][m][n], 0, 0, 0); __builtin_amdgcn_s_setprio(0); } while (0)
#define PG8_WAIT_V(n) asm volatile("s_waitcnt vmcnt(" #n ")" ::: "memory")
#define PG8_WAIT_L(n) asm volatile("s_waitcnt lgkmcnt(" #n ")" ::: "memory")
#define PG8_BAR __builtin_amdgcn_s_barrier()
#define PG8_SCHED __builtin_amdgcn_sched_barrier(0)
    Unit cur, nxt; int ui = 0;
    if (!S.next(0, cur)) return;
    f32x4 acc[2][2][4][2];
#pragma unroll
    for (int a = 0; a < 2; ++a)
#pragma unroll
        for (int b = 0; b < 2; ++b)
#pragma unroll
            for (int m = 0; m < 4; ++m)
#pragma unroll
                for (int n = 0; n < 2; ++n) acc[a][b][m][n] = (f32x4){0.f, 0.f, 0.f, 0.f};
    bf16x8 At[4][2], B0[2][2], B1[2][2];
    const char* cA = cur.a; const char* cB = cur.b;
    if constexpr (Sched::MERGED) { if constexpr (Sched::WAIT_FIRST) { if (S.needs_wait(cur)) { S.wait_panel(cur, wid); PG8_BAR; } } }
    PG8_STAGEB(PG8_SB(0, 0), cB, voffB); PG8_STAGEB(PG8_SB(0, 1), cB + hstepB, voffB); PG8_STAGE(PG8_SA(0, 0), cA, voffA); PG8_STAGE(PG8_SA(0, 1), cA + hstepA, voffA);
    if (wr == 1) PG8_BAR;
    PG8_WAIT_V(2); PG8_BAR;
    PG8_STAGEB(PG8_SB(1, 0), cB + kstep, voffB); PG8_STAGE(PG8_SA(1, 0), cA + kstep, voffA); PG8_STAGEB(PG8_SB(1, 1), cB + hstepB + kstep, voffB);
    PG8_WAIT_V(6); PG8_BAR;
    for (;;) {
        const bool has_next = S.next(ui + 1, nxt);
        const char* nA = has_next ? nxt.a : cA; const char* nB = has_next ? nxt.b : cB;
        const int hmode = cur.hm & 15;
        const bool full = (hmode == 0) || (hmode >= 3);
        int unt = nt; if constexpr (Sched::KSPLIT) { if (hmode == 3) unt = S.ktp; else if (hmode == 4) unt = nt - S.ktp; }
        float pf = 0.f;
        for (int t = 0; t < unt; t += 2) {
            const bool last = (t == unt - 2);
            const char* a1 = cA + (size_t)(t + 1) * kstep;
            const char* a2 = last ? nA : cA + (size_t)(t + 2) * kstep; const char* b2 = last ? nB : cB + (size_t)(t + 2) * kstep;
            const char* a3 = a2 + kstep; const char* b3 = b2 + kstep;
            if constexpr (Sched::MERGED) { if (last && has_next && S.needs_wait(nxt)) { S.wait_panel(nxt, wid); PG8_BAR; } }
            if constexpr (Epi::MIDK > 0) { if (t == Epi::MIDK) E.mid(acc, cur, wid); }
            if constexpr (Epi::PREF) { if (last) pf = E.prefetch(cur, tid); }
            PG8_LDB(B0, 0, 0); PG8_LDB(B1, 0, 1); PG8_SCHED; PG8_LDA(At, 0, 0); PG8_STAGE(PG8_SA(1, 1), a1 + hstepA, voffA);
            PG8_WAIT_V(8); PG8_WAIT_L(0); PG8_BAR; PG8_MMA(0, 0, At, B0); PG8_MMA(0, 1, At, B1); PG8_BAR; PG8_SCHED;
            if (full) PG8_LDA(At, 0, 1); PG8_STAGEB(PG8_SB(0, 0), b2, voffB); PG8_STAGEB(PG8_SB(0, 1), b2 + hstepB, voffB); PG8_STAGE(PG8_SA(0, 0), a2, voffA);
            PG8_WAIT_V(8); PG8_WAIT_L(0); PG8_BAR; if (full) { PG8_MMA(1, 0, At, B0); PG8_MMA(1, 1, At, B1); } PG8_BAR; PG8_SCHED;
            PG8_LDB(B0, 1, 0); PG8_LDB(B1, 1, 1); PG8_SCHED; PG8_LDA(At, 1, 0); PG8_STAGE(PG8_SA(0, 1), a2 + hstepA, voffA);
            PG8_WAIT_V(8); PG8_WAIT_L(0); PG8_BAR; PG8_MMA(0, 0, At, B0); PG8_MMA(0, 1, At, B1); PG8_BAR; PG8_SCHED;
            if (full) PG8_LDA(At, 1, 1); PG8_STAGEB(PG8_SB(1, 0), b3, voffB); PG8_STAGEB(PG8_SB(1, 1), b3 + hstepB, voffB); PG8_STAGE(PG8_SA(1, 0), a3, voffA);
            PG8_WAIT_V(8); PG8_WAIT_L(0); PG8_BAR; if (full) { PG8_MMA(1, 0, At, B0); PG8_MMA(1, 1, At, B1); } PG8_BAR; PG8_SCHED;
        }
        if constexpr (ALIGN_EPI) { if (wr == 0) PG8_BAR; }
        if constexpr (Epi::PREF) { static_assert(ALIGN_EPI, "the side-buffer exchange needs both halves in the epilogue together");
            *(LAS float*)(lds + STAGE_BYTES + tid * 4) = pf; PG8_WAIT_L(0); PG8_BAR; }
        if constexpr (Sched::KSPLIT) {
            if (hmode == 3) {
                E.produce(acc, cur, wid);
                PG8_WAIT_V(0); PG8_BAR;
                if (wid == 0 && fresh_lane() == 0) __hip_atomic_store((GAS unsigned*)(S.flags + (size_t)(cur.hm >> 4) * 16), 1u, __ATOMIC_RELAXED, __HIP_MEMORY_SCOPE_AGENT);
            } else {
                if (hmode == 4) {
                    if (wid == 0) { GAS unsigned* fp = (GAS unsigned*)(S.flags + (size_t)(cur.hm >> 4) * 16); unsigned sp = 0;
                        while ((unsigned)__builtin_amdgcn_readfirstlane(__hip_atomic_load(fp, __ATOMIC_RELAXED, __HIP_MEMORY_SCOPE_AGENT)) != 1u) { __builtin_amdgcn_s_sleep(2); if (++sp > (1u << 20)) break; }
                        __builtin_amdgcn_fence(__ATOMIC_ACQUIRE, "agent"); PG8_WAIT_V(0); }
                    PG8_BAR;
                }
                E(acc, cur, wid);
            }
        } else { E(acc, cur, wid);
            if constexpr (Sched::MERGED) { if (S.publishes(cur)) { PG8_WAIT_V(0); if (fresh_lane() == 0) S.publish(cur); } } }
        if (!has_next) break;
#pragma unroll
        for (int a = 0; a < 2; ++a)
#pragma unroll
            for (int b = 0; b < 2; ++b)
#pragma unroll
                for (int m = 0; m < 4; ++m)
#pragma unroll
                    for (int n = 0; n < 2; ++n) acc[a][b][m][n] = (f32x4){0.f, 0.f, 0.f, 0.f};
        cur = nxt; cA = nA; cB = nB; ++ui;
        if constexpr (ALIGN_EPI) { if (wr == 1) PG8_BAR; }
    }
    PG8_WAIT_V(0);
    if constexpr (!ALIGN_EPI) { if (wr == 0) PG8_BAR; }
    PG8_BAR;
#undef PG8_SA
#undef PG8_SB
#undef PG8_STAGE
#undef PG8_STAGEB
#undef PG8_LDA
#undef PG8_LDB
#undef PG8_MMA
#undef PG8_WAIT_V
#undef PG8_WAIT_L
#undef PG8_BAR
#undef PG8_SCHED
}

typedef f32x4 Acc[2][2][4][2];
constexpr int STG_OFF = STAGE_BYTES + 8192, STG_WAVE = 2304, STG_PITCH = 144;
template <int CTRL> __device__ __forceinline__ float dpp_mov(float v) { return __int_as_float(__builtin_amdgcn_update_dpp(0, __float_as_int(v), CTRL, 0xf, 0xf, true)); }

template <int LDC> struct EpiBf16U {
    static constexpr bool PERM = true, APERM = false; static constexpr int MIDK = 0; static constexpr bool PREF = false;
    __device__ __forceinline__ void operator()(const Acc& acc, const Unit& u, const int wid) const {
        const int lane = fresh_lane(), wr = wid >> 2, wc = wid & 3, fr = lane & 15, fq = lane >> 4;
        const unsigned loff = (unsigned)((wr * 64 + fr) * LDC + wc * 32 + 8 * fq) * 2u;
#pragma unroll
        for (int ai = 0; ai < 2; ++ai)
#pragma unroll
            for (int m = 0; m < 4; ++m) { char* rowp = u.c + (size_t)(ai * HALF + m * 16) * LDC * 2; asm("" : "+s"(rowp));
#pragma unroll
                for (int bj = 0; bj < 2; ++bj) { const f32x4 v0 = acc[ai][bj][m][0], v1 = acc[ai][bj][m][1];
                    u32x4 w; w.x = cvt_pk_bf16(v0[0], v0[1]); w.y = cvt_pk_bf16(v0[2], v0[3]); w.z = cvt_pk_bf16(v1[0], v1[1]); w.w = cvt_pk_bf16(v1[2], v1[3]);
                    *(GAS u32x4*)(rowp + loff + bj * HALF * 2) = w; } }
    }
};
struct EpiIn {
    static constexpr bool PERM = true, APERM = false; static constexpr int MIDK = 0; static constexpr bool PREF = true;
    float* outk; float* outv; int layer; const float* ss; const float* bias; const LAS float* side;
    __device__ __forceinline__ void produce(const Acc&, const Unit&, const int) const {}
    __device__ __forceinline__ float prefetch(const Unit& u, const int tid) const {
        const int bv = u.pm < NB_P ? 0 : 1 + ((u.pm - NB_P) >> 4);
        const float* p = tid < 256 ? ss + (size_t)u.pm * BM + tid : bias + (size_t)bv * IN_DIM + u.pn * BM + (tid - 256);
        return *(const GAS float*)p;
    }
    __device__ __forceinline__ void operator()(const Acc& acc, const Unit& u, const int wid) const {
        const int lane = fresh_lane(), wr = wid >> 2, wc = wid & 3, fr = lane & 15, fq = lane >> 4;
        const bool sig = u.pn >= 16, kv = (u.pm < NB_P) && (u.pn >= 4) && (u.pn < 12);
        const int r0 = wr * 64 + fr, c0 = wc * 32 + 8 * fq;
        const unsigned loff = (unsigned)(r0 * IN_DIM + c0) * 2u, koff = (unsigned)(r0 * HD + c0) * 4u;
        float rstd[2][4]; f32x4 bb[2][2];
        {
#pragma unroll
          for (int ai = 0; ai < 2; ++ai)
#pragma unroll
              for (int m = 0; m < 4; ++m) rstd[ai][m] = side[r0 + ai * HALF + m * 16];
#pragma unroll
          for (int bj = 0; bj < 2; ++bj)
#pragma unroll
              for (int n = 0; n < 2; ++n) bb[bj][n] = *(const LAS f32x4*)(side + 256 + c0 + bj * HALF + 4 * n);
#pragma unroll
          for (int ai = 0; ai < 2; ++ai)
#pragma unroll
              for (int m = 0; m < 4; ++m) rstd[ai][m] = rsqrtf(rstd[ai][m] * (1.0f / D) + RMS_EPS); }
#pragma unroll
        for (int ai = 0; ai < 2; ++ai)
#pragma unroll
            for (int m = 0; m < 4; ++m) { char* rowp = u.c + (size_t)(ai * HALF + m * 16) * IN_DIM * 2; asm("" : "+s"(rowp));
#pragma unroll
                for (int bj = 0; bj < 2; ++bj) { f32x4 v0 = acc[ai][bj][m][0] * rstd[ai][m] + bb[bj][0], v1 = acc[ai][bj][m][1] * rstd[ai][m] + bb[bj][1];
                    if (sig) {
#pragma unroll
                        for (int j = 0; j < 4; ++j) { v0[j] = sigmoidf_fast(v0[j]); v1[j] = sigmoidf_fast(v1[j]); } }
                    u32x4 w; w.x = cvt_pk_bf16(v0[0], v0[1]); w.y = cvt_pk_bf16(v0[2], v0[3]); w.z = cvt_pk_bf16(v1[0], v1[1]); w.w = cvt_pk_bf16(v1[2], v1[3]);
                    *(GAS u32x4*)(rowp + loff + bj * HALF * 2) = w;
                    if (kv) { const int colt = u.pn * BM + bj * HALF; const bool isv = colt >= 2048; const int head = (colt - (isv ? 2048 : 1024)) >> 7;
                        char* dst = (char*)((isv ? outv : outk) + ((((size_t)u.pm * DEPTH + layer) * NH + head) * SEQ_P + (ai * HALF + m * 16)) * HD); asm("" : "+s"(dst));
                        *(GAS f32x4*)(dst + koff) = v0; *(GAS f32x4*)(dst + koff + 16) = v1; } } }
    }
};
struct EpiPab {
    static constexpr bool PERM = true, APERM = false; static constexpr int MIDK = 16; static constexpr bool PREF = false;
    const bf16_t* G; bf16_t* Y;
    __device__ __forceinline__ void produce(const Acc&, const Unit&, const int) const {}
    __device__ __forceinline__ void mid(Acc& acc, const Unit& u, const int wid) const {
        const int lane = fresh_lane(), wr = wid >> 2, wc = wid & 3, fr = lane & 15, fq = lane >> 4;
        const unsigned goff = (unsigned)((wr * 64 + fr) * IN_DIM + wc * 32 + 8 * fq) * 2u;
        const int hb = (u.hm & 15) == 2 ? HALF : 0, na = ((u.hm & 15) == 1 || (u.hm & 15) == 2) ? 1 : 2;
#pragma unroll
        for (int ai = 0; ai < 2; ++ai) if (ai < na) {
#pragma unroll
            for (int mp = 0; mp < 2; ++mp) {
                u32x4 ga[2][2], gb[2][2];
#pragma unroll
                for (int mm = 0; mm < 2; ++mm) { const int m = 2 * mp + mm; const char* gp = (const char*)(G + (size_t)(u.pm * BM + hb + ai * HALF + m * 16) * IN_DIM + 4096 + u.pn * BM); asm("" : "+s"(gp));
#pragma unroll
                    for (int bj = 0; bj < 2; ++bj) { ga[mm][bj] = *(const GAS u32x4*)(gp + goff + bj * HALF * 2); gb[mm][bj] = *(const GAS u32x4*)(gp + goff + bj * HALF * 2 + 2048 * 2); } }
                asm volatile("" ::: "memory");
#pragma unroll
                for (int mm = 0; mm < 2; ++mm)
#pragma unroll
                    for (int bj = 0; bj < 2; ++bj)
#pragma unroll
                        for (int j = 0; j < 4; ++j) { const int m = 2 * mp + mm;
                            const float r0 = bf_lo(ga[mm][bj][j]) * __builtin_amdgcn_rcpf(fmaxf(bf_lo(gb[mm][bj][j]), 1e-30f)), r1 = bf_hi(ga[mm][bj][j]) * __builtin_amdgcn_rcpf(fmaxf(bf_hi(gb[mm][bj][j]), 1e-30f));
                            acc[ai][bj][m][j >> 1][2 * (j & 1)] *= r0; acc[ai][bj][m][j >> 1][2 * (j & 1) + 1] *= r1; }
            }
        }
    }
    __device__ __forceinline__ void operator()(const Acc& acc, const Unit& u, const int wid) const {
        const int lane = fresh_lane(), wr = wid >> 2, wc = wid & 3, fr = lane & 15, fq = lane >> 4;
        const unsigned goff = (unsigned)((wr * 64 + fr) * IN_DIM + wc * 32 + 8 * fq) * 2u, yoff = (unsigned)((wr * 64 + fr) * D + wc * 32 + 8 * fq) * 2u;
        const int hb = (u.hm & 15) == 2 ? HALF : 0, na = ((u.hm & 15) == 1 || (u.hm & 15) == 2) ? 1 : 2;
        u32x4 gb[2][4][2];
#pragma unroll
        for (int ai = 0; ai < 2; ++ai) if (ai < na)
#pragma unroll
            for (int m = 0; m < 4; ++m) { const char* gp = (const char*)(G + (size_t)(u.pm * BM + hb + ai * HALF + m * 16) * IN_DIM + 6144 + u.pn * BM); asm("" : "+s"(gp));
#pragma unroll
                for (int bj = 0; bj < 2; ++bj) gb[ai][m][bj] = *(const GAS u32x4*)(gp + goff + bj * HALF * 2); }
        asm volatile("" ::: "memory");
#pragma unroll
        for (int ai = 0; ai < 2; ++ai) if (ai < na)
#pragma unroll
            for (int m = 0; m < 4; ++m) { char* yp = (char*)(Y + (size_t)(u.pm * BM + hb + ai * HALF + m * 16) * D + u.pn * BM); asm("" : "+s"(yp));
#pragma unroll
                for (int bj = 0; bj < 2; ++bj) { const u32x4 g = gb[ai][m][bj]; const f32x4 v0 = acc[ai][bj][m][0], v1 = acc[ai][bj][m][1];
                    u32x4 w;
                    w.x = cvt_pk_bf16(v0[0] * fmaxf(bf_lo(g[0]), 1e-30f), v0[1] * fmaxf(bf_hi(g[0]), 1e-30f)); w.y = cvt_pk_bf16(v0[2] * fmaxf(bf_lo(g[1]), 1e-30f), v0[3] * fmaxf(bf_hi(g[1]), 1e-30f));
                    w.z = cvt_pk_bf16(v1[0] * fmaxf(bf_lo(g[2]), 1e-30f), v1[1] * fmaxf(bf_hi(g[2]), 1e-30f)); w.w = cvt_pk_bf16(v1[2] * fmaxf(bf_lo(g[3]), 1e-30f), v1[3] * fmaxf(bf_hi(g[3]), 1e-30f));
                    *(GAS u32x4*)(yp + yoff + bj * HALF * 2) = w; } }
    }
};
struct EpiRes {
    static constexpr bool PERM = true, APERM = false; static constexpr int MIDK = 0; static constexpr bool PREF = true;
    const float* xp; const float* xs; float* X; const float* mods_l; int gi; bool first; float* XO;
    bool emit; const float* gvec; const float* scl; float* ss; bf16_t* HBo;
    const LAS float* side;
    __device__ __forceinline__ float prefetch(const Unit& u, const int tid) const {
        const int bv = u.pm < NB_P ? 0 : 1 + ((u.pm - NB_P) >> 4);
        unsigned to = (unsigned)tid * 4u; asm volatile("; opaque lane offset" : "+v"(to));
        if (tid >= 256) return *(const GAS float*)((const GAS char*)(mods_l + ((size_t)bv * NMOD + gi) * D + u.pn * BM - 256) + to);
        if (!emit) return 0.f;
        return *(const GAS float*)((const GAS char*)(gvec + u.pn * BM) + to) * (*(const GAS float*)((const GAS char*)(scl + (size_t)bv * NMOD * D + u.pn * BM) + to) + 1.0f);
    }
    __device__ __forceinline__ void produce(const Acc& acc, const Unit& u, const int wid) const {
        const int lane = fresh_lane(), wr = wid >> 2, wc = wid & 3, fr = lane & 15, fq = lane >> 4;
        const int r0 = wr * 64 + fr, c0 = wc * 32 + 8 * fq;
        const unsigned xoff = (unsigned)(r0 * D + c0) * 4u;
        const float* base = first ? (u.pm < NB_P ? xp : xs - (size_t)MP * D) : X;
        char* xt = (char*)(X + (size_t)u.pm * BM * D + u.pn * BM); asm("" : "+s"(xt));
        const __amdgpu_buffer_rsrc_t rs = __builtin_amdgcn_make_buffer_rsrc(xt, 0, 256 * D * 4, 0x00020000);
#pragma unroll
        for (int ai = 0; ai < 2; ++ai) {
            f32x4 b[4][2][2];
#pragma unroll
            for (int m = 0; m < 4; ++m) { const char* bp = (const char*)(base + (size_t)(u.pm * BM + ai * HALF + m * 16) * D + u.pn * BM); asm("" : "+s"(bp));
#pragma unroll
                for (int bj = 0; bj < 2; ++bj)
#pragma unroll
                    for (int n = 0; n < 2; ++n) b[m][bj][n] = *(const GAS f32x4*)(bp + xoff + (bj * HALF + n * 4) * 4); }
            asm volatile("" ::: "memory");
#pragma unroll
            for (int bj = 0; bj < 2; ++bj)
#pragma unroll
                for (int n = 0; n < 2; ++n) { const f32x4 gvx = *(const LAS f32x4*)(side + 256 + c0 + bj * HALF + n * 4);
#pragma unroll
                    for (int m = 0; m < 4; ++m) __builtin_amdgcn_raw_buffer_store_b128(__builtin_bit_cast(u32x4, b[m][bj][n] + gvx * acc[ai][bj][m][n]), rs, xoff, ((ai * HALF + m * 16) * D + bj * HALF + n * 4) * 4, 16); }
            asm volatile("" ::: "memory");
        }
    }
    __device__ __forceinline__ void operator()(const Acc& acc, const Unit& u, const int wid) const {
        const int lane = fresh_lane(), wr = wid >> 2, wc = wid & 3, fr = lane & 15, fq = lane >> 4, rr = lane >> 3, ck = lane & 7;
        const unsigned xoff = (unsigned)((wr * 64 + rr) * D + wc * 32 + ck * 4) * 4u, hoff = xoff >> 1;
        LAS char* stg = (LAS char*)side + (STG_OFF - STAGE_BYTES) + wid * STG_WAVE;
        const unsigned sw = (unsigned)(fr * STG_PITCH + fq * 32), sr = (unsigned)(rr * STG_PITCH + ck * 16);
        const int cl = wc * 32 + ck * 4;
        const int hmode = u.hm & 15;
        const float* base = (first && hmode != 4) ? (u.pm < NB_P ? xp : xs - (size_t)MP * D) : X;
        float* XOu = XO; const bool em = emit;
        const int hb = hmode == 2 ? HALF : 0, na = (hmode == 1 || hmode == 2) ? 1 : 2;
#pragma unroll
        for (int ai = 0; ai < 2; ++ai) if (ai < na) {
            f32x4 b[4][2][2];
#pragma unroll
            for (int m = 0; m < 4; ++m) { const char* bp = (const char*)(base + (size_t)(u.pm * BM + hb + ai * HALF + m * 16) * D + u.pn * BM); asm("" : "+s"(bp));
#pragma unroll
                for (int bj = 0; bj < 2; ++bj)
#pragma unroll
                    for (int p = 0; p < 2; ++p) b[m][bj][p] = *(const GAS f32x4*)(bp + xoff + (p * 8 * D + bj * HALF) * 4); }
            asm volatile("" ::: "memory");
#pragma unroll
            for (int m = 0; m < 4; ++m) {
                char* xq = (char*)(XOu + (size_t)(u.pm * BM + hb + ai * HALF + m * 16) * D + u.pn * BM); asm("" : "+s"(xq));
                char* hq = (char*)(HBo + (size_t)(u.pm * BM + hb + ai * HALF + m * 16) * D + u.pn * BM); asm("" : "+s"(hq));
                float q0 = 0.f, q1 = 0.f;
#pragma unroll
                for (int bj = 0; bj < 2; ++bj) {
                    *(LAS f32x4*)(stg + sw) = acc[ai][bj][m][0]; *(LAS f32x4*)(stg + sw + 16) = acc[ai][bj][m][1];
                    asm volatile("" ::: "memory");
                    const f32x4 a0 = *(const LAS f32x4*)(stg + sr), a1 = *(const LAS f32x4*)(stg + sr + 8 * STG_PITCH);
                    const f32x4 gvx = *(const LAS f32x4*)(side + 256 + cl + bj * HALF);
                    asm volatile("" ::: "memory");
                    const f32x4 x0 = b[m][bj][0] + gvx * a0, x1 = b[m][bj][1] + gvx * a1;
                    *(GAS f32x4*)(xq + xoff + (bj * HALF) * 4) = x0; *(GAS f32x4*)(xq + xoff + (8 * D + bj * HALF) * 4) = x1;
                    if (em) { const f32x4 gs = *(const LAS f32x4*)(side + cl + bj * HALF); const f32x4 h0 = x0 * gs, h1 = x1 * gs;
                        q0 += (x0[0] * x0[0] + x0[1] * x0[1]) + (x0[2] * x0[2] + x0[3] * x0[3]); q1 += (x1[0] * x1[0] + x1[1] * x1[1]) + (x1[2] * x1[2] + x1[3] * x1[3]);
                        u32x2 w0, w1; w0.x = cvt_pk_bf16(h0[0], h0[1]); w0.y = cvt_pk_bf16(h0[2], h0[3]); w1.x = cvt_pk_bf16(h1[0], h1[1]); w1.y = cvt_pk_bf16(h1[2], h1[3]);
                        *(GAS u32x2*)(hq + hoff + (bj * HALF) * 2) = w0; *(GAS u32x2*)(hq + hoff + (8 * D + bj * HALF) * 2) = w1; }
                }
                if (em) {
                    q0 += dpp_mov<0xB1>(q0); q1 += dpp_mov<0xB1>(q1); q0 += dpp_mov<0x4E>(q0); q1 += dpp_mov<0x4E>(q1); q0 += dpp_mov<0x141>(q0); q1 += dpp_mov<0x141>(q1);
                    if (ck == 0) { GAS float* sp = (GAS float*)(ss + (size_t)(u.pm * BM + hb + ai * HALF + m * 16) + wr * 64 + rr);
                        __hip_atomic_fetch_add(sp, q0, __ATOMIC_RELAXED, __HIP_MEMORY_SCOPE_AGENT); __hip_atomic_fetch_add(sp + 8, q1, __ATOMIC_RELAXED, __HIP_MEMORY_SCOPE_AGENT); }
                }
            }
            asm volatile("" ::: "memory");
        }
    }
};
struct UpOrder {
    static constexpr int BH_ROWS = FFN; static constexpr bool KSPLIT = false, MERGED = false;
    int nM, nN, nwg, G, c; const char* A; const char* B; char* C;
    __device__ __forceinline__ void init(int G_, int c_, const void* A_, const void* B_, void* C_) { nM = M / BM; nN = FFN / 128; nwg = nM * nN; G = G_; c = c_; A = (const char*)A_; B = (const char*)B_; C = (char*)C_; }
    __device__ __forceinline__ bool next(int i, Unit& u) const {
        const long L = (long)i * G + c; if (L >= nwg) return false;
        int wgid = (int)L; { const int q = nwg / NXCD, r = nwg % NXCD, xcd = wgid % NXCD, off = wgid / NXCD; wgid = (xcd < r ? xcd * (q + 1) : r * (q + 1) + (xcd - r) * q) + off; }
        const int nig = WGM * nN, gid = wgid / nig, fm = gid * WGM, gsz = (nM - fm) < WGM ? (nM - fm) : WGM;
        u.pm = fm + ((wgid % nig) % gsz); u.pn = (wgid % nig) / gsz;
        u.a = A + (size_t)u.pm * BM * D * 2; u.b = B + (size_t)u.pn * 128 * D * 2; u.c = C + ((size_t)u.pm * BM * FFN + (size_t)u.pn * 128) * 2; u.hm = 0;
        return true;
    }
};
__device__ __forceinline__ float dpp_shr1(float v) { return __int_as_float(__builtin_amdgcn_update_dpp(0, __float_as_int(v), 0x111, 0xf, 0xf, true)); }
__device__ __forceinline__ float dpp_shl1(float v) { return __int_as_float(__builtin_amdgcn_update_dpp(0, __float_as_int(v), 0x101, 0xf, 0xf, true)); }
struct EpiUpConv {
    static constexpr bool PERM = true, APERM = true; static constexpr int MIDK = 0; static constexpr bool PREF = true;
    const float* cw; const float* cb; float* UH; const float* ss; const float* bias; const LAS float* side;
    __device__ __forceinline__ float prefetch(const Unit& u, const int tid) const {
        const int bv = u.pm < NB_P ? 0 : 1 + ((u.pm - NB_P) >> 4);
        const float* p = tid < 256 ? ss + (size_t)u.pm * BM + tid : bias + (size_t)bv * FFN2 + u.pn * 128 + (tid < 384 ? tid - 256 : FFN + tid - 384);
        return *(const GAS float*)p;
    }
    __device__ __forceinline__ void operator()(const Acc& acc, const Unit& u, const int wid) const {
        const int lane = fresh_lane(), wr = wid >> 2, wc = wid & 3, fr = lane & 15, fq = lane >> 4;
        const int q = 16 * wr + fr, ch0 = 32 * wc + 8 * fq;
        const char* wbase = (const char*)(cw + u.pn * 128); const char* bbase = (const char*)(cb + u.pn * 128); asm("" : "+s"(wbase), "+s"(bbase));
        const unsigned coff = (unsigned)ch0 * 4u;
        float rstd[8];
        { const f32x4 s0 = *(const LAS f32x4*)(side + 8 * q), s1 = *(const LAS f32x4*)(side + 8 * q + 4);
#pragma unroll
          for (int k = 0; k < 4; ++k) { rstd[k] = rsqrtf(s0[k] * (1.0f / D) + RMS_EPS); rstd[4 + k] = rsqrtf(s1[k] * (1.0f / D) + RMS_EPS); } }
        unsigned outp[8][4];
#pragma unroll
        for (int n = 0; n < 2; ++n) {
            const f32x4 wa0 = *(const GAS f32x4*)(wbase + coff + n * 16), wa1 = *(const GAS f32x4*)(wbase + coff + n * 16 + FFN2 * 4), wa2 = *(const GAS f32x4*)(wbase + coff + n * 16 + 2 * FFN2 * 4);
            const f32x4 wg0 = *(const GAS f32x4*)(wbase + coff + n * 16 + FFN * 4), wg1 = *(const GAS f32x4*)(wbase + coff + n * 16 + (FFN2 + FFN) * 4), wg2 = *(const GAS f32x4*)(wbase + coff + n * 16 + (2 * FFN2 + FFN) * 4);
            const f32x4 ba = *(const GAS f32x4*)(bbase + coff + n * 16), bg = *(const GAS f32x4*)(bbase + coff + n * 16 + FFN * 4);
            const f32x4 ua_b = *(const LAS f32x4*)(side + 256 + ch0 + 4 * n), ug_b = *(const LAS f32x4*)(side + 384 + ch0 + 4 * n);
            float keep[8];
#pragma unroll
            for (int e = 0; e < 4; ++e) {
                float ua[8], ug[8];
#pragma unroll
                for (int k = 0; k < 8; ++k) { ua[k] = acc[k >> 2][0][k & 3][n][e] * rstd[k] + ua_b[e]; ug[k] = acc[k >> 2][1][k & 3][n][e] * rstd[k] + ug_b[e]; }
                const float pa = dpp_shr1(ua[7]), na = dpp_shl1(ua[0]), pg = dpp_shr1(ug[7]), ng = dpp_shl1(ug[0]);
#pragma unroll
                for (int k = 0; k < 8; ++k) {
                    const float A = wa0[e] * (k ? ua[k - 1] : pa) + wa1[e] * ua[k] + wa2[e] * (k < 7 ? ua[k + 1] : na) + ba[e];
                    const float Gv = wg0[e] * (k ? ug[k - 1] : pg) + wg1[e] * ug[k] + wg2[e] * (k < 7 ? ug[k + 1] : ng) + bg[e];
                    const float o = Gv * sigmoidf_fast(Gv) * A;
                    if (e & 1) outp[k][2 * n + (e >> 1)] = cvt_pk_bf16(keep[k], o); else keep[k] = o;
                }
            }
        }
        char* cbase = u.c; asm("" : "+s"(cbase));
        const unsigned roff = (unsigned)(8 * q) * (unsigned)(FFN * 2) + (unsigned)ch0 * 2u;
#pragma unroll
        for (int k = 0; k < 8; ++k) {
            const bool skip = (k == 0 && fr == 0) || (k == 7 && fr == 15);
            if (!skip) { u32x4 w; w.x = outp[k][0]; w.y = outp[k][1]; w.z = outp[k][2]; w.w = outp[k][3]; *(GAS u32x4*)(cbase + roff + k * (FFN * 2)) = w; }
        }
        if (fr == 0 || fr == 15) {
            char* ub = (char*)(UH + ((size_t)u.pm * 8 + 4 * wr) * FFN2 + u.pn * 128); asm("" : "+s"(ub));
            const unsigned uoff = (unsigned)(fr == 15 ? 2 * FFN2 * 4 : 0) + coff;
#pragma unroll
            for (int kk = 0; kk < 2; ++kk)
#pragma unroll
                for (int n = 0; n < 2; ++n) {
                    const float rs = fr == 0 ? rstd[kk] : rstd[6 + kk];
                    const f32x4 ua_b = *(const LAS f32x4*)(side + 256 + ch0 + 4 * n), ug_b = *(const LAS f32x4*)(side + 384 + ch0 + 4 * n);
                    const f32x4 va = (fr == 0 ? acc[0][0][kk][n] : acc[1][0][2 + kk][n]) * rs + ua_b, vg = (fr == 0 ? acc[0][1][kk][n] : acc[1][1][2 + kk][n]) * rs + ug_b;
                    *(GAS f32x4*)(ub + uoff + kk * (FFN2 * 4) + n * 16) = va; *(GAS f32x4*)(ub + uoff + kk * (FFN2 * 4) + FFN * 4 + n * 16) = vg; }
        }
    }
};

struct PabOutOrder {
    static constexpr int BH_ROWS = 128; static constexpr bool KSPLIT = false, MERGED = true;
    int c; const char* AF; const char* Wpab; const char* YB; const char* Wout; unsigned* cnt;
    __device__ __forceinline__ bool next(int i, Unit& u) const {
        if (i >= 5) return false;
        const int xcd = c & 7, s = 32 * i + (c >> 3), kind = s >= 80, j = kind ? s - 80 : s;
        u.pm = 10 * xcd + (j >> 3); u.pn = j & 7; u.hm = kind ? 0x1000 : 0; u.c = nullptr;
        u.a = (kind ? YB : AF) + (size_t)u.pm * BM * D * 2; u.b = (kind ? Wout : Wpab) + (size_t)u.pn * BM * D * 2;
        return true;
    }
    static constexpr bool WAIT_FIRST = false;
    __device__ __forceinline__ bool needs_wait(const Unit& u) const { return (u.hm & 0x1000) != 0; }
    __device__ __forceinline__ bool publishes(const Unit& u) const { return (u.hm & 0x1000) == 0; }
    __device__ __forceinline__ void publish(const Unit& u) const { __hip_atomic_fetch_add((GAS unsigned*)(cnt + u.pm * 16), 1u, __ATOMIC_RELAXED, __HIP_MEMORY_SCOPE_AGENT); }
    __device__ __forceinline__ void wait_panel(const Unit& u, const int wid) const {
        if (wid == 0) { GAS unsigned* fp = (GAS unsigned*)(cnt + u.pm * 16); unsigned sp = 0;
            while ((unsigned)__builtin_amdgcn_readfirstlane(__hip_atomic_load(fp, __ATOMIC_RELAXED, __HIP_MEMORY_SCOPE_AGENT)) < 64u) { __builtin_amdgcn_s_sleep(2); if (++sp > (1u << 20)) break; }
            __builtin_amdgcn_fence(__ATOMIC_ACQUIRE, "agent"); asm volatile("s_waitcnt vmcnt(0)" ::: "memory"); }
    }
};
struct EpiPabOut {
    static constexpr bool PERM = true, APERM = false; static constexpr int MIDK = 16; static constexpr bool PREF = true; static constexpr int NPF = 1;
    EpiPab P; EpiRes R;
    __device__ __forceinline__ void produce(const Acc&, const Unit&, const int) const {}
    __device__ __forceinline__ float prefetch(const Unit& u, const int tid) const { return (u.hm & 0x1000) ? R.prefetch(u, tid) : 0.f; }
    __device__ __forceinline__ void mid(Acc& acc, const Unit& u, const int wid) const { if (!(u.hm & 0x1000)) P.mid(acc, u, wid); }
    __device__ __forceinline__ void operator()(const Acc& acc, const Unit& u, const int wid) const { if (u.hm & 0x1000) R(acc, u, wid); else P(acc, u, wid); }
};
}

struct Buffers;
struct FourierSync {
    static constexpr bool WAIT_FIRST = true;
    bool mg; unsigned* pub; unsigned* wt; unsigned need;
    __device__ __forceinline__ bool needs_wait(const pg8::Unit&) const { return mg && wt != nullptr; }
    __device__ __forceinline__ bool publishes(const pg8::Unit&) const { return mg && pub != nullptr; }
    __device__ __forceinline__ void publish(const pg8::Unit& u) const { __hip_atomic_fetch_add((GAS unsigned*)(pub + u.pm * 16), 1u, __ATOMIC_RELAXED, __HIP_MEMORY_SCOPE_AGENT); }
    __device__ __forceinline__ void wait_panel(const pg8::Unit& u, const int wid) const {
        if (wid == 0) { GAS unsigned* fp = (GAS unsigned*)(wt + u.pm * 16); unsigned sp = 0;
            while ((unsigned)__builtin_amdgcn_readfirstlane(__hip_atomic_load(fp, __ATOMIC_RELAXED, __HIP_MEMORY_SCOPE_AGENT)) < need) { __builtin_amdgcn_s_sleep(2); if (++sp > (1u << 20)) break; }
            __builtin_amdgcn_fence(__ATOMIC_ACQUIRE, "agent"); asm volatile("s_waitcnt vmcnt(0)" ::: "memory"); }
    }
};
struct F1SOrder : FourierSync {
    static constexpr int BH_ROWS = 128; static constexpr bool KSPLIT = false, MERGED = true;
    int G, c; const char* DC; const char* QK; char* GTS;
    __device__ __forceinline__ bool next(int i, pg8::Unit& u) const {
        int L; if (mg) { if (i >= 2) return false; L = 64 * (c & 7) + 32 * i + (c >> 3); } else { L = i * G + c; if (L >= 512) return false; }
        const int bg = L >> 5, part = (L >> 4) & 1, nt = L & 15, b = bg >> 2, g = bg & 3;
        u.a = DC + (size_t)part * 256 * 256 * 2; u.b = QK + ((size_t)(MP + b * SEQ_S + nt * 256) * IN_DIM + 3072 + g * 256) * 2;
        u.c = GTS + ((size_t)bg * 256 * 8192 + part * 4096 + nt * 256) * 2; u.pm = bg; u.pn = nt; u.hm = 0; return true;
    }
};
struct F1POrder : FourierSync {
    static constexpr int BH_ROWS = 128; static constexpr bool KSPLIT = false, MERGED = true;
    int G, c; const char* DC; const char* QK; char* GTP;
    __device__ __forceinline__ bool next(int i, pg8::Unit& u) const {
        int L; if (mg) { if (i >= 1 || (c >> 3) < 16) return false; L = 16 * (c & 7) + (c >> 3) - 16; }      else { L = i * G + (G - 1 - c); if (L >= 128) return false; }
        const int bg = L >> 1, part = L & 1, b = bg >> 2, g = bg & 3;
        u.a = DC + (size_t)part * 256 * 256 * 2; u.b = QK + ((size_t)(b * SEQ_P) * IN_DIM + 3072 + g * 256) * 2;
        u.c = GTP + ((size_t)bg * 256 * 512 + part * 256) * 2; u.pm = bg; u.pn = 0; u.hm = 0; return true;
    }
};
struct F2SOrder : FourierSync {
    static constexpr int BH_ROWS = 128; static constexpr bool KSPLIT = false, MERGED = true;
    int G, c; const char* DS; const char* U2; char* AF;
    __device__ __forceinline__ bool next(int i, pg8::Unit& u) const {
        int L; if (mg) { if (i >= 1) return false; L = 32 * (c & 7) + (c >> 3); } else { L = i * G + c; if (L >= 256) return false; }
        const int bg = L >> 4, k2 = L & 15, b = bg >> 2, g = bg & 3;
        u.a = DS; u.b = U2 + (size_t)(bg * 16 + k2) * 256 * 512 * 2;
        u.c = AF + ((size_t)(MP + b * SEQ_S + k2) * D + 1024 + g * 256) * 2; u.pm = bg; u.pn = 0; u.hm = 0; return true;
    }
};
struct F2POrder : FourierSync {
    static constexpr int BH_ROWS = 128; static constexpr bool KSPLIT = false, MERGED = true;
    int G, c; const char* DP; const char* GTP; char* AF;
    __device__ __forceinline__ bool next(int i, pg8::Unit& u) const {
        int L; if (mg) { if (i >= 1 || (c >> 3) < 24) return false; L = 8 * (c & 7) + (c >> 3) - 24; } else { L = i * G + (G - 1 - c); if (L >= 64) return false; }
        const int bg = L, b = bg >> 2, g = bg & 3;
        u.a = DP; u.b = GTP + (size_t)bg * 256 * 512 * 2; u.c = AF + ((size_t)(b * SEQ_P) * D + 1024 + g * 256) * 2; u.pm = bg; u.pn = 0; u.hm = 0; return true;
    }
};

namespace att {
#define KSWZ(row, colB) ((row) * 256 + ((colB) ^ (((row) & 7) << 4)))
__device__ __forceinline__ int crow(int r, int hi) { return (r & 3) + 8 * (r >> 2) + 4 * hi; }
__device__ __forceinline__ int v_st(int k, int c) { const int kk = (k & ~0xC) | ((k & 4) << 1) | ((k & 8) >> 1); return ((kk >> 3) * 4 + (c >> 5)) * 512 + ((kk & 7) * 32 + (c & 31)) * 2; }
__device__ __forceinline__ int v_rd_base(int lane) { return ((lane & 3) << 3) | (((lane >> 2) & 3) << 6) | (((lane >> 4) & 1) << 5) | (((lane >> 5) & 1) << 8); }
constexpr int v_rd_off(int d0, int ks, int half) { return d0 * 512 + ks * 4096 + half * 2048; }
template <int OFF> __device__ __forceinline__ s16x4 tr_read(int vb) { s16x4 r; asm volatile("ds_read_b64_tr_b16 %0, %1 offset:%2" : "=&v"(r) : "v"(vb), "i"(OFF) : "memory"); return r; }
template <int D0> __device__ __forceinline__ void pv_one(f32x16& od, int vb, bf16x8 pa0, bf16x8 pa1, bf16x8 pa2, bf16x8 pa3) {
    const s16x4 l0 = tr_read<v_rd_off(D0, 0, 0)>(vb), h0 = tr_read<v_rd_off(D0, 0, 1)>(vb), l1 = tr_read<v_rd_off(D0, 1, 0)>(vb), h1 = tr_read<v_rd_off(D0, 1, 1)>(vb);
    const s16x4 l2 = tr_read<v_rd_off(D0, 2, 0)>(vb), h2 = tr_read<v_rd_off(D0, 2, 1)>(vb), l3 = tr_read<v_rd_off(D0, 3, 0)>(vb), h3 = tr_read<v_rd_off(D0, 3, 1)>(vb);
    asm volatile("s_waitcnt lgkmcnt(0)" ::: "memory"); __builtin_amdgcn_sched_barrier(0);
#define ATT_PK(L, H) (bf16x8){L[0], L[1], L[2], L[3], H[0], H[1], H[2], H[3]}
    od = __builtin_amdgcn_mfma_f32_32x32x16_bf16(pa0, ATT_PK(l0, h0), od, 0, 0, 0);
    od = __builtin_amdgcn_mfma_f32_32x32x16_bf16(pa1, ATT_PK(l1, h1), od, 0, 0, 0);
    od = __builtin_amdgcn_mfma_f32_32x32x16_bf16(pa2, ATT_PK(l2, h2), od, 0, 0, 0);
    od = __builtin_amdgcn_mfma_f32_32x32x16_bf16(pa3, ATT_PK(l3, h3), od, 0, 0, 0);
#undef ATT_PK
}
constexpr int SHM_V = 64 * 128 * 2, SHM_K = 64 * 128 * 2;
constexpr int L_V = 0, L_K = 2 * SHM_V, L_WS = 2 * SHM_V + 2 * SHM_K, L_TAB = L_WS + NWAVES * 64 * 4, L_END = L_TAB + 15 * 128 * 4;
static_assert(L_END <= 131072, "attention LDS");

struct TileSrc { const bf16_t* K0; const bf16_t* V0; int ld0, nt0; const bf16_t* K1; const bf16_t* V1; int ld1, nt1; };

template <bool NA>
__device__ __forceinline__ void attn_unit(LAS char* lds, const int wave0, const bf16_t* Qb, int ldq, const TileSrc T, int kr0, int qrow0, const float* rpb, bf16_t* Ob, int ldo) {
    const int lane = fresh_lane(), wid = fresh_wave(wave0), tid = wid * 64 + lane, r32 = lane & 31, hi = lane >> 5;
    LAS char* V_lds = lds + L_V; LAS char* K_lds = lds + L_K;
    LAS float* ws = (LAS float*)(lds + L_WS) + wid * 64; LAS float* li_l = ws; LAS float* al_l = ws + 32;
    LAS float* tab = (LAS float*)(lds + L_TAB);
    float m_reg = -1e30f, l_reg = 0.f; f32x16 o[4];
#pragma unroll
    for (int d = 0; d < 4; ++d)
#pragma unroll
        for (int r = 0; r < 16; ++r) o[d][r] = 0.f;
    bf16x8 qr[8];
    { const bf16_t* Qw = Qb + (size_t)(wid * 32 + r32) * ldq + hi * 8;
#pragma unroll
      for (int d0 = 0; d0 < 8; ++d0) qr[d0] = *(const GAS bf16x8*)(Qw + d0 * 16); }
    if (NA) { for (int idx = tid; idx < 15 * 128; idx += NTHREADS) { const int dr7 = idx >> 7, dcc = (idx & 127) - 63;
                  tab[idx] = (dcc >= -15 && dcc <= 15) ? ((const GAS float*)rpb)[dr7 * 31 + dcc + 15] * LOG2E : 0.f; } }
    const int sr = tid >> 4, sc = (tid & 15) * 8, vst0 = v_st(sr, sc), vst1 = v_st(32 + sr, sc), kst0 = KSWZ(sr, sc * 2), kst1 = KSWZ(32 + sr, sc * 2);
    const int vb0 = (int)(uintptr_t)(V_lds) + v_rd_base(lane);
    const int NT = T.nt0 + T.nt1;
    bf16x8 vs0, vs1, ks0, ks1;
#define ATT_SLOAD(t) do { const bool g0 = (t) < T.nt0; const int tt = g0 ? (t) : (t) - T.nt0; const int ld = g0 ? T.ld0 : T.ld1; \
        const bf16_t* Kp = (g0 ? T.K0 : T.K1) + (size_t)tt * 64 * ld; const bf16_t* Vp = (g0 ? T.V0 : T.V1) + (size_t)tt * 64 * ld; \
        vs0 = *(const GAS bf16x8*)(Vp + (size_t)sr * ld + sc); vs1 = *(const GAS bf16x8*)(Vp + (size_t)(32 + sr) * ld + sc); \
        ks0 = *(const GAS bf16x8*)(Kp + (size_t)sr * ld + sc); ks1 = *(const GAS bf16x8*)(Kp + (size_t)(32 + sr) * ld + sc); } while (0)
#define ATT_SWRITE(b) do { *(LAS bf16x8*)(V_lds + (b) * SHM_V + vst0) = vs0; *(LAS bf16x8*)(V_lds + (b) * SHM_V + vst1) = vs1; \
        *(LAS bf16x8*)(K_lds + (b) * SHM_K + kst0) = ks0; *(LAS bf16x8*)(K_lds + (b) * SHM_K + kst1) = ks1; } while (0)
    ATT_SLOAD(0); ATT_SWRITE(0);
    __syncthreads();
    const int qrow = qrow0 + (wid >> 1), qc = 32 * (wid & 1) + r32;
    const int r0w = min(max(qrow - 4, 0), GW - 8), c0 = min(max(qc - 8, 0), GW - 16);
    for (int t = 0; t < NT; ++t) {
        const int buf = t & 1;
        if (t + 1 < NT) ATT_SLOAD(t + 1);
        bool active = true; int dr = 0;
        if (NA && t >= T.nt0) { const int kr = kr0 + (t - T.nt0); active = (kr >= r0w) && (kr < r0w + 8); dr = kr - qrow; }
        if (active) {
            f32x16 p0, p1;
#pragma unroll
            for (int r = 0; r < 16; ++r) { p0[r] = 0.f; p1[r] = 0.f; }
            { LAS const char* Ks = K_lds + buf * SHM_K;
              __builtin_amdgcn_s_setprio(1);
#pragma unroll
              for (int d0 = 0; d0 < 8; ++d0) { const int cb = (d0 * 16 + hi * 8) * 2;
                  const bf16x8 b0 = *(LAS const bf16x8*)(Ks + KSWZ(r32, cb)); const bf16x8 b1 = *(LAS const bf16x8*)(Ks + KSWZ(32 + r32, cb));
                  p0 = __builtin_amdgcn_mfma_f32_32x32x16_bf16(b0, qr[d0], p0, 0, 0, 0); p1 = __builtin_amdgcn_mfma_f32_32x32x16_bf16(b1, qr[d0], p1, 0, 0, 0); }
              __builtin_amdgcn_s_setprio(0); }
            if (NA && t >= T.nt0) {
                LAS const float* brow = tab + (dr + 7) * 128 + 63 - qc + 4 * hi;
#pragma unroll
                for (int r = 0; r < 16; ++r) { const int kq = (r & 3) + 8 * (r >> 2); const int kc = kq + 4 * hi;
                    const float b0 = brow[kq], b1 = brow[kq + 32];
                    p0[r] = ((unsigned)(kc - c0) < 16u) ? p0[r] + b0 : -INFINITY; p1[r] = ((unsigned)(kc + 32 - c0) < 16u) ? p1[r] + b1 : -INFINITY; }
            }
            float pmax = p0[0];
#pragma unroll
            for (int r = 1; r < 16; ++r) pmax = fmaxf(pmax, p0[r]);
#pragma unroll
            for (int r = 0; r < 16; ++r) pmax = fmaxf(pmax, p1[r]);
            { auto rr = __builtin_amdgcn_permlane32_swap(__float_as_uint(pmax), __float_as_uint(pmax), false, false); pmax = fmaxf(__uint_as_float(rr[0]), __uint_as_float(rr[1])); }
            const float mn = fmaxf(m_reg, pmax), alpha = __builtin_amdgcn_exp2f(m_reg - mn); m_reg = mn;
            float ps = 0.f;
#pragma unroll
            for (int r = 0; r < 16; ++r) { p0[r] = __builtin_amdgcn_exp2f(p0[r] - mn); p1[r] = __builtin_amdgcn_exp2f(p1[r] - mn); ps += p0[r] + p1[r]; }
            { auto rr = __builtin_amdgcn_permlane32_swap(__float_as_uint(ps), __float_as_uint(ps), false, false); ps = __uint_as_float(rr[0]) + __uint_as_float(rr[1]); }
            l_reg = l_reg * alpha + ps;
            bf16x8 pa0, pa1, pa2, pa3;
#define ATT_PK4(P, BASE, OUT) do { unsigned a0 = cvt_pk_bf16(P[BASE + 0], P[BASE + 1]), a1 = cvt_pk_bf16(P[BASE + 2], P[BASE + 3]);   \
    unsigned b0 = cvt_pk_bf16(P[BASE + 4], P[BASE + 5]), b1 = cvt_pk_bf16(P[BASE + 6], P[BASE + 7]);                              \
    auto r0_ = __builtin_amdgcn_permlane32_swap(a0, b0, false, false); auto r1_ = __builtin_amdgcn_permlane32_swap(a1, b1, false, false); \
    u32x4 w_ = {r0_[0], r1_[0], r0_[1], r1_[1]}; OUT = *reinterpret_cast<bf16x8*>(&w_); } while (0)
            ATT_PK4(p0, 0, pa0); ATT_PK4(p0, 8, pa1); ATT_PK4(p1, 0, pa2); ATT_PK4(p1, 8, pa3);
#undef ATT_PK4
            if (__any(alpha < 1.f)) { if (hi == 0) al_l[r32] = alpha; asm volatile("s_waitcnt lgkmcnt(0)" ::: "memory");
#pragma unroll
                for (int r = 0; r < 16; ++r) { const float a = al_l[crow(r, hi)];
#pragma unroll
                    for (int d = 0; d < 4; ++d) o[d][r] *= a; } }
            const int vb = vb0 + buf * SHM_V;
            __builtin_amdgcn_s_setprio(1);
            pv_one<0>(o[0], vb, pa0, pa1, pa2, pa3); pv_one<1>(o[1], vb, pa0, pa1, pa2, pa3); pv_one<2>(o[2], vb, pa0, pa1, pa2, pa3); pv_one<3>(o[3], vb, pa0, pa1, pa2, pa3);
            __builtin_amdgcn_s_setprio(0);
        }
        if (t + 1 < NT) ATT_SWRITE(buf ^ 1);
        __syncthreads();
    }
#undef ATT_SLOAD
#undef ATT_SWRITE
    if (hi == 0) li_l[r32] = l_reg;
    asm volatile("s_waitcnt lgkmcnt(0)" ::: "memory");
    bf16_t* Ow = Ob + (size_t)(wid * 32) * ldo;
#pragma unroll
    for (int r = 0; r < 16; ++r) { const int orow = crow(r, hi); const float rl = __builtin_amdgcn_rcpf(li_l[orow]);
#pragma unroll
        for (int d0 = 0; d0 < 4; ++d0) ((GAS bf16_t*)Ow)[(size_t)orow * ldo + d0 * 32 + r32] = (bf16_t)(cvt_pk_bf16(o[d0][r] * rl, 0.f) & 0xffffu); }
    __syncthreads();
}
}

__device__ __forceinline__ void dft4(float& r0, float& i0, float& r1, float& i1, float& r2, float& i2, float& r3, float& i3) {
    const float t0r = r0 + r2, t0i = i0 + i2, t1r = r0 - r2, t1i = i0 - i2, t2r = r1 + r3, t2i = i1 + i3, t3r = r1 - r3, t3i = i1 - i3;
    r0 = t0r + t2r; i0 = t0i + t2i; r2 = t0r - t2r; i2 = t0i - t2i; r1 = t1r + t3i; i1 = t1i - t3r; r3 = t1r - t3i; i3 = t1i + t3r;
}
__device__ __forceinline__ void fft16(float (&xr)[16], float (&xi)[16]) {
#pragma unroll
    for (int nb = 0; nb < 4; ++nb) dft4(xr[nb], xi[nb], xr[4 + nb], xi[4 + nb], xr[8 + nb], xi[8 + nb], xr[12 + nb], xi[12 + nb]);
    constexpr float C1 = 0.92387953251128674f, S1 = 0.38268343236508977f, R2 = 0.70710678118654752f;
    constexpr float TC[10] = {1.f, C1, R2, S1, 0.f, 0.f, -R2, 0.f, 0.f, -C1};
    constexpr float TS[10] = {0.f, S1, R2, C1, 1.f, 0.f, R2, 0.f, 0.f, -S1};
#pragma unroll
    for (int nb = 1; nb < 4; ++nb)
#pragma unroll
        for (int ka = 1; ka < 4; ++ka) { const float c = TC[nb * ka], sn = TS[nb * ka]; const float ar = xr[4 * ka + nb], ai = xi[4 * ka + nb];
            xr[4 * ka + nb] = ar * c + ai * sn; xi[4 * ka + nb] = ai * c - ar * sn; }
#pragma unroll
    for (int ka = 0; ka < 4; ++ka) dft4(xr[4 * ka], xi[4 * ka], xr[4 * ka + 1], xi[4 * ka + 1], xr[4 * ka + 2], xi[4 * ka + 2], xr[4 * ka + 3], xi[4 * ka + 3]);
}

struct Args { const float* in[20]; float* out; unsigned char* ws; };
enum { I_XP = 0, I_XS, I_CK, I_CV, I_C, I_CCTX, I_WMOD, I_BMOD, I_N1G, I_WIN, I_RPB, I_WPA, I_WPB, I_WOUT, I_N2G, I_WUP, I_CONVW, I_CONVB, I_WDOWN, I_NFG };

__device__ __forceinline__ void transpose_item(const float* W, int K, int N, bf16_t* WT, int ldt, int nsc, float sc, LAS float* scr, int item, int lane) {
    const int nblk = N >> 6, kb = item / nblk, nb = item - kb * nblk, k0 = kb << 6, n0 = nb << 6;
    f32x4 v[16];
    const float* src = W + (size_t)(k0 + (lane >> 4)) * N + n0 + 4 * (lane & 15);
#pragma unroll
    for (int i = 0; i < 16; ++i) v[i] = *(const f32x4*)(src + (size_t)(4 * i) * N);
#pragma unroll
    for (int i = 0; i < 16; ++i) { LAS float* d = scr + (4 * i + (lane >> 4)) * 65 + 4 * (lane & 15); d[0] = v[i][0]; d[1] = v[i][1]; d[2] = v[i][2]; d[3] = v[i][3]; }
    LDS_WAIT(); asm volatile("" ::: "memory");
    const int c = lane & 7;
#pragma unroll
    for (int j = 0; j < 8; ++j) { const int n = (lane >> 3) + 8 * j; const LAS float* s = scr + (8 * c) * 65 + n; const float f = (n0 + n) < nsc ? sc : 1.0f;
        u32x4 o; o.x = cvt_pk_bf16(s[0 * 65] * f, s[1 * 65] * f); o.y = cvt_pk_bf16(s[2 * 65] * f, s[3 * 65] * f); o.z = cvt_pk_bf16(s[4 * 65] * f, s[5 * 65] * f); o.w = cvt_pk_bf16(s[6 * 65] * f, s[7 * 65] * f);
        *(u32x4*)(WT + (size_t)(n0 + n) * ldt + k0 + 8 * c) = o; }
    LDS_WAIT(); asm volatile("" ::: "memory");
}

__global__ void __launch_bounds__(NTHREADS, 2) fwd(Args args) {
    extern __shared__ __attribute__((aligned(16))) unsigned char lds_raw[];
    LAS unsigned char* lds = (LAS unsigned char*)lds_raw;
    volatile LAS unsigned* MISC = (volatile LAS unsigned*)(lds + MISC_OFF);
    const int G = gridDim.x, bx = blockIdx.x;
    const int vcu = (G % 8 == 0) ? (bx % 8) * (G / 8) + bx / 8 : bx;
    const int NGW = G * NWAVES;
    const int wave0 = __builtin_amdgcn_readfirstlane((int)threadIdx.x >> 6);
#define OPQ_BX() unsigned mo_ = MISC_OFF + 16; asm volatile("; opaque LDS offset" : "+v"(mo_)); int bxo_ = __builtin_amdgcn_readfirstlane((int)*(volatile LAS unsigned*)(lds + mo_)); asm volatile("; opaque virtual block index" : "+s"(bxo_)); const int bx = bxo_
#define PIN_TID() const int lane = fresh_lane(), wave = fresh_wave(wave0), tid = wave * 64 + lane, gw = vcu * NWAVES + wave; (void)gw; (void)tid
    { const int tid = threadIdx.x; if (tid < 64) MISC[tid] = 0u; }
    unsigned char* ws = args.ws;
    __syncthreads();
    XcdBarrier bar = xcd_barrier_post((unsigned*)(ws + WS_CTL) + CW_BAR, MISC);
    if (threadIdx.x == 0) { const unsigned xcc = xb_xcc_id(); MISC[2] = xcc; MISC[3] = xb_add((unsigned*)(ws + WS_CTL) + CW_XRANK + 64 * xcc, 1u); MISC[4] = blockIdx.x; }
#define GRID_BAR() do { XcdBarrier b_ = bar; asm volatile("; pin bar" : "+s"(b_.bar), "+s"(b_.x)); const bool ldr_ = (fresh_wave(wave0) == 0) && (fresh_lane() == 0); for (int rb_ = 0; rb_ < REP_BAR; ++rb_) xcd_barrier(b_, ldr_); } while (0)

    float* X = args.out;
    float* OUTK = args.out + (size_t)M * D; float* OUTV = OUTK + (size_t)NB_P * DEPTH * NH * SEQ_P * HD;
    float* MODS = (float*)(ws + WS_MODS); float* SS = (float*)(ws + WS_SS); float* BIN = (float*)(ws + WS_BIAS); float* BUP = BIN + (size_t)DEPTH * 5 * IN_DIM;
    bf16_t* CKB = (bf16_t*)(ws + WS_CACHE); bf16_t* CVB = CKB + (size_t)NB_S * DEPTH * NH * PAST * HD;
    bf16_t* DC = (bf16_t*)(ws + WS_DC); bf16_t* DP = (bf16_t*)(ws + WS_DP); bf16_t* DS = (bf16_t*)(ws + WS_DS); bf16_t* U2 = (bf16_t*)(ws + WS_UP2);
    bf16_t* HB = (bf16_t*)(ws + WS_H); bf16_t* QK = (bf16_t*)(ws + WS_BIG); float* UH = (float*)(ws + WS_UH);
    bf16_t* AF = (bf16_t*)(ws + WS_AF); bf16_t* GTS = (bf16_t*)(ws + WS_GTS); bf16_t* GTP = (bf16_t*)(ws + WS_GTP);
    float* T1 = (float*)(ws + WS_T1); bf16_t* ACT = (bf16_t*)(ws + WS_ACT); bf16_t* YB = (bf16_t*)(ws + WS_Y);

    for (int rep_ = 0; rep_ < REP_P0; ++rep_) {
        PIN_TID();
#if EN_MODS
        for (int item = bx; item < DEPTH * 48; item += G) {
            const int l = item / 48, nb = item % 48;
            LAS float* sil = (LAS float*)lds; LAS float* red = (LAS float*)(lds + 5 * D * 4);
            for (int idx = tid; idx < 5 * D; idx += NTHREADS) { const int v = idx / D, k = idx % D; const float cv = v == 0 ? args.in[I_CCTX][k] : args.in[I_C][(size_t)(v - 1) * D + k];
                sil[idx] = cv * sigmoidf_fast(cv); }
            __syncthreads();
            f32x4 a5[5];
#pragma unroll
            for (int v = 0; v < 5; ++v) a5[v] = (f32x4){0.f, 0.f, 0.f, 0.f};
            const float* Wp = args.in[I_WMOD] + ((size_t)l * D + wave * 256) * (NMOD * D) + 256 * nb + 4 * lane;
            for (int k8 = 0; k8 < 256; k8 += 8) {
                f32x4 wv[8];
#pragma unroll
                for (int j = 0; j < 8; ++j) wv[j] = *(const f32x4*)(Wp + (size_t)(k8 + j) * (NMOD * D));
#pragma unroll
                for (int j = 0; j < 8; ++j)
#pragma unroll
                    for (int v = 0; v < 5; ++v) a5[v] += sil[v * D + wave * 256 + k8 + j] * wv[j];
            }
#pragma unroll
            for (int v = 0; v < 5; ++v) *(LAS f32x4*)(red + (wave * 5 + v) * 256 + 4 * lane) = a5[v];
            __syncthreads();
            for (int o = tid; o < 5 * 256; o += NTHREADS) { const int v = o >> 8, n = o & 255; float s = args.in[I_BMOD][(size_t)l * NMOD * D + 256 * nb + n];
#pragma unroll
                for (int w = 0; w < 8; ++w) s += red[(w * 5 + v) * 256 + n];
                MODS[((size_t)l * 5 + v) * (NMOD * D) + 256 * nb + n] = s; }
            __syncthreads();
        }
#endif
#if EN_WT
        {
            LAS float* scr = (LAS float*)(lds + wave * (64 * 65 * 4));
            constexpr int I_IN = (D / 64) * (IN_DIM / 64), I_PA = (AD / 64) * (D / 64), I_PB = (FD / 64) * (D / 64), I_OUT = (D / 64) * (D / 64), I_UP = (D / 64) * (FFN2 / 64), I_DOWN = (FFN / 64) * (D / 64);
            constexpr int PER_LAYER = I_IN + I_PA + I_PB + I_OUT + I_UP + I_DOWN;
            for (int it = gw; it < DEPTH * PER_LAYER; it += NGW) {
                const int l = it / PER_LAYER; int r = it - l * PER_LAYER;
                bf16_t* wt = (bf16_t*)(ws + WS_WT + (size_t)l * WT_LAYER);
                if (r < I_IN) { transpose_item(args.in[I_WIN] + (size_t)l * D * IN_DIM, D, IN_DIM, wt + WT_IN / 2, D, AD, QSCALE, scr, r, lane); continue; } r -= I_IN;
                if (r < I_PA) { transpose_item(args.in[I_WPA] + (size_t)l * AD * D, AD, D, wt + WT_PA / 2, AD + FD, 0, 1.f, scr, r, lane); continue; } r -= I_PA;
                if (r < I_PB) { transpose_item(args.in[I_WPB] + (size_t)l * FD * D, FD, D, wt + WT_PA / 2 + AD, AD + FD, 0, 1.f, scr, r, lane); continue; } r -= I_PB;
                if (r < I_OUT) { transpose_item(args.in[I_WOUT] + (size_t)l * D * D, D, D, wt + WT_OUT / 2, D, 0, 1.f, scr, r, lane); continue; } r -= I_OUT;
                if (r < I_UP) { transpose_item(args.in[I_WUP] + (size_t)l * D * FFN2, D, FFN2, wt + WT_UP / 2, D, 0, 1.f, scr, r, lane); continue; } r -= I_UP;
                transpose_item(args.in[I_WDOWN] + (size_t)l * FFN * D, FFN, D, wt + WT_DOWN / 2, FFN, 0, 1.f, scr, r, lane);
            }
        }
#endif
#if EN_MISC
        {
            const size_t n8 = (size_t)NB_S * DEPTH * NH * PAST * HD / 8;
            for (size_t i = (size_t)gw * 64 + lane; i < 2 * n8; i += (size_t)NGW * 64) { const bool isk = i < n8; const size_t j = isk ? i : i - n8;
                const float* s = (isk ? args.in[I_CK] : args.in[I_CV]) + j * 8; const f32x4 a = *(const f32x4*)s, b = *(const f32x4*)(s + 4);
                u32x4 w; w.x = cvt_pk_bf16(a[0], a[1]); w.y = cvt_pk_bf16(a[2], a[3]); w.z = cvt_pk_bf16(b[0], b[1]); w.w = cvt_pk_bf16(b[2], b[3]);
                *(u32x4*)((isk ? CKB : CVB) + j * 8) = w; }
        }
        {
            for (int i = gw * 64 + lane; i < 512 * 256 / 8; i += NGW * 64) { const int j = i >> 5, c0 = (i & 31) * 8; const bool isin = j >= 256; const int jj = j & 255;
                float v[8];
#pragma unroll
                for (int e = 0; e < 8; ++e) { const int mm = (jj * (c0 + e)) & 255; const float x = (float)mm * (1.0f / 128.0f); v[e] = (isin ? -sinpif(x) : cospif(x)) * (1.0f / 16.0f); }
                u32x4 w; w.x = cvt_pk_bf16(v[0], v[1]); w.y = cvt_pk_bf16(v[2], v[3]); w.z = cvt_pk_bf16(v[4], v[5]); w.w = cvt_pk_bf16(v[6], v[7]);
                *(u32x4*)(DC + (size_t)j * 256 + c0) = w; }
            for (int i = gw * 64 + lane; i < 256 * 512 / 8; i += NGW * 64) { const int k1 = i >> 6, c8 = (i & 63) * 8; const bool isin = c8 >= 256; const int n0 = c8 & 255;
                float v[8];
#pragma unroll
                for (int e = 0; e < 8; ++e) { const int mm = (k1 * (n0 + e)) & 255; const float x = (float)mm * (1.0f / 128.0f); v[e] = (isin ? sinpif(x) : cospif(x)) * (1.0f / 16.0f); }
                u32x4 w; w.x = cvt_pk_bf16(v[0], v[1]); w.y = cvt_pk_bf16(v[2], v[3]); w.z = cvt_pk_bf16(v[4], v[5]); w.w = cvt_pk_bf16(v[6], v[7]);
                *(u32x4*)(DP + (size_t)k1 * 512 + c8) = w;
                w.x = cvt_pk_bf16(v[0] * 0.25f, v[1] * 0.25f); w.y = cvt_pk_bf16(v[2] * 0.25f, v[3] * 0.25f); w.z = cvt_pk_bf16(v[4] * 0.25f, v[5] * 0.25f); w.w = cvt_pk_bf16(v[6] * 0.25f, v[7] * 0.25f);
                *(u32x4*)(DS + (size_t)k1 * 512 + c8) = w; }
        }
#endif
    }
    GRID_BAR();

    if (threadIdx.x == 0) {
        unsigned* rk = (unsigned*)(ws + WS_CTL) + CW_XRANK; const unsigned xcc = MISC[2], myrank = MISC[3]; unsigned npop = 0, xidx = 0; bool ok = (G % 8) == 0;
        for (unsigned j = 0; j < 16; ++j) { const unsigned cnt = xb_ld(rk + 64 * j); if (cnt) { ++npop; if (j < xcc) ++xidx; if (cnt != (unsigned)(G / 8)) ok = false; } }
        if (ok && npop == 8) { MISC[4] = myrank * 8u + xidx; MISC[5] = 1u; }
    }
    __syncthreads();
    {
        PIN_TID();
#if EN_NORM
        { const float* gvec = args.in[I_N1G];
          for (int row = gw; row < M; row += NGW) {
            const float* src = row < MP ? args.in[I_XP] + (size_t)row * D : args.in[I_XS] + (size_t)(row - MP) * D;
            f32x4 v[8]; float ssq = 0.f;
#pragma unroll
            for (int j = 0; j < 8; ++j) { v[j] = *(const GAS f32x4*)(src + 4 * (lane + 64 * j)); ssq += (v[j][0] * v[j][0] + v[j][1] * v[j][1]) + (v[j][2] * v[j][2] + v[j][3] * v[j][3]); }
            ssq = wave_sum(ssq);
            const int bv = row < MP ? 0 : 1 + ((row - MP) >> 12);
            const float* scp = MODS + ((size_t)bv * NMOD + 1) * D;
#pragma unroll
            for (int j = 0; j < 8; ++j) { const int col = 4 * (lane + 64 * j); const f32x4 g = *(const GAS f32x4*)(gvec + col), sc = *(const GAS f32x4*)(scp + col);
                const f32x4 y = v[j] * g * (sc + 1.0f); u32x2 w; w.x = cvt_pk_bf16(y[0], y[1]); w.y = cvt_pk_bf16(y[2], y[3]); *(GAS u32x2*)(HB + (size_t)row * D + col) = w; }
            if (lane == 0) SS[row] = ssq;
          } }
#endif
#if EN_MISC
        for (int l = 0; l < DEPTH; ++l) {
            LAS float* shl = (LAS float*)lds;
            __syncthreads();
            for (int idx = tid; idx < 2 * 5 * D; idx += NTHREADS) { const int w2 = idx / (5 * D), r = idx - w2 * 5 * D, bv = r / D, k = r - bv * D; shl[idx] = MODS[(((size_t)l * 5 + bv) * NMOD + (w2 ? 3 : 0)) * D + k]; }
            __syncthreads();
            const bf16_t* wt_in = (const bf16_t*)(ws + WS_WT + (size_t)l * WT_LAYER + WT_IN); const bf16_t* wt_up = (const bf16_t*)(ws + WS_WT + (size_t)l * WT_LAYER + WT_UP);
            for (int r = gw; r < IN_DIM + FFN2; r += NGW) {
                const bool isup = r >= IN_DIM; const int n = isup ? r - IN_DIM : r;
                const bf16_t* wrow = (isup ? wt_up : wt_in) + (size_t)n * D; const LAS float* sh = shl + (isup ? 5 * D : 0);
                float a5[5] = {0.f, 0.f, 0.f, 0.f, 0.f};
#pragma unroll
                for (int j = 0; j < 4; ++j) { const int k0 = 512 * j + 8 * lane; const u32x4 w = *(const GAS u32x4*)(wrow + k0);
                    float wf[8];
#pragma unroll
                    for (int e = 0; e < 4; ++e) { wf[2 * e] = bf_lo(w[e]); wf[2 * e + 1] = bf_hi(w[e]); }
#pragma unroll
                    for (int bv = 0; bv < 5; ++bv) { const f32x4 s0 = *(const LAS f32x4*)(sh + bv * D + k0), s1 = *(const LAS f32x4*)(sh + bv * D + k0 + 4);
                        a5[bv] += (wf[0] * s0[0] + wf[1] * s0[1]) + (wf[2] * s0[2] + wf[3] * s0[3]) + (wf[4] * s1[0] + wf[5] * s1[1]) + (wf[6] * s1[2] + wf[7] * s1[3]); } }
#pragma unroll
                for (int bv = 0; bv < 5; ++bv) { const float t = wave_sum(a5[bv]); if (lane == 0) { if (isup) BUP[((size_t)l * 5 + bv) * FFN2 + n] = t; else BIN[((size_t)l * 5 + bv) * IN_DIM + n] = t; } }
            }
        }
        __syncthreads();
#endif
    }
    GRID_BAR();

    for (int l = 0; l < DEPTH; ++l) {
        const float* mods_l = MODS + (size_t)l * 5 * NMOD * D;
        const unsigned char* wt = ws + WS_WT + (size_t)l * WT_LAYER;
#if EN_GIN
        {
            OPQ_BX();
            pg8::TileOrder S; S.init(M, IN_DIM, G, bx, HB, D, wt + WT_IN, D, QK, IN_DIM, 2);
            pg8::EpiIn E{OUTK, OUTV, l, SS + (size_t)(2 * l) * M, BIN + (size_t)l * 5 * IN_DIM, (const LAS float*)(lds + pg8::STAGE_BYTES)};
            for (int rep_ = 0; rep_ < REP_GIN; ++rep_)
            pg8::gemm_phase<pg8::EpiIn, pg8::TileOrder>(lds, wave0, D, D, D, S, E);
        }
#endif
        GRID_BAR();

        unsigned mo5_ = MISC_OFF + 20; asm volatile("; opaque LDS offset" : "+v"(mo5_));
        const bool merged_ok = (G == 256) && (__builtin_amdgcn_readfirstlane((int)*(volatile LAS unsigned*)(lds + mo5_)) != 0);
        unsigned* const fcnt = (unsigned*)(ws + WS_CTL) + CW_FOUR + (size_t)l * 96 * 16;
        const bool four_ok = merged_ok && (FOUR_MERGE != 0);
        {
            OPQ_BX();
#if EN_F1
            for (int rep_ = 0; rep_ < REP_FOUR; ++rep_) {
            { F1SOrder S{{four_ok, nullptr, nullptr, 0u}, G, bx, (const char*)DC, (const char*)QK, (char*)GTS}; pg8::EpiBf16U<8192> E; pg8::gemm_phase<pg8::EpiBf16U<8192>, F1SOrder>(lds, wave0, 256, IN_DIM, 256, S, E); }
            { F1POrder S{{four_ok, nullptr, nullptr, 0u}, G, bx, (const char*)DC, (const char*)QK, (char*)GTP}; pg8::EpiBf16U<512> E; pg8::gemm_phase<pg8::EpiBf16U<512>, F1POrder>(lds, wave0, 256, IN_DIM, 256, S, E); }
            }
#endif
#if EN_ATT
            for (int rep_ = 0; rep_ < REP_ATT; ++rep_)
            for (int U = bx; U < 640; U += G) {
                if (U < 512) {
                    const int b = U >> 7, h = (U >> 4) & 7, i4 = U & 15;
                    const int kr0 = max(4 * i4 - 4, 0), ntn = (i4 == 0 || i4 == 15) ? 8 : 11;
                    const size_t rowbase = (size_t)MP + (size_t)b * SEQ_S;
                    att::TileSrc T;
                    T.K0 = CKB + (((size_t)b * DEPTH + l) * NH + h) * PAST * HD; T.V0 = CVB + (((size_t)b * DEPTH + l) * NH + h) * PAST * HD; T.ld0 = HD; T.nt0 = 4;
                    T.K1 = QK + (rowbase + (size_t)kr0 * GW) * IN_DIM + 1024 + h * HD; T.V1 = T.K1 + 1024; T.ld1 = IN_DIM; T.nt1 = ntn;
                    att::attn_unit<true>((LAS char*)lds, wave0, QK + (rowbase + (size_t)i4 * 256) * IN_DIM + h * HD, IN_DIM, T, kr0, 4 * i4,
                                         args.in[I_RPB] + ((size_t)l * NH + h) * 15 * 31, AF + (rowbase + (size_t)i4 * 256) * D + h * HD, D);
                } else {
                    const int bh = U - 512, b = bh >> 3, h = bh & 7;
                    att::TileSrc T;
                    T.K0 = QK + ((size_t)b * SEQ_P) * IN_DIM + 1024 + h * HD; T.V0 = T.K0 + 1024; T.ld0 = IN_DIM; T.nt0 = 4;
                    T.K1 = T.K0; T.V1 = T.V0; T.ld1 = IN_DIM; T.nt1 = 0;
                    att::attn_unit<false>((LAS char*)lds, wave0, QK + ((size_t)b * SEQ_P) * IN_DIM + h * HD, IN_DIM, T, 0, 0, nullptr, AF + ((size_t)b * SEQ_P) * D + h * HD, D);
                }
            }
#endif
            if (four_ok) {
                asm volatile("s_waitcnt vmcnt(0)" ::: "memory");
                if (fresh_lane() == 0) { const int x_ = bx & 7, k_ = bx >> 3;
                    __hip_atomic_fetch_add((GAS unsigned*)(fcnt + (2 * x_) * 16), 1u, __ATOMIC_RELAXED, __HIP_MEMORY_SCOPE_AGENT);
                    __hip_atomic_fetch_add((GAS unsigned*)(fcnt + (2 * x_ + 1) * 16), 1u, __ATOMIC_RELAXED, __HIP_MEMORY_SCOPE_AGENT);
                    if (k_ >= 16) __hip_atomic_fetch_add((GAS unsigned*)(fcnt + (16 + 8 * x_ + ((k_ - 16) >> 1)) * 16), 1u, __ATOMIC_RELAXED, __HIP_MEMORY_SCOPE_AGENT); }
            }
        }
        if (!four_ok || FOUR_KEEPBAR) GRID_BAR();

#if EN_F2
        {
            PIN_TID();
            OPQ_BX();
            if (four_ok) {
                unsigned sp = 0;
                for (int q = 0; q < 2; ++q) { GAS unsigned* fp = (GAS unsigned*)(fcnt + (2 * (bx & 7) + q) * 16);
                    while ((unsigned)__builtin_amdgcn_readfirstlane(__hip_atomic_load(fp, __ATOMIC_RELAXED, __HIP_MEMORY_SCOPE_AGENT)) < 256u) { __builtin_amdgcn_s_sleep(2); if (++sp > (1u << 20)) break; } }
                __builtin_amdgcn_fence(__ATOMIC_ACQUIRE, "agent"); asm volatile("s_waitcnt vmcnt(0)" ::: "memory");
            }
            for (int rep_ = 0; rep_ < REP_FOUR; ++rep_)
            for (int jt = 0; ; ++jt) {
                int it;
                if (four_ok) { if (jt >= 4) break; const int li = (bx >> 3) * NWAVES + wave + 256 * jt; it = ((2 * (bx & 7) + (li >> 9)) << 9) + (li & 511); }
                else { it = gw + jt * NGW; if (it >= 16 * 256 * 2) break; }
                const int row = it >> 1, half = it & 1;
                const char* src = (const char*)GTS + (size_t)row * 8192 * 2 + (unsigned)(half * 256 + lane * 4);
                unsigned zr[16], zi[16];
#pragma unroll
                for (int n2 = 0; n2 < 16; ++n2) { zr[n2] = *(const GAS unsigned*)(src + n2 * 512); zi[n2] = *(const GAS unsigned*)(src + 8192 + n2 * 512); }
                unsigned orr[16], oii[16];
#pragma unroll
                for (int j = 0; j < 2; ++j) {
                    float xr[16], xi[16];
#pragma unroll
                    for (int n2 = 0; n2 < 16; ++n2) { xr[n2] = j ? bf_hi(zr[n2]) : bf_lo(zr[n2]); xi[n2] = j ? bf_hi(zi[n2]) : bf_lo(zi[n2]); }
                    fft16(xr, xi);
                    float s1, c1; sincospif((float)(128 * half + 2 * lane + j) * (1.0f / 2048.0f), &s1, &c1);
                    float wr = 1.f, wi = 0.f;
#pragma unroll
                    for (int k2 = 0; k2 < 16; ++k2) { const int slot = 4 * (k2 & 3) + (k2 >> 2);
                        const float ur = xr[slot] * wr - xi[slot] * wi, ui = xr[slot] * wi + xi[slot] * wr;
                        if (j == 0) { orr[k2] = __float_as_uint(ur); oii[k2] = __float_as_uint(ui); }
                        else { orr[k2] = cvt_pk_bf16(__uint_as_float(orr[k2]), ur); oii[k2] = cvt_pk_bf16(__uint_as_float(oii[k2]), ui); }
                        const float nwr = wr * c1 + wi * s1, nwi = wi * c1 - wr * s1; wr = nwr; wi = nwi; }
                }
                const int bg = row >> 8, c = row & 255;
                char* dst = (char*)U2 + ((size_t)(bg * 16) * 256 + c) * 512 * 2 + (unsigned)(half * 256 + lane * 4);
#pragma unroll
                for (int k2 = 0; k2 < 16; ++k2) { *(GAS unsigned*)(dst + (size_t)k2 * 256 * 512 * 2) = orr[k2]; *(GAS unsigned*)(dst + (size_t)k2 * 256 * 512 * 2 + 512) = oii[k2]; }
            }
            if (four_ok) { asm volatile("s_waitcnt vmcnt(0)" ::: "memory");
                if (fresh_lane() == 0) { __hip_atomic_fetch_add((GAS unsigned*)(fcnt + (80 + 2 * (bx & 7)) * 16), 2u, __ATOMIC_RELAXED, __HIP_MEMORY_SCOPE_AGENT);
                                         __hip_atomic_fetch_add((GAS unsigned*)(fcnt + (81 + 2 * (bx & 7)) * 16), 2u, __ATOMIC_RELAXED, __HIP_MEMORY_SCOPE_AGENT); } }
        }
#endif
        if (!four_ok || FOUR_KEEPBAR) GRID_BAR();

#if EN_F2
        {
            OPQ_BX();
            for (int rep_ = 0; rep_ < REP_FOUR; ++rep_) {
            { F2SOrder S{{four_ok, nullptr, fcnt + 80 * 16, 512u}, G, bx, (const char*)DS, (const char*)U2, (char*)AF}; pg8::EpiBf16U<16 * D> E; pg8::gemm_phase<pg8::EpiBf16U<16 * D>, F2SOrder>(lds, wave0, 512, 512, 512, S, E); }
            { F2POrder S{{four_ok, nullptr, fcnt + 16 * 16, 16u}, G, bx, (const char*)DP, (const char*)GTP, (char*)AF}; pg8::EpiBf16U<D> E; pg8::gemm_phase<pg8::EpiBf16U<D>, F2POrder>(lds, wave0, 512, 512, 512, S, E); }
            }
        }
#endif
        GRID_BAR();

        if (merged_ok) {
            OPQ_BX();
            pg8::PabOutOrder S{bx, (const char*)AF, (const char*)(wt + WT_PA), (const char*)YB, (const char*)(wt + WT_OUT), (unsigned*)(ws + WS_CTL) + CW_PANEL + (size_t)l * 80 * 16};
            pg8::EpiPabOut E{pg8::EpiPab{QK, YB},
                             pg8::EpiRes{args.in[I_XP], args.in[I_XS], X, mods_l, 2, l == 0, X, true, args.in[I_N2G] + (size_t)l * D, mods_l + 4 * D, SS + (size_t)(2 * l + 1) * M, HB, (const LAS float*)(lds + pg8::STAGE_BYTES)}};
            pg8::gemm_phase<pg8::EpiPabOut, pg8::PabOutOrder>(lds, wave0, D, D, D, S, E);
        } else {
#if EN_PAB
        {
            OPQ_BX();
            for (int rep_ = 0; rep_ < REP_PAB; ++rep_) {
            pg8::TileOrder S; S.init(M, D, G, bx, AF, D, wt + WT_PA, AD + FD, YB, D, 2); S.half_tail(); pg8::EpiPab E{QK, YB}; pg8::gemm_phase<pg8::EpiPab, pg8::TileOrder>(lds, wave0, D, AD + FD, AD + FD, S, E);
            }
        }
#endif
        GRID_BAR();

#if EN_OUT
        {
            OPQ_BX();
            pg8::TileOrder S; S.init(M, D, G, bx, YB, D, wt + WT_OUT, D, X, D, 4); S.half_tail();
            pg8::EpiRes E{args.in[I_XP], args.in[I_XS], X, mods_l, 2, l == 0, X, true, args.in[I_N2G] + (size_t)l * D, mods_l + 4 * D, SS + (size_t)(2 * l + 1) * M, HB, (const LAS float*)(lds + pg8::STAGE_BYTES)};
            for (int rep_ = 1; rep_ < REP_OUT; ++rep_) { pg8::EpiRes E2{args.in[I_XP], args.in[I_XS], X, mods_l, 2, l == 0, (float*)QK, false, nullptr, nullptr, nullptr, nullptr, (const LAS float*)(lds + pg8::STAGE_BYTES)}; pg8::gemm_phase<pg8::EpiRes, pg8::TileOrder>(lds, wave0, D, D, D, S, E2); }
            pg8::gemm_phase<pg8::EpiRes, pg8::TileOrder>(lds, wave0, D, D, D, S, E);
        }
#endif
        }
        GRID_BAR();

#if EN_UP
        {
            OPQ_BX();
            pg8::UpOrder S; S.init(G, bx, HB, wt + WT_UP, ACT);
            pg8::EpiUpConv E{args.in[I_CONVW] + (size_t)l * 3 * FFN2, args.in[I_CONVB] + (size_t)l * FFN2, UH, SS + (size_t)(2 * l + 1) * M, BUP + (size_t)l * 5 * FFN2, (const LAS float*)(lds + pg8::STAGE_BYTES)};
            for (int rep_ = 0; rep_ < REP_UP; ++rep_)
            pg8::gemm_phase<pg8::EpiUpConv, pg8::UpOrder>(lds, wave0, D, D, D, S, E);
        }
#endif
        GRID_BAR();

#if EN_CONV
        {
            PIN_TID();
            const float* cw = args.in[I_CONVW] + (size_t)l * 3 * FFN2; const float* cb = args.in[I_CONVB] + (size_t)l * FFN2;
            for (int rep_ = 0; rep_ < REP_THIN; ++rep_)
            for (int it = gw; it < (M / 256) * 4 * 11; it += NGW) {
                const int pm = it / 44, rem = it - pm * 44, t = rem / 11, cc = rem - t * 11, j0 = cc * 512 + lane * 8;
                const int row = pm * 256 + (t == 0 ? 0 : t == 1 ? 127 : t == 2 ? 128 : 255);
                const int seqmask = row < MP ? (SEQ_P - 1) : (SEQ_S - 1);
                const int sc_ = t == 0 ? 0 : t == 1 ? 3 : t == 2 ? 4 : 7;
                const bool zprev = (t == 0) && ((row & seqmask) == 0), znext = (t == 3) && ((row & seqmask) == seqmask);
                const float* pc = UH + ((size_t)pm * 8 + sc_) * FFN2 + j0;
                const float* pp = (t == 0) ? UH + ((size_t)(pm - 1) * 8 + 7) * FFN2 + j0 : pc - FFN2;
                const float* pn = (t == 3) ? UH + ((size_t)(pm + 1) * 8 + 0) * FFN2 + j0 : pc + FFN2;
                float o[8];
#pragma unroll
                for (int h = 0; h < 2; ++h) {
                    const f32x4 z4 = {0.f, 0.f, 0.f, 0.f};
                    const f32x4 ap = zprev ? z4 : *(const GAS f32x4*)(pp + 4 * h), ac = *(const GAS f32x4*)(pc + 4 * h), an = znext ? z4 : *(const GAS f32x4*)(pn + 4 * h);
                    const f32x4 gp = zprev ? z4 : *(const GAS f32x4*)(pp + FFN + 4 * h), gc = *(const GAS f32x4*)(pc + FFN + 4 * h), gn = znext ? z4 : *(const GAS f32x4*)(pn + FFN + 4 * h);
                    const f32x4 wa0 = *(const GAS f32x4*)(cw + j0 + 4 * h), wa1 = *(const GAS f32x4*)(cw + FFN2 + j0 + 4 * h), wa2 = *(const GAS f32x4*)(cw + 2 * FFN2 + j0 + 4 * h), ba = *(const GAS f32x4*)(cb + j0 + 4 * h);
                    const f32x4 wg0 = *(const GAS f32x4*)(cw + FFN + j0 + 4 * h), wg1 = *(const GAS f32x4*)(cw + FFN2 + FFN + j0 + 4 * h), wg2 = *(const GAS f32x4*)(cw + 2 * FFN2 + FFN + j0 + 4 * h), bg = *(const GAS f32x4*)(cb + FFN + j0 + 4 * h);
#pragma unroll
                    for (int e = 0; e < 4; ++e) { const float A = wa0[e] * ap[e] + wa1[e] * ac[e] + wa2[e] * an[e] + ba[e], Gv = wg0[e] * gp[e] + wg1[e] * gc[e] + wg2[e] * gn[e] + bg[e];
                        o[4 * h + e] = Gv * sigmoidf_fast(Gv) * A; }
                }
                u32x4 w; w.x = cvt_pk_bf16(o[0], o[1]); w.y = cvt_pk_bf16(o[2], o[3]); w.z = cvt_pk_bf16(o[4], o[5]); w.w = cvt_pk_bf16(o[6], o[7]);
                *(GAS u32x4*)(ACT + (size_t)row * FFN + j0) = w;
            }
        }
#endif
        GRID_BAR();

#if EN_DOWN
        {
            OPQ_BX();
            pg8::TileOrder S; S.init(M, D, G, bx, ACT, FFN, wt + WT_DOWN, FFN, X, D, 4); S.split_tail(40, (unsigned*)(ws + WS_CTL) + CW_FLAG + (size_t)l * 128 * 16);
            const int ln = l + 1 < DEPTH ? l + 1 : l;
            pg8::EpiRes E{args.in[I_XP], args.in[I_XS], X, mods_l, 5, false, X, l + 1 < DEPTH, args.in[I_N1G] + (size_t)ln * D, MODS + (size_t)ln * 5 * NMOD * D + 1 * D, SS + (size_t)(2 * ln) * M, HB, (const LAS float*)(lds + pg8::STAGE_BYTES)};
            for (int rep_ = 1; rep_ < REP_DOWN; ++rep_) { pg8::EpiRes E2{args.in[I_XP], args.in[I_XS], X, mods_l, 5, false, (float*)QK, false, nullptr, nullptr, nullptr, nullptr, (const LAS float*)(lds + pg8::STAGE_BYTES)}; pg8::gemm_phase<pg8::EpiRes, pg8::TileOrder>(lds, wave0, FFN, FFN, FFN, S, E2); }
            pg8::gemm_phase<pg8::EpiRes, pg8::TileOrder>(lds, wave0, FFN, FFN, FFN, S, E);
        }
#endif
        GRID_BAR();
    }

#if EN_FINAL
    {
        PIN_TID();
        const float* gvec = args.in[I_NFG];
        for (int row = gw; row < M; row += NGW) {
            float* src = X + (size_t)row * D;
            f32x4 v[8]; float ss = 0.f;
#pragma unroll
            for (int j = 0; j < 8; ++j) { v[j] = *(const f32x4*)(src + 4 * (lane + 64 * j)); ss += (v[j][0] * v[j][0] + v[j][1] * v[j][1]) + (v[j][2] * v[j][2] + v[j][3] * v[j][3]); }
            const float rstd = rsqrtf(wave_sum(ss) * (1.0f / D) + RMS_EPS);
#pragma unroll
            for (int j = 0; j < 8; ++j) { const int col = 4 * (lane + 64 * j); const f32x4 g = *(const f32x4*)(gvec + col); *(f32x4*)(src + col) = (v[j] * rstd) * g; }
        }
    }
#endif
}

extern "C" void kernel_launch(void* const* d_in, const int* in_sizes, int n_in, void* d_out, int out_size, void* d_ws, size_t ws_size, hipStream_t stream) {
    static int grid = 0;
    if (grid == 0) {
        if (n_in != 20 || in_sizes[0] != MP * D || in_sizes[1] != MS * D || ws_size < WS_END) {
            fprintf(stderr, "kernel_launch: shape mismatch: n_in %d in0 %d in1 %d out %d ws %zu (need >= %zu); nothing launched\n", n_in, n_in > 0 ? in_sizes[0] : -1, n_in > 1 ? in_sizes[1] : -1, out_size, ws_size, (size_t)WS_END); grid = -1; return; }
        int dev = 0, cus = 0, per_cu = 0;
        if (hipGetDevice(&dev) != hipSuccess || hipDeviceGetAttribute(&cus, hipDeviceAttributeMultiprocessorCount, dev) != hipSuccess) { fprintf(stderr, "kernel_launch: device query failed\n"); grid = -1; return; }
        if (hipFuncSetAttribute((const void*)fwd, hipFuncAttributeMaxDynamicSharedMemorySize, LDS_BYTES) != hipSuccess) { fprintf(stderr, "kernel_launch: hipFuncSetAttribute failed\n"); grid = -1; return; }
        if (hipOccupancyMaxActiveBlocksPerMultiprocessor(&per_cu, (const void*)fwd, NTHREADS, LDS_BYTES) != hipSuccess || per_cu < 1)
            fprintf(stderr, "kernel_launch: note: occupancy query reports %d workgroups per CU\n", per_cu);
        (void)hipGetLastError();
        grid = cus;
    }
    if (grid < 0) return;
    if (hipMemsetAsync((char*)d_ws + WS_CTL, 0, CTL_ZERO_BYTES, stream) != hipSuccess) { fprintf(stderr, "kernel_launch: memset failed\n"); return; }
    Args a{};
    for (int i = 0; i < 20; ++i) a.in[i] = (const float*)d_in[i];
    a.out = (float*)d_out; a.ws = (unsigned char*)d_ws;
    hipLaunchKernelGGL(fwd, dim3(grid), dim3(NTHREADS), LDS_BYTES, stream, a);
    const hipError_t le = hipPeekAtLastError();
    if (le != hipSuccess) fprintf(stderr, "kernel_launch: launch failed: %s\n", hipGetErrorName(le));
}
```

```cpp
#include <hip/hip_runtime.h>
#include <cstdio>
#include <cstdint>

#define GAS __attribute__((address_space(1)))
#define LAS __attribute__((address_space(3)))
typedef unsigned short bf16_t;
typedef short bf16x8 __attribute__((ext_vector_type(8)));
typedef short s16x4 __attribute__((ext_vector_type(4)));
typedef float f32x4 __attribute__((ext_vector_type(4)));
typedef float f32x2 __attribute__((ext_vector_type(2)));
typedef float f32x16 __attribute__((ext_vector_type(16)));
typedef unsigned u32x4 __attribute__((ext_vector_type(4)));
typedef unsigned u32x2 __attribute__((ext_vector_type(2)));

#ifndef EN_MODS
#define EN_MODS 1
#endif
#ifndef EN_WT
#define EN_WT 1
#endif
#ifndef EN_MISC
#define EN_MISC 1
#endif
#ifndef EN_NORM
#define EN_NORM 1
#endif
#ifndef EN_GIN
#define EN_GIN 1
#endif
#ifndef EN_ATT
#define EN_ATT 1
#endif
#ifndef EN_F1
#define EN_F1 1
#endif
#ifndef EN_F2
#define EN_F2 1
#endif
#ifndef EN_PAB
#define EN_PAB 1
#endif
#ifndef EN_OUT
#define EN_OUT 1
#endif
#ifndef EN_UP
#define EN_UP 1
#endif
#ifndef EN_CONV
#define EN_CONV 1
#endif
#ifndef EN_DOWN
#define EN_DOWN 1
#endif
#ifndef EN_FINAL
#define EN_FINAL 1
#endif
#ifndef REP_P0
#define REP_P0 1
#endif
#ifndef FOUR_MERGE
#define FOUR_MERGE 0
#endif
#ifndef FOUR_KEEPBAR
#define FOUR_KEEPBAR 0
#endif
#ifndef REP_ATT
#define REP_ATT 1
#endif
#ifndef REP_THIN
#define REP_THIN 1
#endif
#ifndef REP_GIN
#define REP_GIN 1
#endif
#ifndef REP_BAR
#define REP_BAR 1
#endif
#ifndef REP_OUT
#define REP_OUT 1
#endif
#ifndef REP_DOWN
#define REP_DOWN 1
#endif
#ifndef REP_PAB
#define REP_PAB 1
#endif
#ifndef REP_FOUR
#define REP_FOUR 1
#endif
#ifndef REP_UP
#define REP_UP 1
#endif
constexpr int D = 2048, NB_P = 16, SEQ_P = 256, DEPTH = 4, NB_S = 4, SEQ_S = 4096, PAST = 256;
constexpr int MP = NB_P * SEQ_P;
constexpr int MS = NB_S * SEQ_S;
constexpr int M = MP + MS;
constexpr int NH = 8, HD = 128, AD = 1024, FD = 1024, FFN = 5632, FFN2 = 11264, IN_DIM = 8192, NMOD = 6;
constexpr int GW = 64;
constexpr float RMS_EPS = 1e-6f;
constexpr float QSCALE = 0.08838834764831845f * 1.4426950408889634f;
constexpr float LOG2E = 1.4426950408889634f;

constexpr size_t MiB = 1u << 20;
constexpr size_t WS_CTL = 0, CTL_ZERO_BYTES = 2 * MiB;
constexpr size_t WS_SS = 1 * MiB;
constexpr size_t WS_MODS = 2 * MiB;
constexpr size_t WS_BIAS = 3 * MiB;
constexpr size_t WS_CACHE = 5 * MiB;
constexpr size_t WS_DC = 21 * MiB;
constexpr size_t WS_DP = WS_DC + 256 * 1024;
constexpr size_t WS_DS = WS_DP + 256 * 1024;
constexpr size_t WS_UP2 = 22 * MiB;
constexpr size_t WS_WT = 86 * MiB;
constexpr size_t WT_IN = 0, WT_PA = (size_t)IN_DIM * D * 2, WT_PB = WT_PA + (size_t)D * AD * 2, WT_OUT = WT_PB + (size_t)D * FD * 2,
                 WT_UP = WT_OUT + (size_t)D * D * 2, WT_DOWN = WT_UP + (size_t)FFN2 * D * 2, WT_LAYER = WT_DOWN + (size_t)D * FFN * 2;
static_assert(WT_LAYER == 114 * MiB, "weight copy size");
constexpr size_t WS_H = WS_WT + 4 * WT_LAYER;
constexpr size_t WS_BIG = WS_H + 80 * MiB;
constexpr size_t WS_UH = WS_BIG + 320 * MiB;
constexpr size_t WS_AF = WS_BIG + 440 * MiB;
constexpr size_t WS_GTS = WS_AF + 80 * MiB;
constexpr size_t WS_GTP = WS_GTS + 64 * MiB;
constexpr size_t WS_T1 = WS_GTP + 16 * MiB;
constexpr size_t WS_ACT = WS_AF;
constexpr size_t WS_Y = WS_T1 + 160 * MiB;
constexpr size_t WS_END = WS_Y + 80 * MiB;
static_assert(WS_END <= 1536 * MiB, "workspace map");
static_assert((size_t)M * FFN * 2 <= 320 * MiB, "act overlay");

constexpr int CW_FLAG = 65536;
constexpr int CW_FOUR = 131072;
constexpr int CW_PANEL = 98304;
constexpr int CW_XRANK = 32768;
constexpr int CW_BAR = 4096;

constexpr int LDS_BYTES = 163840;
constexpr int MISC_OFF = LDS_BYTES - 256;
constexpr int NWAVES = 8, NTHREADS = 512;

#define LDS_WAIT() asm volatile("s_waitcnt lgkmcnt(0)" ::: "memory")
#define VM_WAIT() asm volatile("s_waitcnt vmcnt(0)" ::: "memory")
__device__ __forceinline__ unsigned cvt_pk_bf16(float lo, float hi) { unsigned r; asm volatile("v_cvt_pk_bf16_f32 %0, %1, %2" : "=v"(r) : "v"(lo), "v"(hi)); return r; }
__device__ __forceinline__ float bf_lo(unsigned w) { return __uint_as_float(w << 16); }
__device__ __forceinline__ float bf_hi(unsigned w) { return __uint_as_float(w & 0xffff0000u); }
__device__ __forceinline__ float sigmoidf_fast(float x) { return __builtin_amdgcn_rcpf(1.0f + __expf(-x)); }
template <int CTRL> __device__ __forceinline__ float dpp_add(float v) { return v + __int_as_float(__builtin_amdgcn_update_dpp(0, __float_as_int(v), CTRL, 0xf, 0xf, true)); }
__device__ __forceinline__ float wave_sum(float v) {
    v = dpp_add<0xB1>(v);
    v = dpp_add<0x4E>(v);
    v = dpp_add<0x141>(v);
    v = dpp_add<0x140>(v);
    const float s0 = __int_as_float(__builtin_amdgcn_readlane(__float_as_int(v), 0)), s1 = __int_as_float(__builtin_amdgcn_readlane(__float_as_int(v), 16));
    const float s2 = __int_as_float(__builtin_amdgcn_readlane(__float_as_int(v), 32)), s3 = __int_as_float(__builtin_amdgcn_readlane(__float_as_int(v), 48));
    return (s0 + s1) + (s2 + s3);
}
__device__ __forceinline__ int fresh_wave(int w) { asm volatile("; opaque wave index" : "+s"(w)); return w; }
__device__ __forceinline__ int fresh_lane() { int l; asm volatile("v_mbcnt_lo_u32_b32 %0, -1, 0\n\tv_mbcnt_hi_u32_b32 %0, -1, %0" : "=v"(l)); return l; }

#define XB_TMO      128
#define XB_XCNT(j)  (256  + 64 * (j))
#define XB_XSUB(j)  (1280 + 64 * (j))
#define XB_XGEN(j)  (2304 + 64 * (j))
#define XB_TOP      3328
#define XB_TOPGEN   3392
#define XCD_BAR_WORDS 3456
#define XB_SPIN_CAP (1u << 18)
__device__ __forceinline__ unsigned xb_ld(unsigned* p)              { return __hip_atomic_load((GAS unsigned*)p, __ATOMIC_RELAXED, __HIP_MEMORY_SCOPE_AGENT); }
__device__ __forceinline__ unsigned xb_add(unsigned* p, unsigned v) { return __hip_atomic_fetch_add((GAS unsigned*)p, v, __ATOMIC_RELAXED, __HIP_MEMORY_SCOPE_AGENT); }
__device__ __forceinline__ unsigned xb_xcc_id() { return (unsigned)__builtin_amdgcn_s_getreg((3 << 11) | 20) & 0xFu; }
#define XB_SPIN(cond, bar) do { unsigned _sp = 0; while (cond) { __builtin_amdgcn_s_sleep(1); \
    if ((++_sp & 255u) == 0u) { if (xb_ld(&(bar)[XB_TMO])) break; if (_sp > XB_SPIN_CAP) { xb_add(&(bar)[XB_TMO], 1u); break; } } } } while (0)
struct XcdBarrier { unsigned* bar; unsigned x; volatile LAS unsigned* st; };
__device__ __forceinline__ XcdBarrier xcd_barrier_post(unsigned* bar, volatile LAS unsigned* st) {
    XcdBarrier b; b.bar = bar; b.x = xb_xcc_id(); b.st = st;
    if (threadIdx.x == 0) (void)xb_add(&bar[XB_XCNT(b.x)], 1u);
    return b;
}
__device__ __forceinline__ void xcd_barrier_complete(unsigned* bar, unsigned x, unsigned& nloc, unsigned& nx) {
    const unsigned G = gridDim.x * gridDim.y * gridDim.z;
    unsigned sum, cnt, mine, sp = 0u;
    for (;;) {
        sum = 0u; cnt = 0u; mine = 0u;
#pragma unroll
        for (unsigned j = 0; j < 16; ++j) { const unsigned c = xb_ld(&bar[XB_XCNT(j)]); sum += c; cnt += (c > 0u) ? 1u : 0u; mine = (j == x) ? c : mine; }
        if (sum == G) break;
        __builtin_amdgcn_s_sleep(1);
        if ((++sp & 255u) == 0u) { if (xb_ld(&bar[XB_TMO])) break; if (sp > XB_SPIN_CAP) { xb_add(&bar[XB_TMO], 1u); break; } }
    }
    nloc = mine > 0u ? mine : 1u; nx = cnt > 0u ? cnt : 1u;
}
__device__ __forceinline__ void xcd_barrier(const XcdBarrier& b, const bool leader_thread) {
    asm volatile("s_waitcnt vmcnt(0)" ::: "memory");
    __syncthreads();
    if (leader_thread) {
        unsigned* bar = b.bar;
        __builtin_amdgcn_s_waitcnt(0);
        unsigned nloc = b.st[0], nx = b.st[1];
        if (nloc == 0u) { xcd_barrier_complete(bar, b.x, nloc, nx); b.st[0] = nloc; b.st[1] = nx; }
        const unsigned old = xb_add(&bar[XB_XSUB(b.x)], 1u);
        const unsigned gen = old / nloc;
        if (old + 1u == (gen + 1u) * nloc) {
            __builtin_amdgcn_fence(__ATOMIC_RELEASE, "agent");
            asm volatile("s_waitcnt vmcnt(0)" ::: "memory");
            const unsigned og = xb_add(&bar[XB_TOP], 1u);
            const unsigned tg = og / nx;
            if (og + 1u == (tg + 1u) * nx) xb_add(&bar[XB_TOPGEN], 1u);
            else XB_SPIN(xb_ld(&bar[XB_TOPGEN]) == tg, bar);
            __builtin_amdgcn_fence(__ATOMIC_ACQUIRE, "agent");
            xb_add(&bar[XB_XGEN(b.x)], 1u);
            asm volatile("s_waitcnt vmcnt(0)" ::: "memory");
        } else {
            XB_SPIN(xb_ld(&bar[XB_XGEN(b.x)]) == gen, bar);
            __builtin_amdgcn_fence(__ATOMIC_ACQUIRE, "agent");
            asm volatile("s_waitcnt vmcnt(0)" ::: "memory");
        }
    }
    __syncthreads();
}

namespace pg8 {
constexpr int BM = 256, BK = 64, HALF = 128, HTB = HALF * BK * 2, STAGE_BYTES = 8 * HTB, NXCD = 8, WGM = 8;
__host__ __device__ __forceinline__ int lds_byte(int r, int c) { const int st = (r >> 4) * 2 + (c >> 5), rr = r & 15, cc = c & 31, ob = rr * 64 + cc * 2; return st * 1024 + (ob ^ (((ob >> 9) & 1) << 5)); }
__host__ __device__ __forceinline__ void stage_rc(int b, int& R, int& C) { const int st = b / 1024, sb = b % 1024, swz = sb ^ (((sb >> 9) & 1) << 5); R = (st >> 1) * 16 + swz / 64; C = (st & 1) * 32 + (swz % 64) / 2; }
__host__ __device__ __forceinline__ int perm32(int rho) { const int n = rho >> 4, i = rho & 15; return 8 * (i >> 2) + 4 * n + (i & 3); }

struct Unit { const char* a; const char* b; char* c; int pm, pn, hm; };

struct TileOrder {
    static constexpr int BH_ROWS = 128; static constexpr bool KSPLIT = true, MERGED = false;
    int nM, nN, nwg, G, c; const char* A; const char* B; char* C; size_t astep, bstep, cstep; int ldc, cesz; int tail, ktp; size_t khalf; unsigned* flags;
    __device__ __forceinline__ void init(int M_, int N_, int G_, int c_, const void* A_, int lda, const void* B_, int ldb, void* C_, int ldc_, int cesz_) {
        nM = M_ / BM; nN = N_ / BM; nwg = nM * nN; G = G_; c = c_; A = (const char*)A_; B = (const char*)B_; C = (char*)C_;
        astep = (size_t)BM * lda * 2; bstep = (size_t)BM * ldb * 2; ldc = ldc_; cesz = cesz_; cstep = (size_t)BM * ldc_ * cesz_; tail = 0; ktp = 0; khalf = 0; flags = nullptr;
    }
    __device__ __forceinline__ void half_tail() { if (G == 256 && nwg == 640) tail = 1; }
    __device__ __forceinline__ void split_tail(int ktp_, unsigned* flags_) { if (G == 256 && nwg == 640) { tail = 2; ktp = ktp_; khalf = (size_t)ktp_ * (BK * 2); flags = flags_; } }
    __device__ __forceinline__ bool next(int i, Unit& u) const {
        int wgid; u.hm = 0;
        if (tail && i >= 2) { if (i > 2) return false;
            const int xcd = c % NXCD, k = c / NXCD, j = k >> 1; wgid = xcd * (nwg / NXCD) + 64 + j;
            u.hm = (tail == 1) ? 1 + (k & 1) : ((3 + (k & 1)) | ((xcd * 16 + j) << 4)); }
        else { const long L = (long)i * G + c; if (L >= nwg) return false;
            wgid = (int)L; { const int q = nwg / NXCD, r = nwg % NXCD, xcd = wgid % NXCD, off = wgid / NXCD; wgid = (xcd < r ? xcd * (q + 1) : r * (q + 1) + (xcd - r) * q) + off; } }
        const int nig = WGM * nN, gid = wgid / nig, fm = gid * WGM, gsz = (nM - fm) < WGM ? (nM - fm) : WGM;
        u.pm = fm + ((wgid % nig) % gsz); u.pn = (wgid % nig) / gsz;
        const size_t ko = ((u.hm & 15) == 4) ? khalf : 0;
        u.a = A + (size_t)u.pm * astep + ((u.hm & 15) == 2 ? astep / 2 : 0) + ko; u.b = B + (size_t)u.pn * bstep + ko; u.c = C + (size_t)u.pm * cstep + (size_t)u.pn * BM * cesz;
        return true;
    }
};

template <class Epi, class Sched, bool ALIGN_EPI = true>
__device__ __forceinline__ void gemm_phase(LAS unsigned char* lds, const int wave0, const int lda, const int ldb, const int K, const Sched& S, const Epi& E) {
    const int lane = fresh_lane(), wid = fresh_wave(wave0), tid = wid * 64 + lane, wr = wid >> 2, wc = wid & 3, fr = lane & 15, fq = lane >> 4;
    const int nt = K / BK;
    unsigned voffA[2], voffB[2];
#pragma unroll
    for (int i = 0; i < 2; ++i) { int R, C; stage_rc(tid * 16 + i * 8192, R, C); const int Rb = Epi::PERM ? ((R & ~31) + perm32(R & 31)) : R;
        const int Ra = Epi::APERM ? (8 * (16 * (R >> 6) + (R & 15)) + ((R >> 4) & 3)) : R;
        voffA[i] = (unsigned)(Ra * lda + C) * 2u; voffB[i] = (unsigned)(Rb * ldb + C) * 2u; }
    const size_t kstep = (size_t)(BK * 2);
    const size_t hstepA = (size_t)(Epi::APERM ? 4 : HALF) * lda * 2, hstepB = (size_t)Sched::BH_ROWS * ldb * 2;
    const unsigned ldsw = (unsigned)wid * 1024u;
    const int aoff = lds_byte(wr * 64 + fr, fq * 8), boff = lds_byte(wc * 32 + fr, fq * 8);
#define PG8_SA(b, h) (((b) * 2 + (h)) * HTB)
#define PG8_SB(b, h) ((4 + (b) * 2 + (h)) * HTB)
#ifndef PG8_AUX_A
#define PG8_AUX_A 0
#endif
#ifndef PG8_AUX_B
#define PG8_AUX_B 0
#endif
#define PG8_STAGE(bufoff, gbase, voff) do { const GAS char* gb_ = (const GAS char*)(gbase); asm("" : "+s"(gb_));   _Pragma("unroll") for (int _i = 0; _i < 2; ++_i) { asm("" : "+v"((voff)[_i]));   \
        __builtin_amdgcn_global_load_lds((const GAS unsigned*)(gb_ + (voff)[_i]), (LAS unsigned*)(lds + (bufoff) + ldsw + _i * 8192), 16, 0, PG8_AUX_A); } } while (0)
#define PG8_STAGEB(bufoff, gbase, voff) do { const GAS char* gb_ = (const GAS char*)(gbase); asm("" : "+s"(gb_));   _Pragma("unroll") for (int _i = 0; _i < 2; ++_i) { asm("" : "+v"((voff)[_i]));   \
        __builtin_amdgcn_global_load_lds((const GAS unsigned*)(gb_ + (voff)[_i]), (LAS unsigned*)(lds + (bufoff) + ldsw + _i * 8192), 16, 0, PG8_AUX_B); } } while (0)
#define PG8_LDA(dst, b, h) do { _Pragma("unroll") for (int m = 0; m < 4; ++m) _Pragma("unroll") for (int k = 0; k < 2; ++k) dst[m][k] = *(const LAS bf16x8*)(lds + PG8_SA(b, h) + aoff + m * 2048 + k * 1024); } while (0)
#define PG8_LDB(dst, b, h) do { _Pragma("unroll") for (int n = 0; n < 2; ++n) _Pragma("unroll") for (int k = 0; k < 2; ++k) dst[n][k] = *(const LAS bf16x8*)(lds + PG8_SB(b, h) + boff + n * 2048 + k * 1024); } while (0)
#define PG8_MMA(ai, bj, At, Bt) do { __builtin_amdgcn_s_setprio(1); _Pragma("unroll") for (int m = 0; m < 4; ++m) _Pragma("unroll") for (int n = 0; n < 2; ++n) _Pragma("unroll") for (int k = 0; k < 2; ++k) \
        acc[ai][bj][m][n] = __builtin_amdgcn_mfma_f32_16x16x32_bf16(Bt[n][k], At[m][k], acc[ai][bj][m][n], 0, 0, 0); __builtin_amdgcn_s_setprio(0); } while (0)
#define PG8_WAIT_V(n) asm volatile("s_waitcnt vmcnt(" #n ")" ::: "memory")
#define PG8_WAIT_L(n) asm volatile("s_waitcnt lgkmcnt(" #n ")" ::: "memory")
#define PG8_BAR __builtin_amdgcn_s_barrier()
#define PG8_SCHED __builtin_amdgcn_sched_barrier(0)
    Unit cur, nxt; int ui = 0;
    if (!S.next(0, cur)) return;
    f32x4 acc[2][2][4][2];
#pragma unroll
    for (int a = 0; a < 2; ++a)
#pragma unroll
        for (int b = 0; b < 2; ++b)
#pragma unroll
            for (int m = 0; m < 4; ++m)
#pragma unroll
                for (int n = 0; n < 2; ++n) acc[a][b][m][n] = (f32x4){0.f, 0.f, 0.f, 0.f};
    bf16x8 At[4][2], B0[2][2], B1[2][2];
    const char* cA = cur.a; const char* cB = cur.b;
    if constexpr (Sched::MERGED) { if constexpr (Sched::WAIT_FIRST) { if (S.needs_wait(cur)) { S.wait_panel(cur, wid); PG8_BAR; } } }
    PG8_STAGEB(PG8_SB(0, 0), cB, voffB); PG8_STAGEB(PG8_SB(0, 1), cB + hstepB, voffB); PG8_STAGE(PG8_SA(0, 0), cA, voffA); PG8_STAGE(PG8_SA(0, 1), cA + hstepA, voffA);
    if (wr == 1) PG8_BAR;
    PG8_WAIT_V(2); PG8_BAR;
    PG8_STAGEB(PG8_SB(1, 0), cB + kstep, voffB); PG8_STAGE(PG8_SA(1, 0), cA + kstep, voffA); PG8_STAGEB(PG8_SB(1, 1), cB + hstepB + kstep, voffB);
    PG8_WAIT_V(6); PG8_BAR;
    for (;;) {
        const bool has_next = S.next(ui + 1, nxt);
        const char* nA = has_next ? nxt.a : cA; const char* nB = has_next ? nxt.b : cB;
        const int hmode = cur.hm & 15;
        const bool full = (hmode == 0) || (hmode >= 3);
        int unt = nt; if constexpr (Sched::KSPLIT) { if (hmode == 3) unt = S.ktp; else if (hmode == 4) unt = nt - S.ktp; }
        float pf = 0.f;
        for (int t = 0; t < unt; t += 2) {
            const bool last = (t == unt - 2);
            const char* a1 = cA + (size_t)(t + 1) * kstep;
            const char* a2 = last ? nA : cA + (size_t)(t + 2) * kstep; const char* b2 = last ? nB : cB + (size_t)(t + 2) * kstep;
            const char* a3 = a2 + kstep; const char* b3 = b2 + kstep;
            if constexpr (Sched::MERGED) { if (last && has_next && S.needs_wait(nxt)) { S.wait_panel(nxt, wid); PG8_BAR; } }
            if constexpr (Epi::MIDK > 0) { if (t == Epi::MIDK) E.mid(acc, cur, wid); }
            if constexpr (Epi::PREF) { if (last) pf = E.prefetch(cur, tid); }
            PG8_LDB(B0, 0, 0); PG8_LDB(B1, 0, 1); PG8_SCHED; PG8_LDA(At, 0, 0); PG8_STAGE(PG8_SA(1, 1), a1 + hstepA, voffA);
            PG8_WAIT_V(8); PG8_WAIT_L(0); PG8_BAR; PG8_MMA(0, 0, At, B0); PG8_MMA(0, 1, At, B1); PG8_BAR; PG8_SCHED;
            if (full) PG8_LDA(At, 0, 1); PG8_STAGEB(PG8_SB(0, 0), b2, voffB); PG8_STAGEB(PG8_SB(0, 1), b2 + hstepB, voffB); PG8_STAGE(PG8_SA(0, 0), a2, voffA);
            PG8_WAIT_V(8); PG8_WAIT_L(0); PG8_BAR; if (full) { PG8_MMA(1, 0, At, B0); PG8_MMA(1, 1, At, B1); } PG8_BAR; PG8_SCHED;
            PG8_LDB(B0, 1, 0); PG8_LDB(B1, 1, 1); PG8_SCHED; PG8_LDA(At, 1, 0); PG8_STAGE(PG8_SA(0, 1), a2 + hstepA, voffA);
            PG8_WAIT_V(8); PG8_WAIT_L(0); PG8_BAR; PG8_MMA(0, 0, At, B0); PG8_MMA(0, 1, At, B1); PG8_BAR; PG8_SCHED;
            if (full) PG8_LDA(At, 1, 1); PG8_STAGEB(PG8_SB(1, 0), b3, voffB); PG8_STAGEB(PG8_SB(1, 1), b3 + hstepB, voffB); PG8_STAGE(PG8_SA(1, 0), a3, voffA);
            PG8_WAIT_V(8); PG8_WAIT_L(0); PG8_BAR; if (full) { PG8_MMA(1, 0, At, B0); PG8_MMA(1, 1, At, B1); } PG8_BAR; PG8_SCHED;
        }
        if constexpr (ALIGN_EPI) { if (wr == 0) PG8_BAR; }
        if constexpr (Epi::PREF) { static_assert(ALIGN_EPI, "the side-buffer exchange needs both halves in the epilogue together");
            *(LAS float*)(lds + STAGE_BYTES + tid * 4) = pf; PG8_WAIT_L(0); PG8_BAR; }
        if constexpr (Sched::KSPLIT) {
            if (hmode == 3) {
                E.produce(acc, cur, wid);
                PG8_WAIT_V(0); PG8_BAR;
                if (wid == 0 && fresh_lane() == 0) __hip_atomic_store((GAS unsigned*)(S.flags + (size_t)(cur.hm >> 4) * 16), 1u, __ATOMIC_RELAXED, __HIP_MEMORY_SCOPE_AGENT);
            } else {
                if (hmode == 4) {
                    if (wid == 0) { GAS unsigned* fp = (GAS unsigned*)(S.flags + (size_t)(cur.hm >> 4) * 16); unsigned sp = 0;
                        while ((unsigned)__builtin_amdgcn_readfirstlane(__hip_atomic_load(fp, __ATOMIC_RELAXED, __HIP_MEMORY_SCOPE_AGENT)) != 1u) { __builtin_amdgcn_s_sleep(2); if (++sp > (1u << 20)) break; }
                        __builtin_amdgcn_fence(__ATOMIC_ACQUIRE, "agent"); PG8_WAIT_V(0); }
                    PG8_BAR;
                }
                E(acc, cur, wid);
            }
        } else { E(acc, cur, wid);
            if constexpr (Sched::MERGED) { if (S.publishes(cur)) { PG8_WAIT_V(0); if (fresh_lane() == 0) S.publish(cur); } } }
        if (!has_next) break;
#pragma unroll
        for (int a = 0; a < 2; ++a)
#pragma unroll
            for (int b = 0; b < 2; ++b)
#pragma unroll
                for (int m = 0; m < 4; ++m)
#pragma unroll
                    for (int n = 0; n < 2; ++n) acc[a][b][m][n] = (f32x4){0.f, 0.f, 0.f, 0.f};
        cur = nxt; cA = nA; cB = nB; ++ui;
        if constexpr (ALIGN_EPI) { if (wr == 1) PG8_BAR; }
    }
    PG8_WAIT_V(0);
    if constexpr (!ALIGN_EPI) { if (wr == 0) PG8_BAR; }
    PG8_BAR;
#undef PG8_SA
#undef PG8_SB
#undef PG8_STAGE
#undef PG8_STAGEB
#undef PG8_LDA
#undef PG8_LDB
#undef PG8_MMA
#undef PG8_WAIT_V
#undef PG8_WAIT_L
#undef PG8_BAR
#undef PG8_SCHED
}

typedef f32x4 Acc[2][2][4][2];
constexpr int STG_OFF = STAGE_BYTES + 8192, STG_WAVE = 2560, STG_PITCH = 144;
struct Stage64 {
    LAS char* stg; unsigned sw, sr;
    __device__ __forceinline__ Stage64(const LAS float* side, const int wid, const int lane) { stg = (LAS char*)side + (STG_OFF - STAGE_BYTES) + wid * STG_WAVE; sw = (unsigned)((lane & 15) * 80 + (lane >> 4) * 16); sr = (unsigned)((lane >> 2) * 80 + (lane & 3) * 16); }
    __device__ __forceinline__ void put(const int slot, const u32x4 w) const { *(LAS u32x4*)(stg + slot * 1280 + sw) = w; }
    __device__ __forceinline__ u32x4 get(const int slot) const { return *(const LAS u32x4*)(stg + slot * 1280 + sr); }
};
template <int CTRL> __device__ __forceinline__ float dpp_mov(float v) { return __int_as_float(__builtin_amdgcn_update_dpp(0, __float_as_int(v), CTRL, 0xf, 0xf, true)); }

template <int LDC> struct EpiBf16U {
    static constexpr bool PERM = true, APERM = false; static constexpr int MIDK = 0; static constexpr bool PREF = false;
    const LAS float* side;
    __device__ __forceinline__ void operator()(const Acc& acc, const Unit& u, const int wid) const {
        const int lane = fresh_lane(), wr = wid >> 2, wc = wid & 3;
        const Stage64 T(side, wid, lane);
        const unsigned loff = (unsigned)((wr * 64 + (lane >> 2)) * LDC + wc * 32 + 8 * (lane & 3)) * 2u;
#pragma unroll
        for (int ai = 0; ai < 2; ++ai)
#pragma unroll
            for (int m = 0; m < 4; ++m) { char* rowp = u.c + (size_t)(ai * HALF + m * 16) * LDC * 2; asm("" : "+s"(rowp));
#pragma unroll
                for (int bj = 0; bj < 2; ++bj) { const f32x4 v0 = acc[ai][bj][m][0], v1 = acc[ai][bj][m][1];
                    u32x4 w; w.x = cvt_pk_bf16(v0[0], v0[1]); w.y = cvt_pk_bf16(v0[2], v0[3]); w.z = cvt_pk_bf16(v1[0], v1[1]); w.w = cvt_pk_bf16(v1[2], v1[3]);
                    T.put(bj, w); }
                asm volatile("" ::: "memory");
                const u32x4 r0 = T.get(0), r1 = T.get(1);
                asm volatile("" ::: "memory");
                *(GAS u32x4*)(rowp + loff) = r0; *(GAS u32x4*)(rowp + loff + HALF * 2) = r1; }
    }
};
struct EpiIn {
    static constexpr bool PERM = true, APERM = false; static constexpr int MIDK = 0; static constexpr bool PREF = true;
    float* outk; float* outv; int layer; const float* ss; const float* bias; const LAS float* side;
    __device__ __forceinline__ void produce(const Acc&, const Unit&, const int) const {}
    __device__ __forceinline__ float prefetch(const Unit& u, const int tid) const {
        const int bv = u.pm < NB_P ? 0 : 1 + ((u.pm - NB_P) >> 4);
        const float* p = tid < 256 ? ss + (size_t)u.pm * BM + tid : bias + (size_t)bv * IN_DIM + u.pn * BM + (tid - 256);
        return *(const GAS float*)p;
    }
    __device__ __forceinline__ void operator()(const Acc& acc, const Unit& u, const int wid) const {
        const int lane = fresh_lane(), wr = wid >> 2, wc = wid & 3, fr = lane & 15, fq = lane >> 4;
        const bool sig = u.pn >= 16, kv = (u.pm < NB_P) && (u.pn >= 4) && (u.pn < 12);
        const int r0 = wr * 64 + fr, c0 = wc * 32 + 8 * fq;
        const unsigned loff = (unsigned)((wr * 64 + (lane >> 2)) * IN_DIM + wc * 32 + 8 * (lane & 3)) * 2u, koff = (unsigned)(r0 * HD + c0) * 4u;
        const Stage64 T(side, wid, lane);
        float rstd[2][4]; f32x4 bb[2][2];
        {
#pragma unroll
          for (int ai = 0; ai < 2; ++ai)
#pragma unroll
              for (int m = 0; m < 4; ++m) rstd[ai][m] = side[r0 + ai * HALF + m * 16];
#pragma unroll
          for (int bj = 0; bj < 2; ++bj)
#pragma unroll
              for (int n = 0; n < 2; ++n) bb[bj][n] = *(const LAS f32x4*)(side + 256 + c0 + bj * HALF + 4 * n);
#pragma unroll
          for (int ai = 0; ai < 2; ++ai)
#pragma unroll
              for (int m = 0; m < 4; ++m) rstd[ai][m] = rsqrtf(rstd[ai][m] * (1.0f / D) + RMS_EPS); }
#pragma unroll
        for (int ai = 0; ai < 2; ++ai)
#pragma unroll
            for (int m = 0; m < 4; ++m) { char* rowp = u.c + (size_t)(ai * HALF + m * 16) * IN_DIM * 2; asm("" : "+s"(rowp));
#pragma unroll
                for (int bj = 0; bj < 2; ++bj) { f32x4 v0 = acc[ai][bj][m][0] * rstd[ai][m] + bb[bj][0], v1 = acc[ai][bj][m][1] * rstd[ai][m] + bb[bj][1];
                    if (sig) {
#pragma unroll
                        for (int j = 0; j < 4; ++j) { v0[j] = sigmoidf_fast(v0[j]); v1[j] = sigmoidf_fast(v1[j]); } }
                    u32x4 w; w.x = cvt_pk_bf16(v0[0], v0[1]); w.y = cvt_pk_bf16(v0[2], v0[3]); w.z = cvt_pk_bf16(v1[0], v1[1]); w.w = cvt_pk_bf16(v1[2], v1[3]);
                    T.put(bj, w);
                    if (kv) { const int colt = u.pn * BM + bj * HALF; const bool isv = colt >= 2048; const int head = (colt - (isv ? 2048 : 1024)) >> 7;
                        char* dst = (char*)((isv ? outv : outk) + ((((size_t)u.pm * DEPTH + layer) * NH + head) * SEQ_P + (ai * HALF + m * 16)) * HD); asm("" : "+s"(dst));
                        *(GAS f32x4*)(dst + koff) = v0; *(GAS f32x4*)(dst + koff + 16) = v1; } }
                asm volatile("" ::: "memory");
                const u32x4 q0 = T.get(0), q1 = T.get(1);
                asm volatile("" ::: "memory");
                *(GAS u32x4*)(rowp + loff) = q0; *(GAS u32x4*)(rowp + loff + HALF * 2) = q1; }
    }
};
struct EpiPab {
    static constexpr bool PERM = true, APERM = false; static constexpr int MIDK = 16; static constexpr bool PREF = false;
    const bf16_t* G; bf16_t* Y; const LAS float* side;
    __device__ __forceinline__ void produce(const Acc&, const Unit&, const int) const {}
    __device__ __forceinline__ void mid(Acc& acc, const Unit& u, const int wid) const {
        const int lane = fresh_lane(), wr = wid >> 2, wc = wid & 3, fr = lane & 15, fq = lane >> 4;
        const unsigned goff = (unsigned)((wr * 64 + fr) * IN_DIM + wc * 32 + 8 * fq) * 2u;
        const int hb = (u.hm & 15) == 2 ? HALF : 0, na = ((u.hm & 15) == 1 || (u.hm & 15) == 2) ? 1 : 2;
#pragma unroll
        for (int ai = 0; ai < 2; ++ai) if (ai < na) {
#pragma unroll
            for (int mp = 0; mp < 2; ++mp) {
                u32x4 ga[2][2], gb[2][2];
#pragma unroll
                for (int mm = 0; mm < 2; ++mm) { const int m = 2 * mp + mm; const char* gp = (const char*)(G + (size_t)(u.pm * BM + hb + ai * HALF + m * 16) * IN_DIM + 4096 + u.pn * BM); asm("" : "+s"(gp));
#pragma unroll
                    for (int bj = 0; bj < 2; ++bj) { ga[mm][bj] = *(const GAS u32x4*)(gp + goff + bj * HALF * 2); gb[mm][bj] = *(const GAS u32x4*)(gp + goff + bj * HALF * 2 + 2048 * 2); } }
                asm volatile("" ::: "memory");
#pragma unroll
                for (int mm = 0; mm < 2; ++mm)
#pragma unroll
                    for (int bj = 0; bj < 2; ++bj)
#pragma unroll
                        for (int j = 0; j < 4; ++j) { const int m = 2 * mp + mm;
                            const float r0 = bf_lo(ga[mm][bj][j]) * __builtin_amdgcn_rcpf(fmaxf(bf_lo(gb[mm][bj][j]), 1e-30f)), r1 = bf_hi(ga[mm][bj][j]) * __builtin_amdgcn_rcpf(fmaxf(bf_hi(gb[mm][bj][j]), 1e-30f));
                            acc[ai][bj][m][j >> 1][2 * (j & 1)] *= r0; acc[ai][bj][m][j >> 1][2 * (j & 1) + 1] *= r1; }
            }
        }
    }
    __device__ __forceinline__ void operator()(const Acc& acc, const Unit& u, const int wid) const {
        const int lane = fresh_lane(), wr = wid >> 2, wc = wid & 3, fr = lane & 15, fq = lane >> 4;
        const unsigned goff = (unsigned)((wr * 64 + fr) * IN_DIM + wc * 32 + 8 * fq) * 2u, yoff = (unsigned)((wr * 64 + (lane >> 2)) * D + wc * 32 + 8 * (lane & 3)) * 2u;
        const Stage64 T(side, wid, lane);
        const int hb = (u.hm & 15) == 2 ? HALF : 0, na = ((u.hm & 15) == 1 || (u.hm & 15) == 2) ? 1 : 2;
        u32x4 gb[2][4][2];
#pragma unroll
        for (int ai = 0; ai < 2; ++ai) if (ai < na)
#pragma unroll
            for (int m = 0; m < 4; ++m) { const char* gp = (const char*)(G + (size_t)(u.pm * BM + hb + ai * HALF + m * 16) * IN_DIM + 6144 + u.pn * BM); asm("" : "+s"(gp));
#pragma unroll
                for (int bj = 0; bj < 2; ++bj) gb[ai][m][bj] = *(const GAS u32x4*)(gp + goff + bj * HALF * 2); }
        asm volatile("" ::: "memory");
#pragma unroll
        for (int ai = 0; ai < 2; ++ai) if (ai < na)
#pragma unroll
            for (int m = 0; m < 4; ++m) { char* yp = (char*)(Y + (size_t)(u.pm * BM + hb + ai * HALF + m * 16) * D + u.pn * BM); asm("" : "+s"(yp));
#pragma unroll
                for (int bj = 0; bj < 2; ++bj) { const u32x4 g = gb[ai][m][bj]; const f32x4 v0 = acc[ai][bj][m][0], v1 = acc[ai][bj][m][1];
                    u32x4 w;
                    w.x = cvt_pk_bf16(v0[0] * fmaxf(bf_lo(g[0]), 1e-30f), v0[1] * fmaxf(bf_hi(g[0]), 1e-30f)); w.y = cvt_pk_bf16(v0[2] * fmaxf(bf_lo(g[1]), 1e-30f), v0[3] * fmaxf(bf_hi(g[1]), 1e-30f));
                    w.z = cvt_pk_bf16(v1[0] * fmaxf(bf_lo(g[2]), 1e-30f), v1[1] * fmaxf(bf_hi(g[2]), 1e-30f)); w.w = cvt_pk_bf16(v1[2] * fmaxf(bf_lo(g[3]), 1e-30f), v1[3] * fmaxf(bf_hi(g[3]), 1e-30f));
                    T.put(bj, w); }
                asm volatile("" ::: "memory");
                const u32x4 r0 = T.get(0), r1 = T.get(1);
                asm volatile("" ::: "memory");
                *(GAS u32x4*)(yp + yoff) = r0; *(GAS u32x4*)(yp + yoff + HALF * 2) = r1; }
    }
};
struct EpiRes {
    static constexpr bool PERM = true, APERM = false; static constexpr int MIDK = 0; static constexpr bool PREF = true;
    const float* xp; const float* xs; float* X; const float* mods_l; int gi; bool first; float* XO;
    bool emit; const float* gvec; const float* scl; float* ss; bf16_t* HBo;
    const LAS float* side;
    __device__ __forceinline__ float prefetch(const Unit& u, const int tid) const {
        const int bv = u.pm < NB_P ? 0 : 1 + ((u.pm - NB_P) >> 4);
        unsigned to = (unsigned)tid * 4u; asm volatile("; opaque lane offset" : "+v"(to));
        if (tid >= 256) return *(const GAS float*)((const GAS char*)(mods_l + ((size_t)bv * NMOD + gi) * D + u.pn * BM - 256) + to);
        if (!emit) return 0.f;
        return *(const GAS float*)((const GAS char*)(gvec + u.pn * BM) + to) * (*(const GAS float*)((const GAS char*)(scl + (size_t)bv * NMOD * D + u.pn * BM) + to) + 1.0f);
    }
    __device__ __forceinline__ void produce(const Acc& acc, const Unit& u, const int wid) const {
        const int lane = fresh_lane(), wr = wid >> 2, wc = wid & 3, fr = lane & 15, fq = lane >> 4;
        const int r0 = wr * 64 + fr, c0 = wc * 32 + 8 * fq;
        const unsigned xoff = (unsigned)(r0 * D + c0) * 4u;
        const float* base = first ? (u.pm < NB_P ? xp : xs - (size_t)MP * D) : X;
        char* xt = (char*)(X + (size_t)u.pm * BM * D + u.pn * BM); asm("" : "+s"(xt));
        const __amdgpu_buffer_rsrc_t rs = __builtin_amdgcn_make_buffer_rsrc(xt, 0, 256 * D * 4, 0x00020000);
#pragma unroll
        for (int ai = 0; ai < 2; ++ai) {
            f32x4 b[4][2][2];
#pragma unroll
            for (int m = 0; m < 4; ++m) { const char* bp = (const char*)(base + (size_t)(u.pm * BM + ai * HALF + m * 16) * D + u.pn * BM); asm("" : "+s"(bp));
#pragma unroll
                for (int bj = 0; bj < 2; ++bj)
#pragma unroll
                    for (int n = 0; n < 2; ++n) b[m][bj][n] = *(const GAS f32x4*)(bp + xoff + (bj * HALF + n * 4) * 4); }
            asm volatile("" ::: "memory");
#pragma unroll
            for (int bj = 0; bj < 2; ++bj)
#pragma unroll
                for (int n = 0; n < 2; ++n) { const f32x4 gvx = *(const LAS f32x4*)(side + 256 + c0 + bj * HALF + n * 4);
#pragma unroll
                    for (int m = 0; m < 4; ++m) __builtin_amdgcn_raw_buffer_store_b128(__builtin_bit_cast(u32x4, b[m][bj][n] + gvx * acc[ai][bj][m][n]), rs, xoff, ((ai * HALF + m * 16) * D + bj * HALF + n * 4) * 4, 16); }
            asm volatile("" ::: "memory");
        }
    }
    __device__ __forceinline__ void operator()(const Acc& acc, const Unit& u, const int wid) const {
        const int lane = fresh_lane(), wr = wid >> 2, wc = wid & 3, fr = lane & 15, fq = lane >> 4, rr = lane >> 3, ck = lane & 7;
        const unsigned xoff = (unsigned)((wr * 64 + rr) * D + wc * 32 + ck * 4) * 4u, hoff = xoff >> 1;
        LAS char* stg = (LAS char*)side + (STG_OFF - STAGE_BYTES) + wid * STG_WAVE;
        const unsigned sw = (unsigned)(fr * STG_PITCH + fq * 32), sr = (unsigned)(rr * STG_PITCH + ck * 16);
        const int cl = wc * 32 + ck * 4;
        const int hmode = u.hm & 15;
        const float* base = (first && hmode != 4) ? (u.pm < NB_P ? xp : xs - (size_t)MP * D) : X;
        float* XOu = XO; const bool em = emit;
        const int hb = hmode == 2 ? HALF : 0, na = (hmode == 1 || hmode == 2) ? 1 : 2;
#pragma unroll
        for (int ai = 0; ai < 2; ++ai) if (ai < na) {
            f32x4 b[4][2][2];
#pragma unroll
            for (int m = 0; m < 4; ++m) { const char* bp = (const char*)(base + (size_t)(u.pm * BM + hb + ai * HALF + m * 16) * D + u.pn * BM); asm("" : "+s"(bp));
#pragma unroll
                for (int bj = 0; bj < 2; ++bj)
#pragma unroll
                    for (int p = 0; p < 2; ++p) b[m][bj][p] = *(const GAS f32x4*)(bp + xoff + (p * 8 * D + bj * HALF) * 4); }
            asm volatile("" ::: "memory");
#pragma unroll
            for (int m = 0; m < 4; ++m) {
                char* xq = (char*)(XOu + (size_t)(u.pm * BM + hb + ai * HALF + m * 16) * D + u.pn * BM); asm("" : "+s"(xq));
                char* hq = (char*)(HBo + (size_t)(u.pm * BM + hb + ai * HALF + m * 16) * D + u.pn * BM); asm("" : "+s"(hq));
                float q0 = 0.f, q1 = 0.f;
#pragma unroll
                for (int bj = 0; bj < 2; ++bj) {
                    *(LAS f32x4*)(stg + sw) = acc[ai][bj][m][0]; *(LAS f32x4*)(stg + sw + 16) = acc[ai][bj][m][1];
                    asm volatile("" ::: "memory");
                    const f32x4 a0 = *(const LAS f32x4*)(stg + sr), a1 = *(const LAS f32x4*)(stg + sr + 8 * STG_PITCH);
                    const f32x4 gvx = *(const LAS f32x4*)(side + 256 + cl + bj * HALF);
                    asm volatile("" ::: "memory");
                    const f32x4 x0 = b[m][bj][0] + gvx * a0, x1 = b[m][bj][1] + gvx * a1;
                    *(GAS f32x4*)(xq + xoff + (bj * HALF) * 4) = x0; *(GAS f32x4*)(xq + xoff + (8 * D + bj * HALF) * 4) = x1;
                    if (em) { const f32x4 gs = *(const LAS f32x4*)(side + cl + bj * HALF); const f32x4 h0 = x0 * gs, h1 = x1 * gs;
                        q0 += (x0[0] * x0[0] + x0[1] * x0[1]) + (x0[2] * x0[2] + x0[3] * x0[3]); q1 += (x1[0] * x1[0] + x1[1] * x1[1]) + (x1[2] * x1[2] + x1[3] * x1[3]);
                        u32x2 w0, w1; w0.x = cvt_pk_bf16(h0[0], h0[1]); w0.y = cvt_pk_bf16(h0[2], h0[3]); w1.x = cvt_pk_bf16(h1[0], h1[1]); w1.y = cvt_pk_bf16(h1[2], h1[3]);
                        *(GAS u32x2*)(hq + hoff + (bj * HALF) * 2) = w0; *(GAS u32x2*)(hq + hoff + (8 * D + bj * HALF) * 2) = w1; }
                }
                if (em) {
                    q0 += dpp_mov<0xB1>(q0); q1 += dpp_mov<0xB1>(q1); q0 += dpp_mov<0x4E>(q0); q1 += dpp_mov<0x4E>(q1); q0 += dpp_mov<0x141>(q0); q1 += dpp_mov<0x141>(q1);
                    if (ck == 0) { GAS float* sp = (GAS float*)(ss + (size_t)(u.pm * BM + hb + ai * HALF + m * 16) + wr * 64 + rr);
                        __hip_atomic_fetch_add(sp, q0, __ATOMIC_RELAXED, __HIP_MEMORY_SCOPE_AGENT); __hip_atomic_fetch_add(sp + 8, q1, __ATOMIC_RELAXED, __HIP_MEMORY_SCOPE_AGENT); }
                }
            }
            asm volatile("" ::: "memory");
        }
    }
};
struct UpOrder {
    static constexpr int BH_ROWS = FFN; static constexpr bool KSPLIT = false, MERGED = false;
    int nM, nN, nwg, G, c; const char* A; const char* B; char* C;
    __device__ __forceinline__ void init(int G_, int c_, const void* A_, const void* B_, void* C_) { nM = M / BM; nN = FFN / 128; nwg = nM * nN; G = G_; c = c_; A = (const char*)A_; B = (const char*)B_; C = (char*)C_; }
    __device__ __forceinline__ bool next(int i, Unit& u) const {
        const long L = (long)i * G + c; if (L >= nwg) return false;
        int wgid = (int)L; { const int q = nwg / NXCD, r = nwg % NXCD, xcd = wgid % NXCD, off = wgid / NXCD; wgid = (xcd < r ? xcd * (q + 1) : r * (q + 1) + (xcd - r) * q) + off; }
        const int nig = WGM * nN, gid = wgid / nig, fm = gid * WGM, gsz = (nM - fm) < WGM ? (nM - fm) : WGM;
        u.pm = fm + ((wgid % nig) % gsz); u.pn = (wgid % nig) / gsz;
        u.a = A + (size_t)u.pm * BM * D * 2; u.b = B + (size_t)u.pn * 128 * D * 2; u.c = C + ((size_t)u.pm * BM * FFN + (size_t)u.pn * 128) * 2; u.hm = 0;
        return true;
    }
};
__device__ __forceinline__ float dpp_shr1(float v) { return __int_as_float(__builtin_amdgcn_update_dpp(0, __float_as_int(v), 0x111, 0xf, 0xf, true)); }
__device__ __forceinline__ float dpp_shl1(float v) { return __int_as_float(__builtin_amdgcn_update_dpp(0, __float_as_int(v), 0x101, 0xf, 0xf, true)); }
struct EpiUpConv {
    static constexpr bool PERM = true, APERM = true; static constexpr int MIDK = 0; static constexpr bool PREF = true;
    const float* cw; const float* cb; float* UH; const float* ss; const float* bias; const LAS float* side;
    __device__ __forceinline__ float prefetch(const Unit& u, const int tid) const {
        const int bv = u.pm < NB_P ? 0 : 1 + ((u.pm - NB_P) >> 4);
        const float* p = tid < 256 ? ss + (size_t)u.pm * BM + tid : bias + (size_t)bv * FFN2 + u.pn * 128 + (tid < 384 ? tid - 256 : FFN + tid - 384);
        return *(const GAS float*)p;
    }
    __device__ __forceinline__ void operator()(const Acc& acc, const Unit& u, const int wid) const {
        const int lane = fresh_lane(), wr = wid >> 2, wc = wid & 3, fr = lane & 15, fq = lane >> 4;
        const int q = 16 * wr + fr, ch0 = 32 * wc + 8 * fq;
        const char* wbase = (const char*)(cw + u.pn * 128); const char* bbase = (const char*)(cb + u.pn * 128); asm("" : "+s"(wbase), "+s"(bbase));
        const unsigned coff = (unsigned)ch0 * 4u;
        float rstd[8];
        { const f32x4 s0 = *(const LAS f32x4*)(side + 8 * q), s1 = *(const LAS f32x4*)(side + 8 * q + 4);
#pragma unroll
          for (int k = 0; k < 4; ++k) { rstd[k] = rsqrtf(s0[k] * (1.0f / D) + RMS_EPS); rstd[4 + k] = rsqrtf(s1[k] * (1.0f / D) + RMS_EPS); } }
        unsigned outp[8][4];
#pragma unroll
        for (int n = 0; n < 2; ++n) {
            const f32x4 wa0 = *(const GAS f32x4*)(wbase + coff + n * 16), wa1 = *(const GAS f32x4*)(wbase + coff + n * 16 + FFN2 * 4), wa2 = *(const GAS f32x4*)(wbase + coff + n * 16 + 2 * FFN2 * 4);
            const f32x4 wg0 = *(const GAS f32x4*)(wbase + coff + n * 16 + FFN * 4), wg1 = *(const GAS f32x4*)(wbase + coff + n * 16 + (FFN2 + FFN) * 4), wg2 = *(const GAS f32x4*)(wbase + coff + n * 16 + (2 * FFN2 + FFN) * 4);
            const f32x4 ba = *(const GAS f32x4*)(bbase + coff + n * 16), bg = *(const GAS f32x4*)(bbase + coff + n * 16 + FFN * 4);
            const f32x4 ua_b = *(const LAS f32x4*)(side + 256 + ch0 + 4 * n), ug_b = *(const LAS f32x4*)(side + 384 + ch0 + 4 * n);
            float keep[8];
#pragma unroll
            for (int e = 0; e < 4; ++e) {
                float ua[8], ug[8];
#pragma unroll
                for (int k = 0; k < 8; ++k) { ua[k] = acc[k >> 2][0][k & 3][n][e] * rstd[k] + ua_b[e]; ug[k] = acc[k >> 2][1][k & 3][n][e] * rstd[k] + ug_b[e]; }
                const float pa = dpp_shr1(ua[7]), na = dpp_shl1(ua[0]), pg = dpp_shr1(ug[7]), ng = dpp_shl1(ug[0]);
#pragma unroll
                for (int k = 0; k < 8; ++k) {
                    const float A = wa0[e] * (k ? ua[k - 1] : pa) + wa1[e] * ua[k] + wa2[e] * (k < 7 ? ua[k + 1] : na) + ba[e];
                    const float Gv = wg0[e] * (k ? ug[k - 1] : pg) + wg1[e] * ug[k] + wg2[e] * (k < 7 ? ug[k + 1] : ng) + bg[e];
                    const float o = Gv * sigmoidf_fast(Gv) * A;
                    if (e & 1) outp[k][2 * n + (e >> 1)] = cvt_pk_bf16(keep[k], o); else keep[k] = o;
                }
            }
        }
        char* cbase = u.c; asm("" : "+s"(cbase));
        const Stage64 T(side, wid, lane);
        const int f4 = lane >> 2;
        const unsigned roff = (unsigned)(8 * (16 * wr + f4)) * (unsigned)(FFN * 2) + (unsigned)(32 * wc + 8 * (lane & 3)) * 2u;
#pragma unroll
        for (int k = 0; k < 8; k += 2) {
#pragma unroll
            for (int kk = 0; kk < 2; ++kk) { u32x4 w; w.x = outp[k + kk][0]; w.y = outp[k + kk][1]; w.z = outp[k + kk][2]; w.w = outp[k + kk][3]; T.put(kk, w); }
            asm volatile("" ::: "memory");
            const u32x4 r0 = T.get(0), r1 = T.get(1);
            asm volatile("" ::: "memory");
            if (!(k == 0 && f4 == 0)) *(GAS u32x4*)(cbase + roff + k * (FFN * 2)) = r0;
            if (!(k == 6 && f4 == 15)) *(GAS u32x4*)(cbase + roff + (k + 1) * (FFN * 2)) = r1;
        }
        if (fr == 0 || fr == 15) {
            char* ub = (char*)(UH + ((size_t)u.pm * 8 + 4 * wr) * FFN2 + u.pn * 128); asm("" : "+s"(ub));
            const unsigned uoff = (unsigned)(fr == 15 ? 2 * FFN2 * 4 : 0) + coff;
#pragma unroll
            for (int kk = 0; kk < 2; ++kk)
#pragma unroll
                for (int n = 0; n < 2; ++n) {
                    const float rs = fr == 0 ? rstd[kk] : rstd[6 + kk];
                    const f32x4 ua_b = *(const LAS f32x4*)(side + 256 + ch0 + 4 * n), ug_b = *(const LAS f32x4*)(side + 384 + ch0 + 4 * n);
                    const f32x4 va = (fr == 0 ? acc[0][0][kk][n] : acc[1][0][2 + kk][n]) * rs + ua_b, vg = (fr == 0 ? acc[0][1][kk][n] : acc[1][1][2 + kk][n]) * rs + ug_b;
                    *(GAS f32x4*)(ub + uoff + kk * (FFN2 * 4) + n * 16) = va; *(GAS f32x4*)(ub + uoff + kk * (FFN2 * 4) + FFN * 4 + n * 16) = vg; }
        }
    }
};

struct PabOutOrder {
    static constexpr int BH_ROWS = 128; static constexpr bool KSPLIT = false, MERGED = true;
    int c; const char* AF; const char* Wpab; const char* YB; const char* Wout; unsigned* cnt;
    __device__ __forceinline__ bool next(int i, Unit& u) const {
        if (i >= 5) return false;
        const int xcd = c & 7, s = 32 * i + (c >> 3), kind = s >= 80, j = kind ? s - 80 : s;
        u.pm = 10 * xcd + (j >> 3); u.pn = j & 7; u.hm = kind ? 0x1000 : 0; u.c = nullptr;
        u.a = (kind ? YB : AF) + (size_t)u.pm * BM * D * 2; u.b = (kind ? Wout : Wpab) + (size_t)u.pn * BM * D * 2;
        return true;
    }
    static constexpr bool WAIT_FIRST = false;
    __device__ __forceinline__ bool needs_wait(const Unit& u) const { return (u.hm & 0x1000) != 0; }
    __device__ __forceinline__ bool publishes(const Unit& u) const { return (u.hm & 0x1000) == 0; }
    __device__ __forceinline__ void publish(const Unit& u) const { __hip_atomic_fetch_add((GAS unsigned*)(cnt + u.pm * 16), 1u, __ATOMIC_RELAXED, __HIP_MEMORY_SCOPE_AGENT); }
    __device__ __forceinline__ void wait_panel(const Unit& u, const int wid) const {
        if (wid == 0) { GAS unsigned* fp = (GAS unsigned*)(cnt + u.pm * 16); unsigned sp = 0;
            while ((unsigned)__builtin_amdgcn_readfirstlane(__hip_atomic_load(fp, __ATOMIC_RELAXED, __HIP_MEMORY_SCOPE_AGENT)) < 64u) { __builtin_amdgcn_s_sleep(2); if (++sp > (1u << 20)) break; }
            __builtin_amdgcn_fence(__ATOMIC_ACQUIRE, "agent"); asm volatile("s_waitcnt vmcnt(0)" ::: "memory"); }
    }
};
struct EpiPabOut {
    static constexpr bool PERM = true, APERM = false; static constexpr int MIDK = 16; static constexpr bool PREF = true; static constexpr int NPF = 1;
    EpiPab P; EpiRes R;
    __device__ __forceinline__ void produce(const Acc&, const Unit&, const int) const {}
    __device__ __forceinline__ float prefetch(const Unit& u, const int tid) const { return (u.hm & 0x1000) ? R.prefetch(u, tid) : 0.f; }
    __device__ __forceinline__ void mid(Acc& acc, const Unit& u, const int wid) const { if (!(u.hm & 0x1000)) P.mid(acc, u, wid); }
    __device__ __forceinline__ void operator()(const Acc& acc, const Unit& u, const int wid) const { if (u.hm & 0x1000) R(acc, u, wid); else P(acc, u, wid); }
};
}

struct Buffers;
struct FourierSync {
    static constexpr bool WAIT_FIRST = true;
    bool mg; unsigned* pub; unsigned* wt; unsigned need;
    __device__ __forceinline__ bool needs_wait(const pg8::Unit&) const { return mg && wt != nullptr; }
    __device__ __forceinline__ bool publishes(const pg8::Unit&) const { return mg && pub != nullptr; }
    __device__ __forceinline__ void publish(const pg8::Unit& u) const { __hip_atomic_fetch_add((GAS unsigned*)(pub + u.pm * 16), 1u, __ATOMIC_RELAXED, __HIP_MEMORY_SCOPE_AGENT); }
    __device__ __forceinline__ void wait_panel(const pg8::Unit& u, const int wid) const {
        if (wid == 0) { GAS unsigned* fp = (GAS unsigned*)(wt + u.pm * 16); unsigned sp = 0;
            while ((unsigned)__builtin_amdgcn_readfirstlane(__hip_atomic_load(fp, __ATOMIC_RELAXED, __HIP_MEMORY_SCOPE_AGENT)) < need) { __builtin_amdgcn_s_sleep(2); if (++sp > (1u << 20)) break; }
            __builtin_amdgcn_fence(__ATOMIC_ACQUIRE, "agent"); asm volatile("s_waitcnt vmcnt(0)" ::: "memory"); }
    }
};
struct F1SOrder : FourierSync {
    static constexpr int BH_ROWS = 128; static constexpr bool KSPLIT = false, MERGED = true;
    int G, c; const char* DC; const char* QK; char* GTS;
    __device__ __forceinline__ bool next(int i, pg8::Unit& u) const {
        int L; if (mg) { if (i >= 2) return false; L = 64 * (c & 7) + 32 * i + (c >> 3); } else { L = i * G + c; if (L >= 512) return false; }
        const int bg = L >> 5, part = (L >> 4) & 1, nt = L & 15, b = bg >> 2, g = bg & 3;
        u.a = DC + (size_t)part * 256 * 256 * 2; u.b = QK + ((size_t)(MP + b * SEQ_S + nt * 256) * IN_DIM + 3072 + g * 256) * 2;
        u.c = GTS + ((size_t)bg * 256 * 8192 + part * 4096 + nt * 256) * 2; u.pm = bg; u.pn = nt; u.hm = 0; return true;
    }
};
struct F1POrder : FourierSync {
    static constexpr int BH_ROWS = 128; static constexpr bool KSPLIT = false, MERGED = true;
    int G, c; const char* DC; const char* QK; char* GTP;
    __device__ __forceinline__ bool next(int i, pg8::Unit& u) const {
        int L; if (mg) { if (i >= 1 || (c >> 3) < 16) return false; L = 16 * (c & 7) + (c >> 3) - 16; }      else { L = i * G + (G - 1 - c); if (L >= 128) return false; }
        const int bg = L >> 1, part = L & 1, b = bg >> 2, g = bg & 3;
        u.a = DC + (size_t)part * 256 * 256 * 2; u.b = QK + ((size_t)(b * SEQ_P) * IN_DIM + 3072 + g * 256) * 2;
        u.c = GTP + ((size_t)bg * 256 * 512 + part * 256) * 2; u.pm = bg; u.pn = 0; u.hm = 0; return true;
    }
};
struct F2SOrder : FourierSync {
    static constexpr int BH_ROWS = 128; static constexpr bool KSPLIT = false, MERGED = true;
    int G, c; const char* DS; const char* U2; char* AF;
    __device__ __forceinline__ bool next(int i, pg8::Unit& u) const {
        int L; if (mg) { if (i >= 1) return false; L = 32 * (c & 7) + (c >> 3); } else { L = i * G + c; if (L >= 256) return false; }
        const int bg = L >> 4, k2 = L & 15, b = bg >> 2, g = bg & 3;
        u.a = DS; u.b = U2 + (size_t)(bg * 16 + k2) * 256 * 512 * 2;
        u.c = AF + ((size_t)(MP + b * SEQ_S + k2) * D + 1024 + g * 256) * 2; u.pm = bg; u.pn = 0; u.hm = 0; return true;
    }
};
struct F2POrder : FourierSync {
    static constexpr int BH_ROWS = 128; static constexpr bool KSPLIT = false, MERGED = true;
    int G, c; const char* DP; const char* GTP; char* AF;
    __device__ __forceinline__ bool next(int i, pg8::Unit& u) const {
        int L; if (mg) { if (i >= 1 || (c >> 3) < 24) return false; L = 8 * (c & 7) + (c >> 3) - 24; } else { L = i * G + (G - 1 - c); if (L >= 64) return false; }
        const int bg = L, b = bg >> 2, g = bg & 3;
        u.a = DP; u.b = GTP + (size_t)bg * 256 * 512 * 2; u.c = AF + ((size_t)(b * SEQ_P) * D + 1024 + g * 256) * 2; u.pm = bg; u.pn = 0; u.hm = 0; return true;
    }
};

namespace att {
#define KSWZ(row, colB) ((row) * 256 + ((colB) ^ (((row) & 7) << 4)))
__device__ __forceinline__ int crow(int r, int hi) { return (r & 3) + 8 * (r >> 2) + 4 * hi; }
__device__ __forceinline__ int v_st(int k, int c) { const int kk = (k & ~0xC) | ((k & 4) << 1) | ((k & 8) >> 1); return ((kk >> 3) * 4 + (c >> 5)) * 512 + ((kk & 7) * 32 + (c & 31)) * 2; }
__device__ __forceinline__ int v_rd_base(int lane) { return ((lane & 3) << 3) | (((lane >> 2) & 3) << 6) | (((lane >> 4) & 1) << 5) | (((lane >> 5) & 1) << 8); }
constexpr int v_rd_off(int d0, int ks, int half) { return d0 * 512 + ks * 4096 + half * 2048; }
template <int OFF> __device__ __forceinline__ s16x4 tr_read(int vb) { s16x4 r; asm volatile("ds_read_b64_tr_b16 %0, %1 offset:%2" : "=&v"(r) : "v"(vb), "i"(OFF) : "memory"); return r; }
template <int D0> __device__ __forceinline__ void pv_one(f32x16& od, int vb, bf16x8 pa0, bf16x8 pa1, bf16x8 pa2, bf16x8 pa3) {
    const s16x4 l0 = tr_read<v_rd_off(D0, 0, 0)>(vb), h0 = tr_read<v_rd_off(D0, 0, 1)>(vb), l1 = tr_read<v_rd_off(D0, 1, 0)>(vb), h1 = tr_read<v_rd_off(D0, 1, 1)>(vb);
    const s16x4 l2 = tr_read<v_rd_off(D0, 2, 0)>(vb), h2 = tr_read<v_rd_off(D0, 2, 1)>(vb), l3 = tr_read<v_rd_off(D0, 3, 0)>(vb), h3 = tr_read<v_rd_off(D0, 3, 1)>(vb);
    asm volatile("s_waitcnt lgkmcnt(0)" ::: "memory"); __builtin_amdgcn_sched_barrier(0);
#define ATT_PK(L, H) (bf16x8){L[0], L[1], L[2], L[3], H[0], H[1], H[2], H[3]}
    od = __builtin_amdgcn_mfma_f32_32x32x16_bf16(pa0, ATT_PK(l0, h0), od, 0, 0, 0);
    od = __builtin_amdgcn_mfma_f32_32x32x16_bf16(pa1, ATT_PK(l1, h1), od, 0, 0, 0);
    od = __builtin_amdgcn_mfma_f32_32x32x16_bf16(pa2, ATT_PK(l2, h2), od, 0, 0, 0);
    od = __builtin_amdgcn_mfma_f32_32x32x16_bf16(pa3, ATT_PK(l3, h3), od, 0, 0, 0);
#undef ATT_PK
}
constexpr int SHM_V = 64 * 128 * 2, SHM_K = 64 * 128 * 2;
constexpr int L_V = 0, L_K = 2 * SHM_V, L_WS = 2 * SHM_V + 2 * SHM_K, L_TAB = L_WS + NWAVES * 64 * 4, L_END = L_TAB + 15 * 128 * 4;
static_assert(L_END <= 131072, "attention LDS");

struct TileSrc { const bf16_t* K0; const bf16_t* V0; int ld0, nt0; const bf16_t* K1; const bf16_t* V1; int ld1, nt1; };

template <bool NA>
__device__ __forceinline__ void attn_unit(LAS char* lds, const int wave0, const bf16_t* Qb, int ldq, const TileSrc T, int kr0, int qrow0, const float* rpb, bf16_t* Ob, int ldo) {
    const int lane = fresh_lane(), wid = fresh_wave(wave0), tid = wid * 64 + lane, r32 = lane & 31, hi = lane >> 5;
    LAS char* V_lds = lds + L_V; LAS char* K_lds = lds + L_K;
    LAS float* ws = (LAS float*)(lds + L_WS) + wid * 64; LAS float* li_l = ws; LAS float* al_l = ws + 32;
    LAS float* tab = (LAS float*)(lds + L_TAB);
    float m_reg = -1e30f, l_reg = 0.f; f32x16 o[4];
#pragma unroll
    for (int d = 0; d < 4; ++d)
#pragma unroll
        for (int r = 0; r < 16; ++r) o[d][r] = 0.f;
    bf16x8 qr[8];
    { const bf16_t* Qw = Qb + (size_t)(wid * 32 + r32) * ldq + hi * 8;
#pragma unroll
      for (int d0 = 0; d0 < 8; ++d0) qr[d0] = *(const GAS bf16x8*)(Qw + d0 * 16); }
    if (NA) { for (int idx = tid; idx < 15 * 128; idx += NTHREADS) { const int dr7 = idx >> 7, dcc = (idx & 127) - 63;
                  tab[idx] = (dcc >= -15 && dcc <= 15) ? ((const GAS float*)rpb)[dr7 * 31 + dcc + 15] * LOG2E : 0.f; } }
    const int sr = tid >> 4, sc = (tid & 15) * 8, vst0 = v_st(sr, sc), vst1 = v_st(32 + sr, sc), kst0 = KSWZ(sr, sc * 2), kst1 = KSWZ(32 + sr, sc * 2);
    const int vb0 = (int)(uintptr_t)(V_lds) + v_rd_base(lane);
    const int NT = T.nt0 + T.nt1;
    bf16x8 vs0, vs1, ks0, ks1;
#define ATT_SLOAD(t) do { const bool g0 = (t) < T.nt0; const int tt = g0 ? (t) : (t) - T.nt0; const int ld = g0 ? T.ld0 : T.ld1; \
        const bf16_t* Kp = (g0 ? T.K0 : T.K1) + (size_t)tt * 64 * ld; const bf16_t* Vp = (g0 ? T.V0 : T.V1) + (size_t)tt * 64 * ld; \
        vs0 = *(const GAS bf16x8*)(Vp + (size_t)sr * ld + sc); vs1 = *(const GAS bf16x8*)(Vp + (size_t)(32 + sr) * ld + sc); \
        ks0 = *(const GAS bf16x8*)(Kp + (size_t)sr * ld + sc); ks1 = *(const GAS bf16x8*)(Kp + (size_t)(32 + sr) * ld + sc); } while (0)
#define ATT_SWRITE(b) do { *(LAS bf16x8*)(V_lds + (b) * SHM_V + vst0) = vs0; *(LAS bf16x8*)(V_lds + (b) * SHM_V + vst1) = vs1; \
        *(LAS bf16x8*)(K_lds + (b) * SHM_K + kst0) = ks0; *(LAS bf16x8*)(K_lds + (b) * SHM_K + kst1) = ks1; } while (0)
    ATT_SLOAD(0); ATT_SWRITE(0);
    __syncthreads();
    const int qrow = qrow0 + (wid >> 1), qc = 32 * (wid & 1) + r32;
    const int r0w = min(max(qrow - 4, 0), GW - 8), c0 = min(max(qc - 8, 0), GW - 16);
    for (int t = 0; t < NT; ++t) {
        const int buf = t & 1;
        if (t + 1 < NT) ATT_SLOAD(t + 1);
        bool active = true; int dr = 0;
        if (NA && t >= T.nt0) { const int kr = kr0 + (t - T.nt0); active = (kr >= r0w) && (kr < r0w + 8); dr = kr - qrow; }
        if (active) {
            f32x16 p0, p1;
#pragma unroll
            for (int r = 0; r < 16; ++r) { p0[r] = 0.f; p1[r] = 0.f; }
            { LAS const char* Ks = K_lds + buf * SHM_K;
              __builtin_amdgcn_s_setprio(1);
#pragma unroll
              for (int d0 = 0; d0 < 8; ++d0) { const int cb = (d0 * 16 + hi * 8) * 2;
                  const bf16x8 b0 = *(LAS const bf16x8*)(Ks + KSWZ(r32, cb)); const bf16x8 b1 = *(LAS const bf16x8*)(Ks + KSWZ(32 + r32, cb));
                  p0 = __builtin_amdgcn_mfma_f32_32x32x16_bf16(b0, qr[d0], p0, 0, 0, 0); p1 = __builtin_amdgcn_mfma_f32_32x32x16_bf16(b1, qr[d0], p1, 0, 0, 0); }
              __builtin_amdgcn_s_setprio(0); }
            if (NA && t >= T.nt0) {
                LAS const float* brow = tab + (dr + 7) * 128 + 63 - qc + 4 * hi;
#pragma unroll
                for (int r = 0; r < 16; ++r) { const int kq = (r & 3) + 8 * (r >> 2); const int kc = kq + 4 * hi;
                    const float b0 = brow[kq], b1 = brow[kq + 32];
                    p0[r] = ((unsigned)(kc - c0) < 16u) ? p0[r] + b0 : -INFINITY; p1[r] = ((unsigned)(kc + 32 - c0) < 16u) ? p1[r] + b1 : -INFINITY; }
            }
            float pmax = p0[0];
#pragma unroll
            for (int r = 1; r < 16; ++r) pmax = fmaxf(pmax, p0[r]);
#pragma unroll
            for (int r = 0; r < 16; ++r) pmax = fmaxf(pmax, p1[r]);
            { auto rr = __builtin_amdgcn_permlane32_swap(__float_as_uint(pmax), __float_as_uint(pmax), false, false); pmax = fmaxf(__uint_as_float(rr[0]), __uint_as_float(rr[1])); }
            const float mn = fmaxf(m_reg, pmax), alpha = __builtin_amdgcn_exp2f(m_reg - mn); m_reg = mn;
            float ps = 0.f;
#pragma unroll
            for (int r = 0; r < 16; ++r) { p0[r] = __builtin_amdgcn_exp2f(p0[r] - mn); p1[r] = __builtin_amdgcn_exp2f(p1[r] - mn); ps += p0[r] + p1[r]; }
            { auto rr = __builtin_amdgcn_permlane32_swap(__float_as_uint(ps), __float_as_uint(ps), false, false); ps = __uint_as_float(rr[0]) + __uint_as_float(rr[1]); }
            l_reg = l_reg * alpha + ps;
            bf16x8 pa0, pa1, pa2, pa3;
#define ATT_PK4(P, BASE, OUT) do { unsigned a0 = cvt_pk_bf16(P[BASE + 0], P[BASE + 1]), a1 = cvt_pk_bf16(P[BASE + 2], P[BASE + 3]);   \
    unsigned b0 = cvt_pk_bf16(P[BASE + 4], P[BASE + 5]), b1 = cvt_pk_bf16(P[BASE + 6], P[BASE + 7]);                              \
    auto r0_ = __builtin_amdgcn_permlane32_swap(a0, b0, false, false); auto r1_ = __builtin_amdgcn_permlane32_swap(a1, b1, false, false); \
    u32x4 w_ = {r0_[0], r1_[0], r0_[1], r1_[1]}; OUT = *reinterpret_cast<bf16x8*>(&w_); } while (0)
            ATT_PK4(p0, 0, pa0); ATT_PK4(p0, 8, pa1); ATT_PK4(p1, 0, pa2); ATT_PK4(p1, 8, pa3);
#undef ATT_PK4
            if (__any(alpha < 1.f)) { if (hi == 0) al_l[r32] = alpha; asm volatile("s_waitcnt lgkmcnt(0)" ::: "memory");
#pragma unroll
                for (int r = 0; r < 16; ++r) { const float a = al_l[crow(r, hi)];
#pragma unroll
                    for (int d = 0; d < 4; ++d) o[d][r] *= a; } }
            const int vb = vb0 + buf * SHM_V;
            __builtin_amdgcn_s_setprio(1);
            pv_one<0>(o[0], vb, pa0, pa1, pa2, pa3); pv_one<1>(o[1], vb, pa0, pa1, pa2, pa3); pv_one<2>(o[2], vb, pa0, pa1, pa2, pa3); pv_one<3>(o[3], vb, pa0, pa1, pa2, pa3);
            __builtin_amdgcn_s_setprio(0);
        }
        if (t + 1 < NT) ATT_SWRITE(buf ^ 1);
        __syncthreads();
    }
#undef ATT_SLOAD
#undef ATT_SWRITE
    if (hi == 0) li_l[r32] = l_reg;
    asm volatile("s_waitcnt lgkmcnt(0)" ::: "memory");
    bf16_t* Ow = Ob + (size_t)(wid * 32) * ldo;
#pragma unroll
    for (int r = 0; r < 16; ++r) { const int orow = crow(r, hi); const float rl = __builtin_amdgcn_rcpf(li_l[orow]);
#pragma unroll
        for (int d0 = 0; d0 < 4; ++d0) ((GAS bf16_t*)Ow)[(size_t)orow * ldo + d0 * 32 + r32] = (bf16_t)(cvt_pk_bf16(o[d0][r] * rl, 0.f) & 0xffffu); }
    __syncthreads();
}
}

__device__ __forceinline__ void dft4(float& r0, float& i0, float& r1, float& i1, float& r2, float& i2, float& r3, float& i3) {
    const float t0r = r0 + r2, t0i = i0 + i2, t1r = r0 - r2, t1i = i0 - i2, t2r = r1 + r3, t2i = i1 + i3, t3r = r1 - r3, t3i = i1 - i3;
    r0 = t0r + t2r; i0 = t0i + t2i; r2 = t0r - t2r; i2 = t0i - t2i; r1 = t1r + t3i; i1 = t1i - t3r; r3 = t1r - t3i; i3 = t1i + t3r;
}
__device__ __forceinline__ void fft16(float (&xr)[16], float (&xi)[16]) {
#pragma unroll
    for (int nb = 0; nb < 4; ++nb) dft4(xr[nb], xi[nb], xr[4 + nb], xi[4 + nb], xr[8 + nb], xi[8 + nb], xr[12 + nb], xi[12 + nb]);
    constexpr float C1 = 0.92387953251128674f, S1 = 0.38268343236508977f, R2 = 0.70710678118654752f;
    constexpr float TC[10] = {1.f, C1, R2, S1, 0.f, 0.f, -R2, 0.f, 0.f, -C1};
    constexpr float TS[10] = {0.f, S1, R2, C1, 1.f, 0.f, R2, 0.f, 0.f, -S1};
#pragma unroll
    for (int nb = 1; nb < 4; ++nb)
#pragma unroll
        for (int ka = 1; ka < 4; ++ka) { const float c = TC[nb * ka], sn = TS[nb * ka]; const float ar = xr[4 * ka + nb], ai = xi[4 * ka + nb];
            xr[4 * ka + nb] = ar * c + ai * sn; xi[4 * ka + nb] = ai * c - ar * sn; }
#pragma unroll
    for (int ka = 0; ka < 4; ++ka) dft4(xr[4 * ka], xi[4 * ka], xr[4 * ka + 1], xi[4 * ka + 1], xr[4 * ka + 2], xi[4 * ka + 2], xr[4 * ka + 3], xi[4 * ka + 3]);
}

struct Args { const float* in[20]; float* out; unsigned char* ws; };
enum { I_XP = 0, I_XS, I_CK, I_CV, I_C, I_CCTX, I_WMOD, I_BMOD, I_N1G, I_WIN, I_RPB, I_WPA, I_WPB, I_WOUT, I_N2G, I_WUP, I_CONVW, I_CONVB, I_WDOWN, I_NFG };

__device__ __forceinline__ void transpose_item(const float* W, int K, int N, bf16_t* WT, int ldt, int nsc, float sc, LAS float* scr, int item, int lane) {
    const int nblk = N >> 6, kb = item / nblk, nb = item - kb * nblk, k0 = kb << 6, n0 = nb << 6;
    f32x4 v[16];
    const float* src = W + (size_t)(k0 + (lane >> 4)) * N + n0 + 4 * (lane & 15);
#pragma unroll
    for (int i = 0; i < 16; ++i) v[i] = *(const f32x4*)(src + (size_t)(4 * i) * N);
#pragma unroll
    for (int i = 0; i < 16; ++i) { LAS float* d = scr + (4 * i + (lane >> 4)) * 65 + 4 * (lane & 15); d[0] = v[i][0]; d[1] = v[i][1]; d[2] = v[i][2]; d[3] = v[i][3]; }
    LDS_WAIT(); asm volatile("" ::: "memory");
    const int c = lane & 7;
#pragma unroll
    for (int j = 0; j < 8; ++j) { const int n = (lane >> 3) + 8 * j; const LAS float* s = scr + (8 * c) * 65 + n; const float f = (n0 + n) < nsc ? sc : 1.0f;
        u32x4 o; o.x = cvt_pk_bf16(s[0 * 65] * f, s[1 * 65] * f); o.y = cvt_pk_bf16(s[2 * 65] * f, s[3 * 65] * f); o.z = cvt_pk_bf16(s[4 * 65] * f, s[5 * 65] * f); o.w = cvt_pk_bf16(s[6 * 65] * f, s[7 * 65] * f);
        *(u32x4*)(WT + (size_t)(n0 + n) * ldt + k0 + 8 * c) = o; }
    LDS_WAIT(); asm volatile("" ::: "memory");
}

__global__ void __launch_bounds__(NTHREADS, 2) fwd(Args args) {
    extern __shared__ __attribute__((aligned(16))) unsigned char lds_raw[];
    LAS unsigned char* lds = (LAS unsigned char*)lds_raw;
    volatile LAS unsigned* MISC = (volatile LAS unsigned*)(lds + MISC_OFF);
    const int G = gridDim.x, bx = blockIdx.x;
    const int vcu = (G % 8 == 0) ? (bx % 8) * (G / 8) + bx / 8 : bx;
    const int NGW = G * NWAVES;
    const int wave0 = __builtin_amdgcn_readfirstlane((int)threadIdx.x >> 6);
#define OPQ_BX() unsigned mo_ = MISC_OFF + 16; asm volatile("; opaque LDS offset" : "+v"(mo_)); int bxo_ = __builtin_amdgcn_readfirstlane((int)*(volatile LAS unsigned*)(lds + mo_)); asm volatile("; opaque virtual block index" : "+s"(bxo_)); const int bx = bxo_
#define PIN_TID() const int lane = fresh_lane(), wave = fresh_wave(wave0), tid = wave * 64 + lane, gw = vcu * NWAVES + wave; (void)gw; (void)tid
    { const int tid = threadIdx.x; if (tid < 64) MISC[tid] = 0u; }
    unsigned char* ws = args.ws;
    __syncthreads();
    XcdBarrier bar = xcd_barrier_post((unsigned*)(ws + WS_CTL) + CW_BAR, MISC);
    if (threadIdx.x == 0) { const unsigned xcc = xb_xcc_id(); MISC[2] = xcc; MISC[3] = xb_add((unsigned*)(ws + WS_CTL) + CW_XRANK + 64 * xcc, 1u); MISC[4] = blockIdx.x; }
#define GRID_BAR() do { XcdBarrier b_ = bar; asm volatile("; pin bar" : "+s"(b_.bar), "+s"(b_.x)); const bool ldr_ = (fresh_wave(wave0) == 0) && (fresh_lane() == 0); for (int rb_ = 0; rb_ < REP_BAR; ++rb_) xcd_barrier(b_, ldr_); } while (0)

    float* X = args.out;
    float* OUTK = args.out + (size_t)M * D; float* OUTV = OUTK + (size_t)NB_P * DEPTH * NH * SEQ_P * HD;
    float* MODS = (float*)(ws + WS_MODS); float* SS = (float*)(ws + WS_SS); float* BIN = (float*)(ws + WS_BIAS); float* BUP = BIN + (size_t)DEPTH * 5 * IN_DIM;
    bf16_t* CKB = (bf16_t*)(ws + WS_CACHE); bf16_t* CVB = CKB + (size_t)NB_S * DEPTH * NH * PAST * HD;
    bf16_t* DC = (bf16_t*)(ws + WS_DC); bf16_t* DP = (bf16_t*)(ws + WS_DP); bf16_t* DS = (bf16_t*)(ws + WS_DS); bf16_t* U2 = (bf16_t*)(ws + WS_UP2);
    bf16_t* HB = (bf16_t*)(ws + WS_H); bf16_t* QK = (bf16_t*)(ws + WS_BIG); float* UH = (float*)(ws + WS_UH);
    bf16_t* AF = (bf16_t*)(ws + WS_AF); bf16_t* GTS = (bf16_t*)(ws + WS_GTS); bf16_t* GTP = (bf16_t*)(ws + WS_GTP);
    float* T1 = (float*)(ws + WS_T1); bf16_t* ACT = (bf16_t*)(ws + WS_ACT); bf16_t* YB = (bf16_t*)(ws + WS_Y);

    for (int rep_ = 0; rep_ < REP_P0; ++rep_) {
        PIN_TID();
#if EN_MODS
        for (int item = bx; item < DEPTH * 48; item += G) {
            const int l = item / 48, nb = item % 48;
            LAS float* sil = (LAS float*)lds; LAS float* red = (LAS float*)(lds + 5 * D * 4);
            for (int idx = tid; idx < 5 * D; idx += NTHREADS) { const int v = idx / D, k = idx % D; const float cv = v == 0 ? args.in[I_CCTX][k] : args.in[I_C][(size_t)(v - 1) * D + k];
                sil[idx] = cv * sigmoidf_fast(cv); }
            __syncthreads();
            f32x4 a5[5];
#pragma unroll
            for (int v = 0; v < 5; ++v) a5[v] = (f32x4){0.f, 0.f, 0.f, 0.f};
            const float* Wp = args.in[I_WMOD] + ((size_t)l * D + wave * 256) * (NMOD * D) + 256 * nb + 4 * lane;
            for (int k8 = 0; k8 < 256; k8 += 8) {
                f32x4 wv[8];
#pragma unroll
                for (int j = 0; j < 8; ++j) wv[j] = *(const f32x4*)(Wp + (size_t)(k8 + j) * (NMOD * D));
#pragma unroll
                for (int j = 0; j < 8; ++j)
#pragma unroll
                    for (int v = 0; v < 5; ++v) a5[v] += sil[v * D + wave * 256 + k8 + j] * wv[j];
            }
#pragma unroll
            for (int v = 0; v < 5; ++v) *(LAS f32x4*)(red + (wave * 5 + v) * 256 + 4 * lane) = a5[v];
            __syncthreads();
            for (int o = tid; o < 5 * 256; o += NTHREADS) { const int v = o >> 8, n = o & 255; float s = args.in[I_BMOD][(size_t)l * NMOD * D + 256 * nb + n];
#pragma unroll
                for (int w = 0; w < 8; ++w) s += red[(w * 5 + v) * 256 + n];
                MODS[((size_t)l * 5 + v) * (NMOD * D) + 256 * nb + n] = s; }
            __syncthreads();
        }
#endif
#if EN_WT
        {
            LAS float* scr = (LAS float*)(lds + wave * (64 * 65 * 4));
            constexpr int I_IN = (D / 64) * (IN_DIM / 64), I_PA = (AD / 64) * (D / 64), I_PB = (FD / 64) * (D / 64), I_OUT = (D / 64) * (D / 64), I_UP = (D / 64) * (FFN2 / 64), I_DOWN = (FFN / 64) * (D / 64);
            constexpr int PER_LAYER = I_IN + I_PA + I_PB + I_OUT + I_UP + I_DOWN;
            for (int it = gw; it < DEPTH * PER_LAYER; it += NGW) {
                const int l = it / PER_LAYER; int r = it - l * PER_LAYER;
                bf16_t* wt = (bf16_t*)(ws + WS_WT + (size_t)l * WT_LAYER);
                if (r < I_IN) { transpose_item(args.in[I_WIN] + (size_t)l * D * IN_DIM, D, IN_DIM, wt + WT_IN / 2, D, AD, QSCALE, scr, r, lane); continue; } r -= I_IN;
                if (r < I_PA) { transpose_item(args.in[I_WPA] + (size_t)l * AD * D, AD, D, wt + WT_PA / 2, AD + FD, 0, 1.f, scr, r, lane); continue; } r -= I_PA;
                if (r < I_PB) { transpose_item(args.in[I_WPB] + (size_t)l * FD * D, FD, D, wt + WT_PA / 2 + AD, AD + FD, 0, 1.f, scr, r, lane); continue; } r -= I_PB;
                if (r < I_OUT) { transpose_item(args.in[I_WOUT] + (size_t)l * D * D, D, D, wt + WT_OUT / 2, D, 0, 1.f, scr, r, lane); continue; } r -= I_OUT;
                if (r < I_UP) { transpose_item(args.in[I_WUP] + (size_t)l * D * FFN2, D, FFN2, wt + WT_UP / 2, D, 0, 1.f, scr, r, lane); continue; } r -= I_UP;
                transpose_item(args.in[I_WDOWN] + (size_t)l * FFN * D, FFN, D, wt + WT_DOWN / 2, FFN, 0, 1.f, scr, r, lane);
            }
        }
#endif
#if EN_MISC
        {
            const size_t n8 = (size_t)NB_S * DEPTH * NH * PAST * HD / 8;
            for (size_t i = (size_t)gw * 64 + lane; i < 2 * n8; i += (size_t)NGW * 64) { const bool isk = i < n8; const size_t j = isk ? i : i - n8;
                const float* s = (isk ? args.in[I_CK] : args.in[I_CV]) + j * 8; const f32x4 a = *(const f32x4*)s, b = *(const f32x4*)(s + 4);
                u32x4 w; w.x = cvt_pk_bf16(a[0], a[1]); w.y = cvt_pk_bf16(a[2], a[3]); w.z = cvt_pk_bf16(b[0], b[1]); w.w = cvt_pk_bf16(b[2], b[3]);
                *(u32x4*)((isk ? CKB : CVB) + j * 8) = w; }
        }
        {
            for (int i = gw * 64 + lane; i < 512 * 256 / 8; i += NGW * 64) { const int j = i >> 5, c0 = (i & 31) * 8; const bool isin = j >= 256; const int jj = j & 255;
                float v[8];
#pragma unroll
                for (int e = 0; e < 8; ++e) { const int mm = (jj * (c0 + e)) & 255; const float x = (float)mm * (1.0f / 128.0f); v[e] = (isin ? -sinpif(x) : cospif(x)) * (1.0f / 16.0f); }
                u32x4 w; w.x = cvt_pk_bf16(v[0], v[1]); w.y = cvt_pk_bf16(v[2], v[3]); w.z = cvt_pk_bf16(v[4], v[5]); w.w = cvt_pk_bf16(v[6], v[7]);
                *(u32x4*)(DC + (size_t)j * 256 + c0) = w; }
            for (int i = gw * 64 + lane; i < 256 * 512 / 8; i += NGW * 64) { const int k1 = i >> 6, c8 = (i & 63) * 8; const bool isin = c8 >= 256; const int n0 = c8 & 255;
                float v[8];
#pragma unroll
                for (int e = 0; e < 8; ++e) { const int mm = (k1 * (n0 + e)) & 255; const float x = (float)mm * (1.0f / 128.0f); v[e] = (isin ? sinpif(x) : cospif(x)) * (1.0f / 16.0f); }
                u32x4 w; w.x = cvt_pk_bf16(v[0], v[1]); w.y = cvt_pk_bf16(v[2], v[3]); w.z = cvt_pk_bf16(v[4], v[5]); w.w = cvt_pk_bf16(v[6], v[7]);
                *(u32x4*)(DP + (size_t)k1 * 512 + c8) = w;
                w.x = cvt_pk_bf16(v[0] * 0.25f, v[1] * 0.25f); w.y = cvt_pk_bf16(v[2] * 0.25f, v[3] * 0.25f); w.z = cvt_pk_bf16(v[4] * 0.25f, v[5] * 0.25f); w.w = cvt_pk_bf16(v[6] * 0.25f, v[7] * 0.25f);
                *(u32x4*)(DS + (size_t)k1 * 512 + c8) = w; }
        }
#endif
    }
    GRID_BAR();

    if (threadIdx.x == 0) {
        unsigned* rk = (unsigned*)(ws + WS_CTL) + CW_XRANK; const unsigned xcc = MISC[2], myrank = MISC[3]; unsigned npop = 0, xidx = 0; bool ok = (G % 8) == 0;
        for (unsigned j = 0; j < 16; ++j) { const unsigned cnt = xb_ld(rk + 64 * j); if (cnt) { ++npop; if (j < xcc) ++xidx; if (cnt != (unsigned)(G / 8)) ok = false; } }
        if (ok && npop == 8) { MISC[4] = myrank * 8u + xidx; MISC[5] = 1u; }
    }
    __syncthreads();
    {
        PIN_TID();
#if EN_NORM
        { const float* gvec = args.in[I_N1G];
          for (int row = gw; row < M; row += NGW) {
            const float* src = row < MP ? args.in[I_XP] + (size_t)row * D : args.in[I_XS] + (size_t)(row - MP) * D;
            f32x4 v[8]; float ssq = 0.f;
#pragma unroll
            for (int j = 0; j < 8; ++j) { v[j] = *(const GAS f32x4*)(src + 4 * (lane + 64 * j)); ssq += (v[j][0] * v[j][0] + v[j][1] * v[j][1]) + (v[j][2] * v[j][2] + v[j][3] * v[j][3]); }
            ssq = wave_sum(ssq);
            const int bv = row < MP ? 0 : 1 + ((row - MP) >> 12);
            const float* scp = MODS + ((size_t)bv * NMOD + 1) * D;
#pragma unroll
            for (int j = 0; j < 8; ++j) { const int col = 4 * (lane + 64 * j); const f32x4 g = *(const GAS f32x4*)(gvec + col), sc = *(const GAS f32x4*)(scp + col);
                const f32x4 y = v[j] * g * (sc + 1.0f); u32x2 w; w.x = cvt_pk_bf16(y[0], y[1]); w.y = cvt_pk_bf16(y[2], y[3]); *(GAS u32x2*)(HB + (size_t)row * D + col) = w; }
            if (lane == 0) SS[row] = ssq;
          } }
#endif
#if EN_MISC
        for (int l = 0; l < DEPTH; ++l) {
            LAS float* shl = (LAS float*)lds;
            __syncthreads();
            for (int idx = tid; idx < 2 * 5 * D; idx += NTHREADS) { const int w2 = idx / (5 * D), r = idx - w2 * 5 * D, bv = r / D, k = r - bv * D; shl[idx] = MODS[(((size_t)l * 5 + bv) * NMOD + (w2 ? 3 : 0)) * D + k]; }
            __syncthreads();
            const bf16_t* wt_in = (const bf16_t*)(ws + WS_WT + (size_t)l * WT_LAYER + WT_IN); const bf16_t* wt_up = (const bf16_t*)(ws + WS_WT + (size_t)l * WT_LAYER + WT_UP);
            for (int r = gw; r < IN_DIM + FFN2; r += NGW) {
                const bool isup = r >= IN_DIM; const int n = isup ? r - IN_DIM : r;
                const bf16_t* wrow = (isup ? wt_up : wt_in) + (size_t)n * D; const LAS float* sh = shl + (isup ? 5 * D : 0);
                float a5[5] = {0.f, 0.f, 0.f, 0.f, 0.f};
#pragma unroll
                for (int j = 0; j < 4; ++j) { const int k0 = 512 * j + 8 * lane; const u32x4 w = *(const GAS u32x4*)(wrow + k0);
                    float wf[8];
#pragma unroll
                    for (int e = 0; e < 4; ++e) { wf[2 * e] = bf_lo(w[e]); wf[2 * e + 1] = bf_hi(w[e]); }
#pragma unroll
                    for (int bv = 0; bv < 5; ++bv) { const f32x4 s0 = *(const LAS f32x4*)(sh + bv * D + k0), s1 = *(const LAS f32x4*)(sh + bv * D + k0 + 4);
                        a5[bv] += (wf[0] * s0[0] + wf[1] * s0[1]) + (wf[2] * s0[2] + wf[3] * s0[3]) + (wf[4] * s1[0] + wf[5] * s1[1]) + (wf[6] * s1[2] + wf[7] * s1[3]); } }
#pragma unroll
                for (int bv = 0; bv < 5; ++bv) { const float t = wave_sum(a5[bv]); if (lane == 0) { if (isup) BUP[((size_t)l * 5 + bv) * FFN2 + n] = t; else BIN[((size_t)l * 5 + bv) * IN_DIM + n] = t; } }
            }
        }
        __syncthreads();
#endif
    }
    GRID_BAR();

    for (int l = 0; l < DEPTH; ++l) {
        const float* mods_l = MODS + (size_t)l * 5 * NMOD * D;
        const unsigned char* wt = ws + WS_WT + (size_t)l * WT_LAYER;
#if EN_GIN
        {
            OPQ_BX();
            pg8::TileOrder S; S.init(M, IN_DIM, G, bx, HB, D, wt + WT_IN, D, QK, IN_DIM, 2);
            pg8::EpiIn E{OUTK, OUTV, l, SS + (size_t)(2 * l) * M, BIN + (size_t)l * 5 * IN_DIM, (const LAS float*)(lds + pg8::STAGE_BYTES)};
            for (int rep_ = 0; rep_ < REP_GIN; ++rep_)
            pg8::gemm_phase<pg8::EpiIn, pg8::TileOrder>(lds, wave0, D, D, D, S, E);
        }
#endif
        GRID_BAR();

        unsigned mo5_ = MISC_OFF + 20; asm volatile("; opaque LDS offset" : "+v"(mo5_));
        const bool merged_ok = (G == 256) && (__builtin_amdgcn_readfirstlane((int)*(volatile LAS unsigned*)(lds + mo5_)) != 0);
        unsigned* const fcnt = (unsigned*)(ws + WS_CTL) + CW_FOUR + (size_t)l * 96 * 16;
        const bool four_ok = merged_ok && (FOUR_MERGE != 0);
        {
            OPQ_BX();
#if EN_F1
            for (int rep_ = 0; rep_ < REP_FOUR; ++rep_) {
            { F1SOrder S{{four_ok, nullptr, nullptr, 0u}, G, bx, (const char*)DC, (const char*)QK, (char*)GTS}; pg8::EpiBf16U<8192> E{(const LAS float*)(lds + pg8::STAGE_BYTES)}; pg8::gemm_phase<pg8::EpiBf16U<8192>, F1SOrder>(lds, wave0, 256, IN_DIM, 256, S, E); }
            { F1POrder S{{four_ok, nullptr, nullptr, 0u}, G, bx, (const char*)DC, (const char*)QK, (char*)GTP}; pg8::EpiBf16U<512> E{(const LAS float*)(lds + pg8::STAGE_BYTES)}; pg8::gemm_phase<pg8::EpiBf16U<512>, F1POrder>(lds, wave0, 256, IN_DIM, 256, S, E); }
            }
#endif
#if EN_ATT
            for (int rep_ = 0; rep_ < REP_ATT; ++rep_)
            for (int U = bx; U < 640; U += G) {
                if (U < 512) {
                    const int b = U >> 7, h = (U >> 4) & 7, i4 = U & 15;
                    const int kr0 = max(4 * i4 - 4, 0), ntn = (i4 == 0 || i4 == 15) ? 8 : 11;
                    const size_t rowbase = (size_t)MP + (size_t)b * SEQ_S;
                    att::TileSrc T;
                    T.K0 = CKB + (((size_t)b * DEPTH + l) * NH + h) * PAST * HD; T.V0 = CVB + (((size_t)b * DEPTH + l) * NH + h) * PAST * HD; T.ld0 = HD; T.nt0 = 4;
                    T.K1 = QK + (rowbase + (size_t)kr0 * GW) * IN_DIM + 1024 + h * HD; T.V1 = T.K1 + 1024; T.ld1 = IN_DIM; T.nt1 = ntn;
                    att::attn_unit<true>((LAS char*)lds, wave0, QK + (rowbase + (size_t)i4 * 256) * IN_DIM + h * HD, IN_DIM, T, kr0, 4 * i4,
                                         args.in[I_RPB] + ((size_t)l * NH + h) * 15 * 31, AF + (rowbase + (size_t)i4 * 256) * D + h * HD, D);
                } else {
                    const int bh = U - 512, b = bh >> 3, h = bh & 7;
                    att::TileSrc T;
                    T.K0 = QK + ((size_t)b * SEQ_P) * IN_DIM + 1024 + h * HD; T.V0 = T.K0 + 1024; T.ld0 = IN_DIM; T.nt0 = 4;
                    T.K1 = T.K0; T.V1 = T.V0; T.ld1 = IN_DIM; T.nt1 = 0;
                    att::attn_unit<false>((LAS char*)lds, wave0, QK + ((size_t)b * SEQ_P) * IN_DIM + h * HD, IN_DIM, T, 0, 0, nullptr, AF + ((size_t)b * SEQ_P) * D + h * HD, D);
                }
            }
#endif
            if (four_ok) {
                asm volatile("s_waitcnt vmcnt(0)" ::: "memory");
                if (fresh_lane() == 0) { const int x_ = bx & 7, k_ = bx >> 3;
                    __hip_atomic_fetch_add((GAS unsigned*)(fcnt + (2 * x_) * 16), 1u, __ATOMIC_RELAXED, __HIP_MEMORY_SCOPE_AGENT);
                    __hip_atomic_fetch_add((GAS unsigned*)(fcnt + (2 * x_ + 1) * 16), 1u, __ATOMIC_RELAXED, __HIP_MEMORY_SCOPE_AGENT);
                    if (k_ >= 16) __hip_atomic_fetch_add((GAS unsigned*)(fcnt + (16 + 8 * x_ + ((k_ - 16) >> 1)) * 16), 1u, __ATOMIC_RELAXED, __HIP_MEMORY_SCOPE_AGENT); }
            }
        }
        if (!four_ok || FOUR_KEEPBAR) GRID_BAR();

#if EN_F2
        {
            PIN_TID();
            OPQ_BX();
            if (four_ok) {
                unsigned sp = 0;
                for (int q = 0; q < 2; ++q) { GAS unsigned* fp = (GAS unsigned*)(fcnt + (2 * (bx & 7) + q) * 16);
                    while ((unsigned)__builtin_amdgcn_readfirstlane(__hip_atomic_load(fp, __ATOMIC_RELAXED, __HIP_MEMORY_SCOPE_AGENT)) < 256u) { __builtin_amdgcn_s_sleep(2); if (++sp > (1u << 20)) break; } }
                __builtin_amdgcn_fence(__ATOMIC_ACQUIRE, "agent"); asm volatile("s_waitcnt vmcnt(0)" ::: "memory");
            }
            for (int rep_ = 0; rep_ < REP_FOUR; ++rep_)
            for (int jt = 0; ; ++jt) {
                int it;
                if (four_ok) { if (jt >= 4) break; const int li = (bx >> 3) * NWAVES + wave + 256 * jt; it = ((2 * (bx & 7) + (li >> 9)) << 9) + (li & 511); }
                else { it = gw + jt * NGW; if (it >= 16 * 256 * 2) break; }
                const int row = it >> 1, half = it & 1;
                const char* src = (const char*)GTS + (size_t)row * 8192 * 2 + (unsigned)(half * 256 + lane * 4);
                unsigned zr[16], zi[16];
#pragma unroll
                for (int n2 = 0; n2 < 16; ++n2) { zr[n2] = *(const GAS unsigned*)(src + n2 * 512); zi[n2] = *(const GAS unsigned*)(src + 8192 + n2 * 512); }
                unsigned orr[16], oii[16];
#pragma unroll
                for (int j = 0; j < 2; ++j) {
                    float xr[16], xi[16];
#pragma unroll
                    for (int n2 = 0; n2 < 16; ++n2) { xr[n2] = j ? bf_hi(zr[n2]) : bf_lo(zr[n2]); xi[n2] = j ? bf_hi(zi[n2]) : bf_lo(zi[n2]); }
                    fft16(xr, xi);
                    float s1, c1; sincospif((float)(128 * half + 2 * lane + j) * (1.0f / 2048.0f), &s1, &c1);
                    float wr = 1.f, wi = 0.f;
#pragma unroll
                    for (int k2 = 0; k2 < 16; ++k2) { const int slot = 4 * (k2 & 3) + (k2 >> 2);
                        const float ur = xr[slot] * wr - xi[slot] * wi, ui = xr[slot] * wi + xi[slot] * wr;
                        if (j == 0) { orr[k2] = __float_as_uint(ur); oii[k2] = __float_as_uint(ui); }
                        else { orr[k2] = cvt_pk_bf16(__uint_as_float(orr[k2]), ur); oii[k2] = cvt_pk_bf16(__uint_as_float(oii[k2]), ui); }
                        const float nwr = wr * c1 + wi * s1, nwi = wi * c1 - wr * s1; wr = nwr; wi = nwi; }
                }
                const int bg = row >> 8, c = row & 255;
                char* dst = (char*)U2 + ((size_t)(bg * 16) * 256 + c) * 512 * 2 + (unsigned)(half * 256 + lane * 4);
#pragma unroll
                for (int k2 = 0; k2 < 16; ++k2) { *(GAS unsigned*)(dst + (size_t)k2 * 256 * 512 * 2) = orr[k2]; *(GAS unsigned*)(dst + (size_t)k2 * 256 * 512 * 2 + 512) = oii[k2]; }
            }
            if (four_ok) { asm volatile("s_waitcnt vmcnt(0)" ::: "memory");
                if (fresh_lane() == 0) { __hip_atomic_fetch_add((GAS unsigned*)(fcnt + (80 + 2 * (bx & 7)) * 16), 2u, __ATOMIC_RELAXED, __HIP_MEMORY_SCOPE_AGENT);
                                         __hip_atomic_fetch_add((GAS unsigned*)(fcnt + (81 + 2 * (bx & 7)) * 16), 2u, __ATOMIC_RELAXED, __HIP_MEMORY_SCOPE_AGENT); } }
        }
#endif
        if (!four_ok || FOUR_KEEPBAR) GRID_BAR();

#if EN_F2
        {
            OPQ_BX();
            for (int rep_ = 0; rep_ < REP_FOUR; ++rep_) {
            { F2SOrder S{{four_ok, nullptr, fcnt + 80 * 16, 512u}, G, bx, (const char*)DS, (const char*)U2, (char*)AF}; pg8::EpiBf16U<16 * D> E{(const LAS float*)(lds + pg8::STAGE_BYTES)}; pg8::gemm_phase<pg8::EpiBf16U<16 * D>, F2SOrder>(lds, wave0, 512, 512, 512, S, E); }
            { F2POrder S{{four_ok, nullptr, fcnt + 16 * 16, 16u}, G, bx, (const char*)DP, (const char*)GTP, (char*)AF}; pg8::EpiBf16U<D> E{(const LAS float*)(lds + pg8::STAGE_BYTES)}; pg8::gemm_phase<pg8::EpiBf16U<D>, F2POrder>(lds, wave0, 512, 512, 512, S, E); }
            }
        }
#endif
        GRID_BAR();

        if (merged_ok) {
            OPQ_BX();
            pg8::PabOutOrder S{bx, (const char*)AF, (const char*)(wt + WT_PA), (const char*)YB, (const char*)(wt + WT_OUT), (unsigned*)(ws + WS_CTL) + CW_PANEL + (size_t)l * 80 * 16};
            pg8::EpiPabOut E{pg8::EpiPab{QK, YB, (const LAS float*)(lds + pg8::STAGE_BYTES)},
                             pg8::EpiRes{args.in[I_XP], args.in[I_XS], X, mods_l, 2, l == 0, X, true, args.in[I_N2G] + (size_t)l * D, mods_l + 4 * D, SS + (size_t)(2 * l + 1) * M, HB, (const LAS float*)(lds + pg8::STAGE_BYTES)}};
            pg8::gemm_phase<pg8::EpiPabOut, pg8::PabOutOrder>(lds, wave0, D, D, D, S, E);
        } else {
#if EN_PAB
        {
            OPQ_BX();
            for (int rep_ = 0; rep_ < REP_PAB; ++rep_) {
            pg8::TileOrder S; S.init(M, D, G, bx, AF, D, wt + WT_PA, AD + FD, YB, D, 2); S.half_tail(); pg8::EpiPab E{QK, YB, (const LAS float*)(lds + pg8::STAGE_BYTES)}; pg8::gemm_phase<pg8::EpiPab, pg8::TileOrder>(lds, wave0, D, AD + FD, AD + FD, S, E);
            }
        }
#endif
        GRID_BAR();

#if EN_OUT
        {
            OPQ_BX();
            pg8::TileOrder S; S.init(M, D, G, bx, YB, D, wt + WT_OUT, D, X, D, 4); S.half_tail();
            pg8::EpiRes E{args.in[I_XP], args.in[I_XS], X, mods_l, 2, l == 0, X, true, args.in[I_N2G] + (size_t)l * D, mods_l + 4 * D, SS + (size_t)(2 * l + 1) * M, HB, (const LAS float*)(lds + pg8::STAGE_BYTES)};
            for (int rep_ = 1; rep_ < REP_OUT; ++rep_) { pg8::EpiRes E2{args.in[I_XP], args.in[I_XS], X, mods_l, 2, l == 0, (float*)QK, false, nullptr, nullptr, nullptr, nullptr, (const LAS float*)(lds + pg8::STAGE_BYTES)}; pg8::gemm_phase<pg8::EpiRes, pg8::TileOrder>(lds, wave0, D, D, D, S, E2); }
            pg8::gemm_phase<pg8::EpiRes, pg8::TileOrder>(lds, wave0, D, D, D, S, E);
        }
#endif
        }
        GRID_BAR();

#if EN_UP
        {
            OPQ_BX();
            pg8::UpOrder S; S.init(G, bx, HB, wt + WT_UP, ACT);
            pg8::EpiUpConv E{args.in[I_CONVW] + (size_t)l * 3 * FFN2, args.in[I_CONVB] + (size_t)l * FFN2, UH, SS + (size_t)(2 * l + 1) * M, BUP + (size_t)l * 5 * FFN2, (const LAS float*)(lds + pg8::STAGE_BYTES)};
            for (int rep_ = 0; rep_ < REP_UP; ++rep_)
            pg8::gemm_phase<pg8::EpiUpConv, pg8::UpOrder>(lds, wave0, D, D, D, S, E);
        }
#endif
        GRID_BAR();

#if EN_CONV
        {
            PIN_TID();
            const float* cw = args.in[I_CONVW] + (size_t)l * 3 * FFN2; const float* cb = args.in[I_CONVB] + (size_t)l * FFN2;
            for (int rep_ = 0; rep_ < REP_THIN; ++rep_)
            for (int it = gw; it < (M / 256) * 4 * 11; it += NGW) {
                const int pm = it / 44, rem = it - pm * 44, t = rem / 11, cc = rem - t * 11, j0 = cc * 512 + lane * 8;
                const int row = pm * 256 + (t == 0 ? 0 : t == 1 ? 127 : t == 2 ? 128 : 255);
                const int seqmask = row < MP ? (SEQ_P - 1) : (SEQ_S - 1);
                const int sc_ = t == 0 ? 0 : t == 1 ? 3 : t == 2 ? 4 : 7;
                const bool zprev = (t == 0) && ((row & seqmask) == 0), znext = (t == 3) && ((row & seqmask) == seqmask);
                const float* pc = UH + ((size_t)pm * 8 + sc_) * FFN2 + j0;
                const float* pp = (t == 0) ? UH + ((size_t)(pm - 1) * 8 + 7) * FFN2 + j0 : pc - FFN2;
                const float* pn = (t == 3) ? UH + ((size_t)(pm + 1) * 8 + 0) * FFN2 + j0 : pc + FFN2;
                float o[8];
#pragma unroll
                for (int h = 0; h < 2; ++h) {
                    const f32x4 z4 = {0.f, 0.f, 0.f, 0.f};
                    const f32x4 ap = zprev ? z4 : *(const GAS f32x4*)(pp + 4 * h), ac = *(const GAS f32x4*)(pc + 4 * h), an = znext ? z4 : *(const GAS f32x4*)(pn + 4 * h);
                    const f32x4 gp = zprev ? z4 : *(const GAS f32x4*)(pp + FFN + 4 * h), gc = *(const GAS f32x4*)(pc + FFN + 4 * h), gn = znext ? z4 : *(const GAS f32x4*)(pn + FFN + 4 * h);
                    const f32x4 wa0 = *(const GAS f32x4*)(cw + j0 + 4 * h), wa1 = *(const GAS f32x4*)(cw + FFN2 + j0 + 4 * h), wa2 = *(const GAS f32x4*)(cw + 2 * FFN2 + j0 + 4 * h), ba = *(const GAS f32x4*)(cb + j0 + 4 * h);
                    const f32x4 wg0 = *(const GAS f32x4*)(cw + FFN + j0 + 4 * h), wg1 = *(const GAS f32x4*)(cw + FFN2 + FFN + j0 + 4 * h), wg2 = *(const GAS f32x4*)(cw + 2 * FFN2 + FFN + j0 + 4 * h), bg = *(const GAS f32x4*)(cb + FFN + j0 + 4 * h);
#pragma unroll
                    for (int e = 0; e < 4; ++e) { const float A = wa0[e] * ap[e] + wa1[e] * ac[e] + wa2[e] * an[e] + ba[e], Gv = wg0[e] * gp[e] + wg1[e] * gc[e] + wg2[e] * gn[e] + bg[e];
                        o[4 * h + e] = Gv * sigmoidf_fast(Gv) * A; }
                }
                u32x4 w; w.x = cvt_pk_bf16(o[0], o[1]); w.y = cvt_pk_bf16(o[2], o[3]); w.z = cvt_pk_bf16(o[4], o[5]); w.w = cvt_pk_bf16(o[6], o[7]);
                *(GAS u32x4*)(ACT + (size_t)row * FFN + j0) = w;
            }
        }
#endif
        GRID_BAR();

#if EN_DOWN
        {
            OPQ_BX();
            pg8::TileOrder S; S.init(M, D, G, bx, ACT, FFN, wt + WT_DOWN, FFN, X, D, 4); S.split_tail(40, (unsigned*)(ws + WS_CTL) + CW_FLAG + (size_t)l * 128 * 16);
            const int ln = l + 1 < DEPTH ? l + 1 : l;
            pg8::EpiRes E{args.in[I_XP], args.in[I_XS], X, mods_l, 5, false, X, l + 1 < DEPTH, args.in[I_N1G] + (size_t)ln * D, MODS + (size_t)ln * 5 * NMOD * D + 1 * D, SS + (size_t)(2 * ln) * M, HB, (const LAS float*)(lds + pg8::STAGE_BYTES)};
            for (int rep_ = 1; rep_ < REP_DOWN; ++rep_) { pg8::EpiRes E2{args.in[I_XP], args.in[I_XS], X, mods_l, 5, false, (float*)QK, false, nullptr, nullptr, nullptr, nullptr, (const LAS float*)(lds + pg8::STAGE_BYTES)}; pg8::gemm_phase<pg8::EpiRes, pg8::TileOrder>(lds, wave0, FFN, FFN, FFN, S, E2); }
            pg8::gemm_phase<pg8::EpiRes, pg8::TileOrder>(lds, wave0, FFN, FFN, FFN, S, E);
        }
#endif
        GRID_BAR();
    }

#if EN_FINAL
    {
        PIN_TID();
        const float* gvec = args.in[I_NFG];
        for (int row = gw; row < M; row += NGW) {
            float* src = X + (size_t)row * D;
            f32x4 v[8]; float ss = 0.f;
#pragma unroll
            for (int j = 0; j < 8; ++j) { v[j] = *(const f32x4*)(src + 4 * (lane + 64 * j)); ss += (v[j][0] * v[j][0] + v[j][1] * v[j][1]) + (v[j][2] * v[j][2] + v[j][3] * v[j][3]); }
            const float rstd = rsqrtf(wave_sum(ss) * (1.0f / D) + RMS_EPS);
#pragma unroll
            for (int j = 0; j < 8; ++j) { const int col = 4 * (lane + 64 * j); const f32x4 g = *(const f32x4*)(gvec + col); *(f32x4*)(src + col) = (v[j] * rstd) * g; }
        }
    }
#endif
}

extern "C" void kernel_launch(void* const* d_in, const int* in_sizes, int n_in, void* d_out, int out_size, void* d_ws, size_t ws_size, hipStream_t stream) {
    static int grid = 0;
    if (grid == 0) {
        if (n_in != 20 || in_sizes[0] != MP * D || in_sizes[1] != MS * D || ws_size < WS_END) {
            fprintf(stderr, "kernel_launch: shape mismatch: n_in %d in0 %d in1 %d out %d ws %zu (need >= %zu); nothing launched\n", n_in, n_in > 0 ? in_sizes[0] : -1, n_in > 1 ? in_sizes[1] : -1, out_size, ws_size, (size_t)WS_END); grid = -1; return; }
        int dev = 0, cus = 0, per_cu = 0;
        if (hipGetDevice(&dev) != hipSuccess || hipDeviceGetAttribute(&cus, hipDeviceAttributeMultiprocessorCount, dev) != hipSuccess) { fprintf(stderr, "kernel_launch: device query failed\n"); grid = -1; return; }
        if (hipFuncSetAttribute((const void*)fwd, hipFuncAttributeMaxDynamicSharedMemorySize, LDS_BYTES) != hipSuccess) { fprintf(stderr, "kernel_launch: hipFuncSetAttribute failed\n"); grid = -1; return; }
        if (hipOccupancyMaxActiveBlocksPerMultiprocessor(&per_cu, (const void*)fwd, NTHREADS, LDS_BYTES) != hipSuccess || per_cu < 1)
            fprintf(stderr, "kernel_launch: note: occupancy query reports %d workgroups per CU\n", per_cu);
        (void)hipGetLastError();
        grid = cus;
    }
    if (grid < 0) return;
    if (hipMemsetAsync((char*)d_ws + WS_CTL, 0, CTL_ZERO_BYTES, stream) != hipSuccess) { fprintf(stderr, "kernel_launch: memset failed\n"); return; }
    Args a{};
    for (int i = 0; i < 20; ++i) a.in[i] = (const float*)d_in[i];
    a.out = (float*)d_out; a.ws = (unsigned char*)d_ws;
    hipLaunchKernelGGL(fwd, dim3(grid), dim3(NTHREADS), LDS_BYTES, stream, a);
    const hipError_t le = hipPeekAtLastError();
    if (le != hipSuccess) fprintf(stderr, "kernel_launch: launch failed: %s\n", hipGetErrorName(le));
}
```

```cpp
#include <hip/hip_runtime.h>
#include <cstdio>
#include <cstdint>

#define GAS __attribute__((address_space(1)))
#define LAS __attribute__((address_space(3)))
typedef unsigned short bf16_t;
typedef short bf16x8 __attribute__((ext_vector_type(8)));
typedef short s16x4 __attribute__((ext_vector_type(4)));
typedef float f32x4 __attribute__((ext_vector_type(4)));
typedef float f32x2 __attribute__((ext_vector_type(2)));
typedef float f32x16 __attribute__((ext_vector_type(16)));
typedef unsigned u32x4 __attribute__((ext_vector_type(4)));
typedef unsigned u32x2 __attribute__((ext_vector_type(2)));

#ifndef EN_MODS
#define EN_MODS 1
#endif
#ifndef EN_WT
#define EN_WT 1
#endif
#ifndef EN_MISC
#define EN_MISC 1
#endif
#ifndef EN_NORM
#define EN_NORM 1
#endif
#ifndef EN_GIN
#define EN_GIN 1
#endif
#ifndef EN_ATT
#define EN_ATT 1
#endif
#ifndef EN_F1
#define EN_F1 1
#endif
#ifndef EN_F2
#define EN_F2 1
#endif
#ifndef EN_PAB
#define EN_PAB 1
#endif
#ifndef EN_OUT
#define EN_OUT 1
#endif
#ifndef EN_UP
#define EN_UP 1
#endif
#ifndef EN_CONV
#define EN_CONV 1
#endif
#ifndef EN_DOWN
#define EN_DOWN 1
#endif
#ifndef EN_FINAL
#define EN_FINAL 1
#endif
#ifndef REP_P0
#define REP_P0 1
#endif
#ifndef FOUR_MERGE
#define FOUR_MERGE 0
#endif
#ifndef FOUR_KEEPBAR
#define FOUR_KEEPBAR 0
#endif
#ifndef REP_ATT
#define REP_ATT 1
#endif
#ifndef REP_THIN
#define REP_THIN 1
#endif
#ifndef REP_GIN
#define REP_GIN 1
#endif
#ifndef REP_BAR
#define REP_BAR 1
#endif
#ifndef REP_OUT
#define REP_OUT 1
#endif
#ifndef REP_DOWN
#define REP_DOWN 1
#endif
#ifndef REP_PAB
#define REP_PAB 1
#endif
#ifndef REP_FOUR
#define REP_FOUR 1
#endif
#ifndef REP_UP
#define REP_UP 1
#endif
constexpr int D = 2048, NB_P = 16, SEQ_P = 256, DEPTH = 4, NB_S = 4, SEQ_S = 4096, PAST = 256;
constexpr int MP = NB_P * SEQ_P;
constexpr int MS = NB_S * SEQ_S;
constexpr int M = MP + MS;
constexpr int NH = 8, HD = 128, AD = 1024, FD = 1024, FFN = 5632, FFN2 = 11264, IN_DIM = 8192, NMOD = 6;
constexpr int GW = 64;
constexpr float RMS_EPS = 1e-6f;
constexpr float QSCALE = 0.08838834764831845f * 1.4426950408889634f;
constexpr float LOG2E = 1.4426950408889634f;

constexpr size_t MiB = 1u << 20;
constexpr size_t WS_CTL = 0, CTL_ZERO_BYTES = 2 * MiB;
constexpr size_t WS_SS = 1 * MiB;
constexpr size_t WS_MODS = 2 * MiB;
constexpr size_t WS_BIAS = 3 * MiB;
constexpr size_t WS_CACHE = 5 * MiB;
constexpr size_t WS_DC = 21 * MiB;
constexpr size_t WS_DP = WS_DC + 256 * 1024;
constexpr size_t WS_DS = WS_DP + 256 * 1024;
constexpr size_t WS_UP2 = 22 * MiB;
constexpr size_t WS_WT = 86 * MiB;
constexpr size_t WT_IN = 0, WT_PA = (size_t)IN_DIM * D * 2, WT_PB = WT_PA + (size_t)D * AD * 2, WT_OUT = WT_PB + (size_t)D * FD * 2,
                 WT_UP = WT_OUT + (size_t)D * D * 2, WT_DOWN = WT_UP + (size_t)FFN2 * D * 2, WT_LAYER = WT_DOWN + (size_t)D * FFN * 2;
static_assert(WT_LAYER == 114 * MiB, "weight copy size");
constexpr size_t WS_H = WS_WT + 4 * WT_LAYER;
constexpr size_t WS_BIG = WS_H + 80 * MiB;
constexpr size_t WS_UH = WS_BIG + 320 * MiB;
constexpr size_t WS_AF = WS_BIG + 440 * MiB;
constexpr size_t WS_GTS = WS_AF + 80 * MiB;
constexpr size_t WS_GTP = WS_GTS + 64 * MiB;
constexpr size_t WS_T1 = WS_GTP + 16 * MiB;
constexpr size_t WS_ACT = WS_AF;
constexpr size_t WS_Y = WS_T1 + 160 * MiB;
constexpr size_t WS_END = WS_Y + 80 * MiB;
static_assert(WS_END <= 1536 * MiB, "workspace map");
static_assert((size_t)M * FFN * 2 <= 320 * MiB, "act overlay");

constexpr int CW_FLAG = 65536;
constexpr int CW_FOUR = 131072;
constexpr int CW_PANEL = 98304;
constexpr int CW_XRANK = 32768;
constexpr int CW_BAR = 4096;

constexpr int LDS_BYTES = 163840;
constexpr int MISC_OFF = LDS_BYTES - 256;
constexpr int NWAVES = 8, NTHREADS = 512;

#define LDS_WAIT() asm volatile("s_waitcnt lgkmcnt(0)" ::: "memory")
#define VM_WAIT() asm volatile("s_waitcnt vmcnt(0)" ::: "memory")
__device__ __forceinline__ unsigned cvt_pk_bf16(float lo, float hi) { unsigned r; asm volatile("v_cvt_pk_bf16_f32 %0, %1, %2" : "=v"(r) : "v"(lo), "v"(hi)); return r; }
__device__ __forceinline__ float bf_lo(unsigned w) { return __uint_as_float(w << 16); }
__device__ __forceinline__ float bf_hi(unsigned w) { return __uint_as_float(w & 0xffff0000u); }
__device__ __forceinline__ float sigmoidf_fast(float x) { return __builtin_amdgcn_rcpf(1.0f + __expf(-x)); }
template <int CTRL> __device__ __forceinline__ float dpp_add(float v) { return v + __int_as_float(__builtin_amdgcn_update_dpp(0, __float_as_int(v), CTRL, 0xf, 0xf, true)); }
__device__ __forceinline__ float wave_sum(float v) {
    v = dpp_add<0xB1>(v);
    v = dpp_add<0x4E>(v);
    v = dpp_add<0x141>(v);
    v = dpp_add<0x140>(v);
    const float s0 = __int_as_float(__builtin_amdgcn_readlane(__float_as_int(v), 0)), s1 = __int_as_float(__builtin_amdgcn_readlane(__float_as_int(v), 16));
    const float s2 = __int_as_float(__builtin_amdgcn_readlane(__float_as_int(v), 32)), s3 = __int_as_float(__builtin_amdgcn_readlane(__float_as_int(v), 48));
    return (s0 + s1) + (s2 + s3);
}
__device__ __forceinline__ int fresh_wave(int w) { asm volatile("; opaque wave index" : "+s"(w)); return w; }
__device__ __forceinline__ int fresh_lane() { int l; asm volatile("v_mbcnt_lo_u32_b32 %0, -1, 0\n\tv_mbcnt_hi_u32_b32 %0, -1, %0" : "=v"(l)); return l; }

#define XB_TMO      128
#define XB_XCNT(j)  (256  + 64 * (j))
#define XB_XSUB(j)  (1280 + 64 * (j))
#define XB_XGEN(j)  (2304 + 64 * (j))
#define XB_TOP      3328
#define XB_TOPGEN   3392
#define XCD_BAR_WORDS 3456
#define XB_SPIN_CAP (1u << 18)
__device__ __forceinline__ unsigned xb_ld(unsigned* p)              { return __hip_atomic_load((GAS unsigned*)p, __ATOMIC_RELAXED, __HIP_MEMORY_SCOPE_AGENT); }
__device__ __forceinline__ unsigned xb_add(unsigned* p, unsigned v) { return __hip_atomic_fetch_add((GAS unsigned*)p, v, __ATOMIC_RELAXED, __HIP_MEMORY_SCOPE_AGENT); }
__device__ __forceinline__ unsigned xb_xcc_id() { return (unsigned)__builtin_amdgcn_s_getreg((3 << 11) | 20) & 0xFu; }
#define XB_SPIN(cond, bar) do { unsigned _sp = 0; while (cond) { __builtin_amdgcn_s_sleep(1); \
    if ((++_sp & 255u) == 0u) { if (xb_ld(&(bar)[XB_TMO])) break; if (_sp > XB_SPIN_CAP) { xb_add(&(bar)[XB_TMO], 1u); break; } } } } while (0)
struct XcdBarrier { unsigned* bar; unsigned x; volatile LAS unsigned* st; };
__device__ __forceinline__ XcdBarrier xcd_barrier_post(unsigned* bar, volatile LAS unsigned* st) {
    XcdBarrier b; b.bar = bar; b.x = xb_xcc_id(); b.st = st;
    if (threadIdx.x == 0) (void)xb_add(&bar[XB_XCNT(b.x)], 1u);
    return b;
}
__device__ __forceinline__ void xcd_barrier_complete(unsigned* bar, unsigned x, unsigned& nloc, unsigned& nx) {
    const unsigned G = gridDim.x * gridDim.y * gridDim.z;
    unsigned sum, cnt, mine, sp = 0u;
    for (;;) {
        sum = 0u; cnt = 0u; mine = 0u;
#pragma unroll
        for (unsigned j = 0; j < 16; ++j) { const unsigned c = xb_ld(&bar[XB_XCNT(j)]); sum += c; cnt += (c > 0u) ? 1u : 0u; mine = (j == x) ? c : mine; }
        if (sum == G) break;
        __builtin_amdgcn_s_sleep(1);
        if ((++sp & 255u) == 0u) { if (xb_ld(&bar[XB_TMO])) break; if (sp > XB_SPIN_CAP) { xb_add(&bar[XB_TMO], 1u); break; } }
    }
    nloc = mine > 0u ? mine : 1u; nx = cnt > 0u ? cnt : 1u;
}
__device__ __forceinline__ void xcd_barrier(const XcdBarrier& b, const bool leader_thread) {
    asm volatile("s_waitcnt vmcnt(0)" ::: "memory");
    __syncthreads();
    if (leader_thread) {
        unsigned* bar = b.bar;
        __builtin_amdgcn_s_waitcnt(0);
        unsigned nloc = b.st[0], nx = b.st[1];
        if (nloc == 0u) { xcd_barrier_complete(bar, b.x, nloc, nx); b.st[0] = nloc; b.st[1] = nx; }
        const unsigned old = xb_add(&bar[XB_XSUB(b.x)], 1u);
        const unsigned gen = old / nloc;
        if (old + 1u == (gen + 1u) * nloc) {
            __builtin_amdgcn_fence(__ATOMIC_RELEASE, "agent");
            asm volatile("s_waitcnt vmcnt(0)" ::: "memory");
            const unsigned og = xb_add(&bar[XB_TOP], 1u);
            const unsigned tg = og / nx;
            if (og + 1u == (tg + 1u) * nx) xb_add(&bar[XB_TOPGEN], 1u);
            else XB_SPIN(xb_ld(&bar[XB_TOPGEN]) == tg, bar);
            __builtin_amdgcn_fence(__ATOMIC_ACQUIRE, "agent");
            xb_add(&bar[XB_XGEN(b.x)], 1u);
            asm volatile("s_waitcnt vmcnt(0)" ::: "memory");
        } else {
            XB_SPIN(xb_ld(&bar[XB_XGEN(b.x)]) == gen, bar);
            __builtin_amdgcn_fence(__ATOMIC_ACQUIRE, "agent");
            asm volatile("s_waitcnt vmcnt(0)" ::: "memory");
        }
    }
    __syncthreads();
}

namespace pg8 {
constexpr int BM = 256, BK = 64, HALF = 128, HTB = HALF * BK * 2, STAGE_BYTES = 8 * HTB, NXCD = 8, WGM = 8;
__host__ __device__ __forceinline__ int lds_byte(int r, int c) { const int st = (r >> 4) * 2 + (c >> 5), rr = r & 15, cc = c & 31, ob = rr * 64 + cc * 2; return st * 1024 + (ob ^ (((ob >> 9) & 1) << 5)); }
__host__ __device__ __forceinline__ void stage_rc(int b, int& R, int& C) { const int st = b / 1024, sb = b % 1024, swz = sb ^ (((sb >> 9) & 1) << 5); R = (st >> 1) * 16 + swz / 64; C = (st & 1) * 32 + (swz % 64) / 2; }
__host__ __device__ __forceinline__ int perm32(int rho) { const int n = rho >> 4, i = rho & 15; return 8 * (i >> 2) + 4 * n + (i & 3); }

struct Unit { const char* a; const char* b; char* c; int pm, pn, hm; };

struct TileOrder {
    static constexpr int BH_ROWS = 128; static constexpr bool KSPLIT = true, MERGED = false;
    int nM, nN, nwg, G, c; const char* A; const char* B; char* C; size_t astep, bstep, cstep; int ldc, cesz; int tail, ktp; size_t khalf; unsigned* flags;
    __device__ __forceinline__ void init(int M_, int N_, int G_, int c_, const void* A_, int lda, const void* B_, int ldb, void* C_, int ldc_, int cesz_) {
        nM = M_ / BM; nN = N_ / BM; nwg = nM * nN; G = G_; c = c_; A = (const char*)A_; B = (const char*)B_; C = (char*)C_;
        astep = (size_t)BM * lda * 2; bstep = (size_t)BM * ldb * 2; ldc = ldc_; cesz = cesz_; cstep = (size_t)BM * ldc_ * cesz_; tail = 0; ktp = 0; khalf = 0; flags = nullptr;
    }
    __device__ __forceinline__ void half_tail() { if (G == 256 && nwg == 640) tail = 1; }
    __device__ __forceinline__ void split_tail(int ktp_, unsigned* flags_) { if (G == 256 && nwg == 640) { tail = 2; ktp = ktp_; khalf = (size_t)ktp_ * (BK * 2); flags = flags_; } }
    __device__ __forceinline__ bool next(int i, Unit& u) const {
        int wgid; u.hm = 0;
        if (tail && i >= 2) { if (i > 2) return false;
            const int xcd = c % NXCD, k = c / NXCD, j = k >> 1; wgid = xcd * (nwg / NXCD) + 64 + j;
            u.hm = (tail == 1) ? 1 + (k & 1) : ((3 + (k & 1)) | ((xcd * 16 + j) << 4)); }
        else { const long L = (long)i * G + c; if (L >= nwg) return false;
            wgid = (int)L; { const int q = nwg / NXCD, r = nwg % NXCD, xcd = wgid % NXCD, off = wgid / NXCD; wgid = (xcd < r ? xcd * (q + 1) : r * (q + 1) + (xcd - r) * q) + off; } }
        const int nig = WGM * nN, gid = wgid / nig, fm = gid * WGM, gsz = (nM - fm) < WGM ? (nM - fm) : WGM;
        u.pm = fm + ((wgid % nig) % gsz); u.pn = (wgid % nig) / gsz;
        const size_t ko = ((u.hm & 15) == 4) ? khalf : 0;
        u.a = A + (size_t)u.pm * astep + ((u.hm & 15) == 2 ? astep / 2 : 0) + ko; u.b = B + (size_t)u.pn * bstep + ko; u.c = C + (size_t)u.pm * cstep + (size_t)u.pn * BM * cesz;
        return true;
    }
};

template <class Epi, class Sched, bool ALIGN_EPI = true>
__device__ __forceinline__ void gemm_phase(LAS unsigned char* lds, const int wave0, const int lda, const int ldb, const int K, const Sched& S, const Epi& E) {
    const int lane = fresh_lane(), wid = fresh_wave(wave0), tid = wid * 64 + lane, wr = wid >> 2, wc = wid & 3, fr = lane & 15, fq = lane >> 4;
    const int nt = K / BK;
    unsigned voffA[2], voffB[2];
#pragma unroll
    for (int i = 0; i < 2; ++i) { int R, C; stage_rc(tid * 16 + i * 8192, R, C); const int Rb = Epi::PERM ? ((R & ~31) + perm32(R & 31)) : R;
        const int Ra = Epi::APERM ? (8 * (16 * (R >> 6) + (R & 15)) + ((R >> 4) & 3)) : R;
        voffA[i] = (unsigned)(Ra * lda + C) * 2u; voffB[i] = (unsigned)(Rb * ldb + C) * 2u; }
    const size_t kstep = (size_t)(BK * 2);
    const size_t hstepA = (size_t)(Epi::APERM ? 4 : HALF) * lda * 2, hstepB = (size_t)Sched::BH_ROWS * ldb * 2;
    const unsigned ldsw = (unsigned)wid * 1024u;
    const int aoff = lds_byte(wr * 64 + fr, fq * 8), boff = lds_byte(wc * 32 + fr, fq * 8);
#define PG8_SA(b, h) (((b) * 2 + (h)) * HTB)
#define PG8_SB(b, h) ((4 + (b) * 2 + (h)) * HTB)
#ifndef PG8_AUX_A
#define PG8_AUX_A 0
#endif
#ifndef PG8_AUX_B
#define PG8_AUX_B 0
#endif
#define PG8_STAGE(bufoff, gbase, voff) do { const GAS char* gb_ = (const GAS char*)(gbase); asm("" : "+s"(gb_));   _Pragma("unroll") for (int _i = 0; _i < 2; ++_i) { asm("" : "+v"((voff)[_i]));   \
        __builtin_amdgcn_global_load_lds((const GAS unsigned*)(gb_ + (voff)[_i]), (LAS unsigned*)(lds + (bufoff) + ldsw + _i * 8192), 16, 0, PG8_AUX_A); } } while (0)
#define PG8_STAGEB(bufoff, gbase, voff) do { const GAS char* gb_ = (const GAS char*)(gbase); asm("" : "+s"(gb_));   _Pragma("unroll") for (int _i = 0; _i < 2; ++_i) { asm("" : "+v"((voff)[_i]));   \
        __builtin_amdgcn_global_load_lds((const GAS unsigned*)(gb_ + (voff)[_i]), (LAS unsigned*)(lds + (bufoff) + ldsw + _i * 8192), 16, 0, PG8_AUX_B); } } while (0)
#define PG8_LDA(dst, b, h) do { _Pragma("unroll") for (int m = 0; m < 4; ++m) _Pragma("unroll") for (int k = 0; k < 2; ++k) dst[m][k] = *(const LAS bf16x8*)(lds + PG8_SA(b, h) + aoff + m * 2048 + k * 1024); } while (0)
#define PG8_LDB(dst, b, h) do { _Pragma("unroll") for (int n = 0; n < 2; ++n) _Pragma("unroll") for (int k = 0; k < 2; ++k) dst[n][k] = *(const LAS bf16x8*)(lds + PG8_SB(b, h) + boff + n * 2048 + k * 1024); } while (0)
#define PG8_MMA(ai, bj, At, Bt) do { __builtin_amdgcn_s_setprio(1); _Pragma("unroll") for (int m = 0; m < 4; ++m) _Pragma("unroll") for (int n = 0; n < 2; ++n) _Pragma("unroll") for (int k = 0; k < 2; ++k) \
        acc[ai][bj][m][n] = __builtin_amdgcn_mfma_f32_16x16x32_bf16(Bt[n][k], At[m][k], acc[ai][bj][m][n], 0, 0, 0); __builtin_amdgcn_s_setprio(0); } while (0)
#define PG8_WAIT_V(n) asm volatile("s_waitcnt vmcnt(" #n ")" ::: "memory")
#define PG8_WAIT_L(n) asm volatile("s_waitcnt lgkmcnt(" #n ")" ::: "memory")
#define PG8_BAR __builtin_amdgcn_s_barrier()
#define PG8_SCHED __builtin_amdgcn_sched_barrier(0)
    Unit cur, nxt; int ui = 0;
    if (!S.next(0, cur)) return;
    f32x4 acc[2][2][4][2];
#pragma unroll
    for (int a = 0; a < 2; ++a)
#pragma unroll
        for (int b = 0; b < 2; ++b)
#pragma unroll
            for (int m = 0; m < 4; ++m)
#pragma unroll
                for (int n = 0; n < 2; ++n) acc[a][b][m][n] = (f32x4){0.f, 0.f, 0.f, 0.f};
    bf16x8 At[4][2], B0[2][2], B1[2][2];
    const char* cA = cur.a; const char* cB = cur.b;
    if constexpr (Sched::MERGED) { if constexpr (Sched::WAIT_FIRST) { if (S.needs_wait(cur)) { S.wait_panel(cur, wid); PG8_BAR; } } }
    PG8_STAGEB(PG8_SB(0, 0), cB, voffB); PG8_STAGEB(PG8_SB(0, 1), cB + hstepB, voffB); PG8_STAGE(PG8_SA(0, 0), cA, voffA); PG8_STAGE(PG8_SA(0, 1), cA + hstepA, voffA);
    if (wr == 1) PG8_BAR;
    PG8_WAIT_V(2); PG8_BAR;
    PG8_STAGEB(PG8_SB(1, 0), cB + kstep, voffB); PG8_STAGE(PG8_SA(1, 0), cA + kstep, voffA); PG8_STAGEB(PG8_SB(1, 1), cB + hstepB + kstep, voffB);
    PG8_WAIT_V(6); PG8_BAR;
    for (;;) {
        const bool has_next = S.next(ui + 1, nxt);
        const char* nA = has_next ? nxt.a : cA; const char* nB = has_next ? nxt.b : cB;
        const int hmode = cur.hm & 15;
        const bool full = (hmode == 0) || (hmode >= 3);
        int unt = nt; if constexpr (Sched::KSPLIT) { if (hmode == 3) unt = S.ktp; else if (hmode == 4) unt = nt - S.ktp; }
        float pf = 0.f;
        for (int t = 0; t < unt; t += 2) {
            const bool last = (t == unt - 2);
            const char* a1 = cA + (size_t)(t + 1) * kstep;
            const char* a2 = last ? nA : cA + (size_t)(t + 2) * kstep; const char* b2 = last ? nB : cB + (size_t)(t + 2) * kstep;
            const char* a3 = a2 + kstep; const char* b3 = b2 + kstep;
            if constexpr (Sched::MERGED) { if (last && has_next && S.needs_wait(nxt)) { S.wait_panel(nxt, wid); PG8_BAR; } }
            if constexpr (Epi::MIDK > 0) { if (t == Epi::MIDK) E.mid(acc, cur, wid); }
            if constexpr (Epi::PREF) { if (last) pf = E.prefetch(cur, tid); }
            PG8_LDB(B0, 0, 0); PG8_LDB(B1, 0, 1); PG8_SCHED; PG8_LDA(At, 0, 0); PG8_STAGE(PG8_SA(1, 1), a1 + hstepA, voffA);
            PG8_WAIT_V(8); PG8_WAIT_L(0); PG8_BAR; PG8_MMA(0, 0, At, B0); PG8_MMA(0, 1, At, B1); PG8_BAR; PG8_SCHED;
            if (full) PG8_LDA(At, 0, 1); PG8_STAGEB(PG8_SB(0, 0), b2, voffB); PG8_STAGEB(PG8_SB(0, 1), b2 + hstepB, voffB); PG8_STAGE(PG8_SA(0, 0), a2, voffA);
            PG8_WAIT_V(8); PG8_WAIT_L(0); PG8_BAR; if (full) { PG8_MMA(1, 0, At, B0); PG8_MMA(1, 1, At, B1); } PG8_BAR; PG8_SCHED;
            PG8_LDB(B0, 1, 0); PG8_LDB(B1, 1, 1); PG8_SCHED; PG8_LDA(At, 1, 0); PG8_STAGE(PG8_SA(0, 1), a2 + hstepA, voffA);
            PG8_WAIT_V(8); PG8_WAIT_L(0); PG8_BAR; PG8_MMA(0, 0, At, B0); PG8_MMA(0, 1, At, B1); PG8_BAR; PG8_SCHED;
            if (full) PG8_LDA(At, 1, 1); PG8_STAGEB(PG8_SB(1, 0), b3, voffB); PG8_STAGEB(PG8_SB(1, 1), b3 + hstepB, voffB); PG8_STAGE(PG8_SA(1, 0), a3, voffA);
            PG8_WAIT_V(8); PG8_WAIT_L(0); PG8_BAR; if (full) { PG8_MMA(1, 0, At, B0); PG8_MMA(1, 1, At, B1); } PG8_BAR; PG8_SCHED;
        }
        if constexpr (ALIGN_EPI) { if (wr == 0) PG8_BAR; }
        if constexpr (Epi::PREF) { static_assert(ALIGN_EPI, "the side-buffer exchange needs both halves in the epilogue together");
            *(LAS float*)(lds + STAGE_BYTES + tid * 4) = pf; PG8_WAIT_L(0); PG8_BAR; }
        if constexpr (Sched::KSPLIT) {
            if (hmode == 3) {
                E.produce(acc, cur, wid);
                PG8_WAIT_V(0); PG8_BAR;
                if (wid == 0 && fresh_lane() == 0) __hip_atomic_store((GAS unsigned*)(S.flags + (size_t)(cur.hm >> 4) * 16), 1u, __ATOMIC_RELAXED, __HIP_MEMORY_SCOPE_AGENT);
            } else {
                if (hmode == 4) {
                    if (wid == 0) { GAS unsigned* fp = (GAS unsigned*)(S.flags + (size_t)(cur.hm >> 4) * 16); unsigned sp = 0;
                        while ((unsigned)__builtin_amdgcn_readfirstlane(__hip_atomic_load(fp, __ATOMIC_RELAXED, __HIP_MEMORY_SCOPE_AGENT)) != 1u) { __builtin_amdgcn_s_sleep(2); if (++sp > (1u << 20)) break; }
                        __builtin_amdgcn_fence(__ATOMIC_ACQUIRE, "agent"); PG8_WAIT_V(0); }
                    PG8_BAR;
                }
                E(acc, cur, wid);
            }
        } else { E(acc, cur, wid);
            if constexpr (Sched::MERGED) { if (S.publishes(cur)) { PG8_WAIT_V(0); if (fresh_lane() == 0) S.publish(cur); } } }
        if (!has_next) break;
#pragma unroll
        for (int a = 0; a < 2; ++a)
#pragma unroll
            for (int b = 0; b < 2; ++b)
#pragma unroll
                for (int m = 0; m < 4; ++m)
#pragma unroll
                    for (int n = 0; n < 2; ++n) acc[a][b][m][n] = (f32x4){0.f, 0.f, 0.f, 0.f};
        cur = nxt; cA = nA; cB = nB; ++ui;
        if constexpr (ALIGN_EPI) { if (wr == 1) PG8_BAR; }
    }
    PG8_WAIT_V(0);
    if constexpr (!ALIGN_EPI) { if (wr == 0) PG8_BAR; }
    PG8_BAR;
#undef PG8_SA
#undef PG8_SB
#undef PG8_STAGE
#undef PG8_STAGEB
#undef PG8_LDA
#undef PG8_LDB
#undef PG8_MMA
#undef PG8_WAIT_V
#undef PG8_WAIT_L
#undef PG8_BAR
#undef PG8_SCHED
}

typedef f32x4 Acc[2][2][4][2];
constexpr int STG_OFF = STAGE_BYTES + 8192, STG_WAVE = 2560, STG_PITCH = 144;
struct Stage64 {
    LAS char* stg; unsigned sw, sr;
    __device__ __forceinline__ Stage64(const LAS float* side, const int wid, const int lane) { stg = (LAS char*)side + (STG_OFF - STAGE_BYTES) + wid * STG_WAVE; sw = (unsigned)((lane & 15) * 80 + (lane >> 4) * 16); sr = (unsigned)((lane >> 2) * 80 + (lane & 3) * 16); }
    __device__ __forceinline__ void put(const int slot, const u32x4 w) const { *(LAS u32x4*)(stg + slot * 1280 + sw) = w; }
    __device__ __forceinline__ u32x4 get(const int slot) const { return *(const LAS u32x4*)(stg + slot * 1280 + sr); }
};
template <int CTRL> __device__ __forceinline__ float dpp_mov(float v) { return __int_as_float(__builtin_amdgcn_update_dpp(0, __float_as_int(v), CTRL, 0xf, 0xf, true)); }

template <int LDC> struct EpiBf16U {
    static constexpr bool PERM = true, APERM = false; static constexpr int MIDK = 0; static constexpr bool PREF = false;
    const LAS float* side;
    __device__ __forceinline__ void operator()(const Acc& acc, const Unit& u, const int wid) const {
        const int lane = fresh_lane(), wr = wid >> 2, wc = wid & 3;
        const Stage64 T(side, wid, lane);
        const unsigned loff = (unsigned)((wr * 64 + (lane >> 2)) * LDC + wc * 32 + 8 * (lane & 3)) * 2u;
#pragma unroll
        for (int ai = 0; ai < 2; ++ai)
#pragma unroll
            for (int m = 0; m < 4; ++m) { char* rowp = u.c + (size_t)(ai * HALF + m * 16) * LDC * 2; asm("" : "+s"(rowp));
#pragma unroll
                for (int bj = 0; bj < 2; ++bj) { const f32x4 v0 = acc[ai][bj][m][0], v1 = acc[ai][bj][m][1];
                    u32x4 w; w.x = cvt_pk_bf16(v0[0], v0[1]); w.y = cvt_pk_bf16(v0[2], v0[3]); w.z = cvt_pk_bf16(v1[0], v1[1]); w.w = cvt_pk_bf16(v1[2], v1[3]);
                    T.put(bj, w); }
                asm volatile("" ::: "memory");
                const u32x4 r0 = T.get(0), r1 = T.get(1);
                asm volatile("" ::: "memory");
                *(GAS u32x4*)(rowp + loff) = r0; *(GAS u32x4*)(rowp + loff + HALF * 2) = r1; }
    }
};
struct EpiIn {
    static constexpr bool PERM = true, APERM = false; static constexpr int MIDK = 0; static constexpr bool PREF = true;
    float* outk; float* outv; int layer; const float* ss; const float* bias; const LAS float* side;
    __device__ __forceinline__ void produce(const Acc&, const Unit&, const int) const {}
    __device__ __forceinline__ float prefetch(const Unit& u, const int tid) const {
        const int bv = u.pm < NB_P ? 0 : 1 + ((u.pm - NB_P) >> 4);
        const float* p = tid < 256 ? ss + (size_t)u.pm * BM + tid : bias + (size_t)bv * IN_DIM + u.pn * BM + (tid - 256);
        return *(const GAS float*)p;
    }
    __device__ __forceinline__ void operator()(const Acc& acc, const Unit& u, const int wid) const {
        const int lane = fresh_lane(), wr = wid >> 2, wc = wid & 3, fr = lane & 15, fq = lane >> 4;
        const bool sig = u.pn >= 16, kv = (u.pm < NB_P) && (u.pn >= 4) && (u.pn < 12);
        const int r0 = wr * 64 + fr, c0 = wc * 32 + 8 * fq;
        const unsigned loff = (unsigned)((wr * 64 + (lane >> 2)) * IN_DIM + wc * 32 + 8 * (lane & 3)) * 2u, koff = (unsigned)((wr * 64 + (lane >> 3)) * HD + wc * 32 + 4 * (lane & 7)) * 4u;
        const Stage64 T(side, wid, lane);
        const unsigned ksw = (unsigned)(fr * STG_PITCH + fq * 32), ksr = (unsigned)((lane >> 3) * STG_PITCH + (lane & 7) * 16);
        float rstd[2][4]; f32x4 bb[2][2];
        {
#pragma unroll
          for (int ai = 0; ai < 2; ++ai)
#pragma unroll
              for (int m = 0; m < 4; ++m) rstd[ai][m] = side[r0 + ai * HALF + m * 16];
#pragma unroll
          for (int bj = 0; bj < 2; ++bj)
#pragma unroll
              for (int n = 0; n < 2; ++n) bb[bj][n] = *(const LAS f32x4*)(side + 256 + c0 + bj * HALF + 4 * n);
#pragma unroll
          for (int ai = 0; ai < 2; ++ai)
#pragma unroll
              for (int m = 0; m < 4; ++m) rstd[ai][m] = rsqrtf(rstd[ai][m] * (1.0f / D) + RMS_EPS); }
#pragma unroll
        for (int ai = 0; ai < 2; ++ai)
#pragma unroll
            for (int m = 0; m < 4; ++m) { char* rowp = u.c + (size_t)(ai * HALF + m * 16) * IN_DIM * 2; asm("" : "+s"(rowp));
                f32x4 vv[2][2];
#pragma unroll
                for (int bj = 0; bj < 2; ++bj) { f32x4 v0 = acc[ai][bj][m][0] * rstd[ai][m] + bb[bj][0], v1 = acc[ai][bj][m][1] * rstd[ai][m] + bb[bj][1];
                    if (sig) {
#pragma unroll
                        for (int j = 0; j < 4; ++j) { v0[j] = sigmoidf_fast(v0[j]); v1[j] = sigmoidf_fast(v1[j]); } }
                    u32x4 w; w.x = cvt_pk_bf16(v0[0], v0[1]); w.y = cvt_pk_bf16(v0[2], v0[3]); w.z = cvt_pk_bf16(v1[0], v1[1]); w.w = cvt_pk_bf16(v1[2], v1[3]);
                    T.put(bj, w); vv[bj][0] = v0; vv[bj][1] = v1; }
                asm volatile("" ::: "memory");
                const u32x4 q0 = T.get(0), q1 = T.get(1);
                asm volatile("" ::: "memory");
                if (kv) {
#pragma unroll
                    for (int bj = 0; bj < 2; ++bj) { const int colt = u.pn * BM + bj * HALF; const bool isv = colt >= 2048; const int head = (colt - (isv ? 2048 : 1024)) >> 7;
                        char* dst = (char*)((isv ? outv : outk) + ((((size_t)u.pm * DEPTH + layer) * NH + head) * SEQ_P + (ai * HALF + m * 16)) * HD); asm("" : "+s"(dst));
                        *(LAS f32x4*)(T.stg + ksw) = vv[bj][0]; *(LAS f32x4*)(T.stg + ksw + 16) = vv[bj][1];
                        asm volatile("" ::: "memory");
                        const f32x4 a0 = *(const LAS f32x4*)(T.stg + ksr), a1 = *(const LAS f32x4*)(T.stg + ksr + 8 * STG_PITCH);
                        asm volatile("" ::: "memory");
                        *(GAS f32x4*)(dst + koff) = a0; *(GAS f32x4*)(dst + koff + 8 * HD * 4) = a1; } }
                *(GAS u32x4*)(rowp + loff) = q0; *(GAS u32x4*)(rowp + loff + HALF * 2) = q1; }
    }
};
struct EpiPab {
    static constexpr bool PERM = true, APERM = false; static constexpr int MIDK = 16; static constexpr bool PREF = false;
    const bf16_t* G; bf16_t* Y; const LAS float* side;
    __device__ __forceinline__ void produce(const Acc&, const Unit&, const int) const {}
    __device__ __forceinline__ void mid(Acc& acc, const Unit& u, const int wid) const {
        const int lane = fresh_lane(), wr = wid >> 2, wc = wid & 3, fr = lane & 15, fq = lane >> 4;
        const unsigned goff = (unsigned)((wr * 64 + fr) * IN_DIM + wc * 32 + 8 * fq) * 2u;
        const int hb = (u.hm & 15) == 2 ? HALF : 0, na = ((u.hm & 15) == 1 || (u.hm & 15) == 2) ? 1 : 2;
#pragma unroll
        for (int ai = 0; ai < 2; ++ai) if (ai < na) {
#pragma unroll
            for (int mp = 0; mp < 2; ++mp) {
                u32x4 ga[2][2], gb[2][2];
#pragma unroll
                for (int mm = 0; mm < 2; ++mm) { const int m = 2 * mp + mm; const char* gp = (const char*)(G + (size_t)(u.pm * BM + hb + ai * HALF + m * 16) * IN_DIM + 4096 + u.pn * BM); asm("" : "+s"(gp));
#pragma unroll
                    for (int bj = 0; bj < 2; ++bj) { ga[mm][bj] = *(const GAS u32x4*)(gp + goff + bj * HALF * 2); gb[mm][bj] = *(const GAS u32x4*)(gp + goff + bj * HALF * 2 + 2048 * 2); } }
                asm volatile("" ::: "memory");
#pragma unroll
                for (int mm = 0; mm < 2; ++mm)
#pragma unroll
                    for (int bj = 0; bj < 2; ++bj)
#pragma unroll
                        for (int j = 0; j < 4; ++j) { const int m = 2 * mp + mm;
                            const float r0 = bf_lo(ga[mm][bj][j]) * __builtin_amdgcn_rcpf(fmaxf(bf_lo(gb[mm][bj][j]), 1e-30f)), r1 = bf_hi(ga[mm][bj][j]) * __builtin_amdgcn_rcpf(fmaxf(bf_hi(gb[mm][bj][j]), 1e-30f));
                            acc[ai][bj][m][j >> 1][2 * (j & 1)] *= r0; acc[ai][bj][m][j >> 1][2 * (j & 1) + 1] *= r1; }
            }
        }
    }
    __device__ __forceinline__ void operator()(const Acc& acc, const Unit& u, const int wid) const {
        const int lane = fresh_lane(), wr = wid >> 2, wc = wid & 3, fr = lane & 15, fq = lane >> 4;
        const unsigned goff = (unsigned)((wr * 64 + fr) * IN_DIM + wc * 32 + 8 * fq) * 2u, yoff = (unsigned)((wr * 64 + (lane >> 2)) * D + wc * 32 + 8 * (lane & 3)) * 2u;
        const Stage64 T(side, wid, lane);
        const int hb = (u.hm & 15) == 2 ? HALF : 0, na = ((u.hm & 15) == 1 || (u.hm & 15) == 2) ? 1 : 2;
        u32x4 gb[2][4][2];
#pragma unroll
        for (int ai = 0; ai < 2; ++ai) if (ai < na)
#pragma unroll
            for (int m = 0; m < 4; ++m) { const char* gp = (const char*)(G + (size_t)(u.pm * BM + hb + ai * HALF + m * 16) * IN_DIM + 6144 + u.pn * BM); asm("" : "+s"(gp));
#pragma unroll
                for (int bj = 0; bj < 2; ++bj) gb[ai][m][bj] = *(const GAS u32x4*)(gp + goff + bj * HALF * 2); }
        asm volatile("" ::: "memory");
#pragma unroll
        for (int ai = 0; ai < 2; ++ai) if (ai < na)
#pragma unroll
            for (int m = 0; m < 4; ++m) { char* yp = (char*)(Y + (size_t)(u.pm * BM + hb + ai * HALF + m * 16) * D + u.pn * BM); asm("" : "+s"(yp));
#pragma unroll
                for (int bj = 0; bj < 2; ++bj) { const u32x4 g = gb[ai][m][bj]; const f32x4 v0 = acc[ai][bj][m][0], v1 = acc[ai][bj][m][1];
                    u32x4 w;
                    w.x = cvt_pk_bf16(v0[0] * fmaxf(bf_lo(g[0]), 1e-30f), v0[1] * fmaxf(bf_hi(g[0]), 1e-30f)); w.y = cvt_pk_bf16(v0[2] * fmaxf(bf_lo(g[1]), 1e-30f), v0[3] * fmaxf(bf_hi(g[1]), 1e-30f));
                    w.z = cvt_pk_bf16(v1[0] * fmaxf(bf_lo(g[2]), 1e-30f), v1[1] * fmaxf(bf_hi(g[2]), 1e-30f)); w.w = cvt_pk_bf16(v1[2] * fmaxf(bf_lo(g[3]), 1e-30f), v1[3] * fmaxf(bf_hi(g[3]), 1e-30f));
                    T.put(bj, w); }
                asm volatile("" ::: "memory");
                const u32x4 r0 = T.get(0), r1 = T.get(1);
                asm volatile("" ::: "memory");
                *(GAS u32x4*)(yp + yoff) = r0; *(GAS u32x4*)(yp + yoff + HALF * 2) = r1; }
    }
};
struct EpiRes {
    static constexpr bool PERM = true, APERM = false; static constexpr int MIDK = 0; static constexpr bool PREF = true;
    const float* xp; const float* xs; float* X; const float* mods_l; int gi; bool first; float* XO;
    bool emit; const float* gvec; const float* scl; float* ss; bf16_t* HBo;
    const LAS float* side;
    __device__ __forceinline__ float prefetch(const Unit& u, const int tid) const {
        const int bv = u.pm < NB_P ? 0 : 1 + ((u.pm - NB_P) >> 4);
        unsigned to = (unsigned)tid * 4u; asm volatile("; opaque lane offset" : "+v"(to));
        if (tid >= 256) return *(const GAS float*)((const GAS char*)(mods_l + ((size_t)bv * NMOD + gi) * D + u.pn * BM - 256) + to);
        if (!emit) return 0.f;
        return *(const GAS float*)((const GAS char*)(gvec + u.pn * BM) + to) * (*(const GAS float*)((const GAS char*)(scl + (size_t)bv * NMOD * D + u.pn * BM) + to) + 1.0f);
    }
    __device__ __forceinline__ void produce(const Acc& acc, const Unit& u, const int wid) const {
        const int lane = fresh_lane(), wr = wid >> 2, wc = wid & 3, fr = lane & 15, fq = lane >> 4, rr = lane >> 3, ck = lane & 7;
        const unsigned xoff = (unsigned)((wr * 64 + rr) * D + wc * 32 + ck * 4) * 4u;
        LAS char* stg = (LAS char*)side + (STG_OFF - STAGE_BYTES) + wid * STG_WAVE;
        const unsigned sw = (unsigned)(fr * STG_PITCH + fq * 32), sr = (unsigned)(rr * STG_PITCH + ck * 16);
        const int cl = wc * 32 + ck * 4;
        const float* base = first ? (u.pm < NB_P ? xp : xs - (size_t)MP * D) : X;
        char* xt = (char*)(X + (size_t)u.pm * BM * D + u.pn * BM); asm("" : "+s"(xt));
        const __amdgpu_buffer_rsrc_t rs = __builtin_amdgcn_make_buffer_rsrc(xt, 0, 256 * D * 4, 0x00020000);
#pragma unroll
        for (int ai = 0; ai < 2; ++ai) {
            f32x4 b[4][2][2];
#pragma unroll
            for (int m = 0; m < 4; ++m) { const char* bp = (const char*)(base + (size_t)(u.pm * BM + ai * HALF + m * 16) * D + u.pn * BM); asm("" : "+s"(bp));
#pragma unroll
                for (int bj = 0; bj < 2; ++bj)
#pragma unroll
                    for (int p = 0; p < 2; ++p) b[m][bj][p] = *(const GAS f32x4*)(bp + xoff + (p * 8 * D + bj * HALF) * 4); }
            asm volatile("" ::: "memory");
#pragma unroll
            for (int m = 0; m < 4; ++m)
#pragma unroll
                for (int bj = 0; bj < 2; ++bj) {
                    *(LAS f32x4*)(stg + sw) = acc[ai][bj][m][0]; *(LAS f32x4*)(stg + sw + 16) = acc[ai][bj][m][1];
                    asm volatile("" ::: "memory");
                    const f32x4 a0 = *(const LAS f32x4*)(stg + sr), a1 = *(const LAS f32x4*)(stg + sr + 8 * STG_PITCH);
                    const f32x4 gvx = *(const LAS f32x4*)(side + 256 + cl + bj * HALF);
                    asm volatile("" ::: "memory");
                    __builtin_amdgcn_raw_buffer_store_b128(__builtin_bit_cast(u32x4, b[m][bj][0] + gvx * a0), rs, xoff, ((ai * HALF + m * 16) * D + bj * HALF) * 4, 16);
                    __builtin_amdgcn_raw_buffer_store_b128(__builtin_bit_cast(u32x4, b[m][bj][1] + gvx * a1), rs, xoff, ((ai * HALF + m * 16 + 8) * D + bj * HALF) * 4, 16); }
            asm volatile("" ::: "memory");
        }
    }
    __device__ __forceinline__ void operator()(const Acc& acc, const Unit& u, const int wid) const {
        const int lane = fresh_lane(), wr = wid >> 2, wc = wid & 3, fr = lane & 15, fq = lane >> 4, rr = lane >> 3, ck = lane & 7;
        const unsigned xoff = (unsigned)((wr * 64 + rr) * D + wc * 32 + ck * 4) * 4u, hoff = xoff >> 1;
        LAS char* stg = (LAS char*)side + (STG_OFF - STAGE_BYTES) + wid * STG_WAVE;
        const unsigned sw = (unsigned)(fr * STG_PITCH + fq * 32), sr = (unsigned)(rr * STG_PITCH + ck * 16);
        const int cl = wc * 32 + ck * 4;
        const int hmode = u.hm & 15;
        const float* base = (first && hmode != 4) ? (u.pm < NB_P ? xp : xs - (size_t)MP * D) : X;
        float* XOu = XO; const bool em = emit;
        const int hb = hmode == 2 ? HALF : 0, na = (hmode == 1 || hmode == 2) ? 1 : 2;
#pragma unroll
        for (int ai = 0; ai < 2; ++ai) if (ai < na) {
            f32x4 b[4][2][2];
#pragma unroll
            for (int m = 0; m < 4; ++m) { const char* bp = (const char*)(base + (size_t)(u.pm * BM + hb + ai * HALF + m * 16) * D + u.pn * BM); asm("" : "+s"(bp));
#pragma unroll
                for (int bj = 0; bj < 2; ++bj)
#pragma unroll
                    for (int p = 0; p < 2; ++p) b[m][bj][p] = *(const GAS f32x4*)(bp + xoff + (p * 8 * D + bj * HALF) * 4); }
            asm volatile("" ::: "memory");
#pragma unroll
            for (int m = 0; m < 4; ++m) {
                char* xq = (char*)(XOu + (size_t)(u.pm * BM + hb + ai * HALF + m * 16) * D + u.pn * BM); asm("" : "+s"(xq));
                char* hq = (char*)(HBo + (size_t)(u.pm * BM + hb + ai * HALF + m * 16) * D + u.pn * BM); asm("" : "+s"(hq));
                float q0 = 0.f, q1 = 0.f;
#pragma unroll
                for (int bj = 0; bj < 2; ++bj) {
                    *(LAS f32x4*)(stg + sw) = acc[ai][bj][m][0]; *(LAS f32x4*)(stg + sw + 16) = acc[ai][bj][m][1];
                    asm volatile("" ::: "memory");
                    const f32x4 a0 = *(const LAS f32x4*)(stg + sr), a1 = *(const LAS f32x4*)(stg + sr + 8 * STG_PITCH);
                    const f32x4 gvx = *(const LAS f32x4*)(side + 256 + cl + bj * HALF);
                    asm volatile("" ::: "memory");
                    const f32x4 x0 = b[m][bj][0] + gvx * a0, x1 = b[m][bj][1] + gvx * a1;
                    *(GAS f32x4*)(xq + xoff + (bj * HALF) * 4) = x0; *(GAS f32x4*)(xq + xoff + (8 * D + bj * HALF) * 4) = x1;
                    if (em) { const f32x4 gs = *(const LAS f32x4*)(side + cl + bj * HALF); const f32x4 h0 = x0 * gs, h1 = x1 * gs;
                        q0 += (x0[0] * x0[0] + x0[1] * x0[1]) + (x0[2] * x0[2] + x0[3] * x0[3]); q1 += (x1[0] * x1[0] + x1[1] * x1[1]) + (x1[2] * x1[2] + x1[3] * x1[3]);
                        u32x2 w0, w1; w0.x = cvt_pk_bf16(h0[0], h0[1]); w0.y = cvt_pk_bf16(h0[2], h0[3]); w1.x = cvt_pk_bf16(h1[0], h1[1]); w1.y = cvt_pk_bf16(h1[2], h1[3]);
                        *(GAS u32x2*)(hq + hoff + (bj * HALF) * 2) = w0; *(GAS u32x2*)(hq + hoff + (8 * D + bj * HALF) * 2) = w1; }
                }
                if (em) {
                    q0 += dpp_mov<0xB1>(q0); q1 += dpp_mov<0xB1>(q1); q0 += dpp_mov<0x4E>(q0); q1 += dpp_mov<0x4E>(q1); q0 += dpp_mov<0x141>(q0); q1 += dpp_mov<0x141>(q1);
                    if (ck == 0) { GAS float* sp = (GAS float*)(ss + (size_t)(u.pm * BM + hb + ai * HALF + m * 16) + wr * 64 + rr);
                        __hip_atomic_fetch_add(sp, q0, __ATOMIC_RELAXED, __HIP_MEMORY_SCOPE_AGENT); __hip_atomic_fetch_add(sp + 8, q1, __ATOMIC_RELAXED, __HIP_MEMORY_SCOPE_AGENT); }
                }
            }
            asm volatile("" ::: "memory");
        }
    }
};
struct UpOrder {
    static constexpr int BH_ROWS = FFN; static constexpr bool KSPLIT = false, MERGED = false;
    int nM, nN, nwg, G, c; const char* A; const char* B; char* C;
    __device__ __forceinline__ void init(int G_, int c_, const void* A_, const void* B_, void* C_) { nM = M / BM; nN = FFN / 128; nwg = nM * nN; G = G_; c = c_; A = (const char*)A_; B = (const char*)B_; C = (char*)C_; }
    __device__ __forceinline__ bool next(int i, Unit& u) const {
        const long L = (long)i * G + c; if (L >= nwg) return false;
        int wgid = (int)L; { const int q = nwg / NXCD, r = nwg % NXCD, xcd = wgid % NXCD, off = wgid / NXCD; wgid = (xcd < r ? xcd * (q + 1) : r * (q + 1) + (xcd - r) * q) + off; }
        const int nig = WGM * nN, gid = wgid / nig, fm = gid * WGM, gsz = (nM - fm) < WGM ? (nM - fm) : WGM;
        u.pm = fm + ((wgid % nig) % gsz); u.pn = (wgid % nig) / gsz;
        u.a = A + (size_t)u.pm * BM * D * 2; u.b = B + (size_t)u.pn * 128 * D * 2; u.c = C + ((size_t)u.pm * BM * FFN + (size_t)u.pn * 128) * 2; u.hm = 0;
        return true;
    }
};
__device__ __forceinline__ float dpp_shr1(float v) { return __int_as_float(__builtin_amdgcn_update_dpp(0, __float_as_int(v), 0x111, 0xf, 0xf, true)); }
__device__ __forceinline__ float dpp_shl1(float v) { return __int_as_float(__builtin_amdgcn_update_dpp(0, __float_as_int(v), 0x101, 0xf, 0xf, true)); }
struct EpiUpConv {
    static constexpr bool PERM = true, APERM = true; static constexpr int MIDK = 0; static constexpr bool PREF = true;
    const float* cw; const float* cb; float* UH; const float* ss; const float* bias; const LAS float* side;
    __device__ __forceinline__ float prefetch(const Unit& u, const int tid) const {
        const int bv = u.pm < NB_P ? 0 : 1 + ((u.pm - NB_P) >> 4);
        const float* p = tid < 256 ? ss + (size_t)u.pm * BM + tid : bias + (size_t)bv * FFN2 + u.pn * 128 + (tid < 384 ? tid - 256 : FFN + tid - 384);
        return *(const GAS float*)p;
    }
    __device__ __forceinline__ void operator()(const Acc& acc, const Unit& u, const int wid) const {
        const int lane = fresh_lane(), wr = wid >> 2, wc = wid & 3, fr = lane & 15, fq = lane >> 4;
        const int q = 16 * wr + fr, ch0 = 32 * wc + 8 * fq;
        const char* wbase = (const char*)(cw + u.pn * 128); const char* bbase = (const char*)(cb + u.pn * 128); asm("" : "+s"(wbase), "+s"(bbase));
        const unsigned coff = (unsigned)ch0 * 4u;
        float rstd[8];
        { const f32x4 s0 = *(const LAS f32x4*)(side + 8 * q), s1 = *(const LAS f32x4*)(side + 8 * q + 4);
#pragma unroll
          for (int k = 0; k < 4; ++k) { rstd[k] = rsqrtf(s0[k] * (1.0f / D) + RMS_EPS); rstd[4 + k] = rsqrtf(s1[k] * (1.0f / D) + RMS_EPS); } }
        unsigned outp[8][4];
#pragma unroll
        for (int n = 0; n < 2; ++n) {
            const f32x4 wa0 = *(const GAS f32x4*)(wbase + coff + n * 16), wa1 = *(const GAS f32x4*)(wbase + coff + n * 16 + FFN2 * 4), wa2 = *(const GAS f32x4*)(wbase + coff + n * 16 + 2 * FFN2 * 4);
            const f32x4 wg0 = *(const GAS f32x4*)(wbase + coff + n * 16 + FFN * 4), wg1 = *(const GAS f32x4*)(wbase + coff + n * 16 + (FFN2 + FFN) * 4), wg2 = *(const GAS f32x4*)(wbase + coff + n * 16 + (2 * FFN2 + FFN) * 4);
            const f32x4 ba = *(const GAS f32x4*)(bbase + coff + n * 16), bg = *(const GAS f32x4*)(bbase + coff + n * 16 + FFN * 4);
            const f32x4 ua_b = *(const LAS f32x4*)(side + 256 + ch0 + 4 * n), ug_b = *(const LAS f32x4*)(side + 384 + ch0 + 4 * n);
            float keep[8];
#pragma unroll
            for (int e = 0; e < 4; ++e) {
                float ua[8], ug[8];
#pragma unroll
                for (int k = 0; k < 8; ++k) { ua[k] = acc[k >> 2][0][k & 3][n][e] * rstd[k] + ua_b[e]; ug[k] = acc[k >> 2][1][k & 3][n][e] * rstd[k] + ug_b[e]; }
                const float pa = dpp_shr1(ua[7]), na = dpp_shl1(ua[0]), pg = dpp_shr1(ug[7]), ng = dpp_shl1(ug[0]);
#pragma unroll
                for (int k = 0; k < 8; ++k) {
                    const float A = wa0[e] * (k ? ua[k - 1] : pa) + wa1[e] * ua[k] + wa2[e] * (k < 7 ? ua[k + 1] : na) + ba[e];
                    const float Gv = wg0[e] * (k ? ug[k - 1] : pg) + wg1[e] * ug[k] + wg2[e] * (k < 7 ? ug[k + 1] : ng) + bg[e];
                    const float o = Gv * sigmoidf_fast(Gv) * A;
                    if (e & 1) outp[k][2 * n + (e >> 1)] = cvt_pk_bf16(keep[k], o); else keep[k] = o;
                }
            }
        }
        char* cbase = u.c; asm("" : "+s"(cbase));
        const Stage64 T(side, wid, lane);
        const int f4 = lane >> 2;
        const unsigned roff = (unsigned)(8 * (16 * wr + f4)) * (unsigned)(FFN * 2) + (unsigned)(32 * wc + 8 * (lane & 3)) * 2u;
#pragma unroll
        for (int k = 0; k < 8; k += 2) {
#pragma unroll
            for (int kk = 0; kk < 2; ++kk) { u32x4 w; w.x = outp[k + kk][0]; w.y = outp[k + kk][1]; w.z = outp[k + kk][2]; w.w = outp[k + kk][3]; T.put(kk, w); }
            asm volatile("" ::: "memory");
            const u32x4 r0 = T.get(0), r1 = T.get(1);
            asm volatile("" ::: "memory");
            if (!(k == 0 && f4 == 0)) *(GAS u32x4*)(cbase + roff + k * (FFN * 2)) = r0;
            if (!(k == 6 && f4 == 15)) *(GAS u32x4*)(cbase + roff + (k + 1) * (FFN * 2)) = r1;
        }
        if (fr == 0 || fr == 15) {
            char* ub = (char*)(UH + ((size_t)u.pm * 8 + 4 * wr) * FFN2 + u.pn * 128); asm("" : "+s"(ub));
            const unsigned uoff = (unsigned)(fr == 15 ? 2 * FFN2 * 4 : 0) + coff;
#pragma unroll
            for (int kk = 0; kk < 2; ++kk)
#pragma unroll
                for (int n = 0; n < 2; ++n) {
                    const float rs = fr == 0 ? rstd[kk] : rstd[6 + kk];
                    const f32x4 ua_b = *(const LAS f32x4*)(side + 256 + ch0 + 4 * n), ug_b = *(const LAS f32x4*)(side + 384 + ch0 + 4 * n);
                    const f32x4 va = (fr == 0 ? acc[0][0][kk][n] : acc[1][0][2 + kk][n]) * rs + ua_b, vg = (fr == 0 ? acc[0][1][kk][n] : acc[1][1][2 + kk][n]) * rs + ug_b;
                    *(GAS f32x4*)(ub + uoff + kk * (FFN2 * 4) + n * 16) = va; *(GAS f32x4*)(ub + uoff + kk * (FFN2 * 4) + FFN * 4 + n * 16) = vg; }
        }
    }
};

struct PabOutOrder {
    static constexpr int BH_ROWS = 128; static constexpr bool KSPLIT = false, MERGED = true;
    int c; const char* AF; const char* Wpab; const char* YB; const char* Wout; unsigned* cnt;
    __device__ __forceinline__ bool next(int i, Unit& u) const {
        if (i >= 5) return false;
        const int xcd = c & 7, s = 32 * i + (c >> 3), kind = s >= 80, j = kind ? s - 80 : s;
        u.pm = 10 * xcd + (j >> 3); u.pn = j & 7; u.hm = kind ? 0x1000 : 0; u.c = nullptr;
        u.a = (kind ? YB : AF) + (size_t)u.pm * BM * D * 2; u.b = (kind ? Wout : Wpab) + (size_t)u.pn * BM * D * 2;
        return true;
    }
    static constexpr bool WAIT_FIRST = false;
    __device__ __forceinline__ bool needs_wait(const Unit& u) const { return (u.hm & 0x1000) != 0; }
    __device__ __forceinline__ bool publishes(const Unit& u) const { return (u.hm & 0x1000) == 0; }
    __device__ __forceinline__ void publish(const Unit& u) const { __hip_atomic_fetch_add((GAS unsigned*)(cnt + u.pm * 16), 1u, __ATOMIC_RELAXED, __HIP_MEMORY_SCOPE_AGENT); }
    __device__ __forceinline__ void wait_panel(const Unit& u, const int wid) const {
        if (wid == 0) { GAS unsigned* fp = (GAS unsigned*)(cnt + u.pm * 16); unsigned sp = 0;
            while ((unsigned)__builtin_amdgcn_readfirstlane(__hip_atomic_load(fp, __ATOMIC_RELAXED, __HIP_MEMORY_SCOPE_AGENT)) < 64u) { __builtin_amdgcn_s_sleep(2); if (++sp > (1u << 20)) break; }
            __builtin_amdgcn_fence(__ATOMIC_ACQUIRE, "agent"); asm volatile("s_waitcnt vmcnt(0)" ::: "memory"); }
    }
};
struct EpiPabOut {
    static constexpr bool PERM = true, APERM = false; static constexpr int MIDK = 16; static constexpr bool PREF = true; static constexpr int NPF = 1;
    EpiPab P; EpiRes R;
    __device__ __forceinline__ void produce(const Acc&, const Unit&, const int) const {}
    __device__ __forceinline__ float prefetch(const Unit& u, const int tid) const { return (u.hm & 0x1000) ? R.prefetch(u, tid) : 0.f; }
    __device__ __forceinline__ void mid(Acc& acc, const Unit& u, const int wid) const { if (!(u.hm & 0x1000)) P.mid(acc, u, wid); }
    __device__ __forceinline__ void operator()(const Acc& acc, const Unit& u, const int wid) const { if (u.hm & 0x1000) R(acc, u, wid); else P(acc, u, wid); }
};
}

struct Buffers;
struct FourierSync {
    static constexpr bool WAIT_FIRST = true;
    bool mg; unsigned* pub; unsigned* wt; unsigned need;
    __device__ __forceinline__ bool needs_wait(const pg8::Unit&) const { return mg && wt != nullptr; }
    __device__ __forceinline__ bool publishes(const pg8::Unit&) const { return mg && pub != nullptr; }
    __device__ __forceinline__ void publish(const pg8::Unit& u) const { __hip_atomic_fetch_add((GAS unsigned*)(pub + u.pm * 16), 1u, __ATOMIC_RELAXED, __HIP_MEMORY_SCOPE_AGENT); }
    __device__ __forceinline__ void wait_panel(const pg8::Unit& u, const int wid) const {
        if (wid == 0) { GAS unsigned* fp = (GAS unsigned*)(wt + u.pm * 16); unsigned sp = 0;
            while ((unsigned)__builtin_amdgcn_readfirstlane(__hip_atomic_load(fp, __ATOMIC_RELAXED, __HIP_MEMORY_SCOPE_AGENT)) < need) { __builtin_amdgcn_s_sleep(2); if (++sp > (1u << 20)) break; }
            __builtin_amdgcn_fence(__ATOMIC_ACQUIRE, "agent"); asm volatile("s_waitcnt vmcnt(0)" ::: "memory"); }
    }
};
struct F1SOrder : FourierSync {
    static constexpr int BH_ROWS = 128; static constexpr bool KSPLIT = false, MERGED = true;
    int G, c; const char* DC; const char* QK; char* GTS;
    __device__ __forceinline__ bool next(int i, pg8::Unit& u) const {
        int L; if (mg) { if (i >= 2) return false; L = 64 * (c & 7) + 32 * i + (c >> 3); } else { L = i * G + c; if (L >= 512) return false; }
        const int bg = L >> 5, part = (L >> 4) & 1, nt = L & 15, b = bg >> 2, g = bg & 3;
        u.a = DC + (size_t)part * 256 * 256 * 2; u.b = QK + ((size_t)(MP + b * SEQ_S + nt * 256) * IN_DIM + 3072 + g * 256) * 2;
        u.c = GTS + ((size_t)bg * 256 * 8192 + part * 4096 + nt * 256) * 2; u.pm = bg; u.pn = nt; u.hm = 0; return true;
    }
};
struct F1POrder : FourierSync {
    static constexpr int BH_ROWS = 128; static constexpr bool KSPLIT = false, MERGED = true;
    int G, c; const char* DC; const char* QK; char* GTP;
    __device__ __forceinline__ bool next(int i, pg8::Unit& u) const {
        int L; if (mg) { if (i >= 1 || (c >> 3) < 16) return false; L = 16 * (c & 7) + (c >> 3) - 16; }      else { L = i * G + (G - 1 - c); if (L >= 128) return false; }
        const int bg = L >> 1, part = L & 1, b = bg >> 2, g = bg & 3;
        u.a = DC + (size_t)part * 256 * 256 * 2; u.b = QK + ((size_t)(b * SEQ_P) * IN_DIM + 3072 + g * 256) * 2;
        u.c = GTP + ((size_t)bg * 256 * 512 + part * 256) * 2; u.pm = bg; u.pn = 0; u.hm = 0; return true;
    }
};
struct F2SOrder : FourierSync {
    static constexpr int BH_ROWS = 128; static constexpr bool KSPLIT = false, MERGED = true;
    int G, c; const char* DS; const char* U2; char* AF;
    __device__ __forceinline__ bool next(int i, pg8::Unit& u) const {
        int L; if (mg) { if (i >= 1) return false; L = 32 * (c & 7) + (c >> 3); } else { L = i * G + c; if (L >= 256) return false; }
        const int bg = L >> 4, k2 = L & 15, b = bg >> 2, g = bg & 3;
        u.a = DS; u.b = U2 + (size_t)(bg * 16 + k2) * 256 * 512 * 2;
        u.c = AF + ((size_t)(MP + b * SEQ_S + k2) * D + 1024 + g * 256) * 2; u.pm = bg; u.pn = 0; u.hm = 0; return true;
    }
};
struct F2POrder : FourierSync {
    static constexpr int BH_ROWS = 128; static constexpr bool KSPLIT = false, MERGED = true;
    int G, c; const char* DP; const char* GTP; char* AF;
    __device__ __forceinline__ bool next(int i, pg8::Unit& u) const {
        int L; if (mg) { if (i >= 1 || (c >> 3) < 24) return false; L = 8 * (c & 7) + (c >> 3) - 24; } else { L = i * G + (G - 1 - c); if (L >= 64) return false; }
        const int bg = L, b = bg >> 2, g = bg & 3;
        u.a = DP; u.b = GTP + (size_t)bg * 256 * 512 * 2; u.c = AF + ((size_t)(b * SEQ_P) * D + 1024 + g * 256) * 2; u.pm = bg; u.pn = 0; u.hm = 0; return true;
    }
};

namespace att {
#define KSWZ(row, colB) ((row) * 256 + ((colB) ^ (((row) & 7) << 4)))
__device__ __forceinline__ int crow(int r, int hi) { return (r & 3) + 8 * (r >> 2) + 4 * hi; }
__device__ __forceinline__ int v_st(int k, int c) { const int kk = (k & ~0xC) | ((k & 4) << 1) | ((k & 8) >> 1); return ((kk >> 3) * 4 + (c >> 5)) * 512 + ((kk & 7) * 32 + (c & 31)) * 2; }
__device__ __forceinline__ int v_rd_base(int lane) { return ((lane & 3) << 3) | (((lane >> 2) & 3) << 6) | (((lane >> 4) & 1) << 5) | (((lane >> 5) & 1) << 8); }
constexpr int v_rd_off(int d0, int ks, int half) { return d0 * 512 + ks * 4096 + half * 2048; }
template <int OFF> __device__ __forceinline__ s16x4 tr_read(int vb) { s16x4 r; asm volatile("ds_read_b64_tr_b16 %0, %1 offset:%2" : "=&v"(r) : "v"(vb), "i"(OFF) : "memory"); return r; }
template <int D0> __device__ __forceinline__ void pv_one(f32x16& od, int vb, bf16x8 pa0, bf16x8 pa1, bf16x8 pa2, bf16x8 pa3) {
    const s16x4 l0 = tr_read<v_rd_off(D0, 0, 0)>(vb), h0 = tr_read<v_rd_off(D0, 0, 1)>(vb), l1 = tr_read<v_rd_off(D0, 1, 0)>(vb), h1 = tr_read<v_rd_off(D0, 1, 1)>(vb);
    const s16x4 l2 = tr_read<v_rd_off(D0, 2, 0)>(vb), h2 = tr_read<v_rd_off(D0, 2, 1)>(vb), l3 = tr_read<v_rd_off(D0, 3, 0)>(vb), h3 = tr_read<v_rd_off(D0, 3, 1)>(vb);
    asm volatile("s_waitcnt lgkmcnt(0)" ::: "memory"); __builtin_amdgcn_sched_barrier(0);
#define ATT_PK(L, H) (bf16x8){L[0], L[1], L[2], L[3], H[0], H[1], H[2], H[3]}
    od = __builtin_amdgcn_mfma_f32_32x32x16_bf16(pa0, ATT_PK(l0, h0), od, 0, 0, 0);
    od = __builtin_amdgcn_mfma_f32_32x32x16_bf16(pa1, ATT_PK(l1, h1), od, 0, 0, 0);
    od = __builtin_amdgcn_mfma_f32_32x32x16_bf16(pa2, ATT_PK(l2, h2), od, 0, 0, 0);
    od = __builtin_amdgcn_mfma_f32_32x32x16_bf16(pa3, ATT_PK(l3, h3), od, 0, 0, 0);
#undef ATT_PK
}
constexpr int SHM_V = 64 * 128 * 2, SHM_K = 64 * 128 * 2;
constexpr int L_V = 0, L_K = 2 * SHM_V, L_WS = 2 * SHM_V + 2 * SHM_K, L_TAB = L_WS + NWAVES * 64 * 4, L_END = L_TAB + 15 * 128 * 4;
static_assert(L_END <= 131072, "attention LDS");

struct TileSrc { const bf16_t* K0; const bf16_t* V0; int ld0, nt0; const bf16_t* K1; const bf16_t* V1; int ld1, nt1; };

template <bool NA>
__device__ __forceinline__ void attn_unit(LAS char* lds, const int wave0, const bf16_t* Qb, int ldq, const TileSrc T, int kr0, int qrow0, const float* rpb, bf16_t* Ob, int ldo) {
    const int lane = fresh_lane(), wid = fresh_wave(wave0), tid = wid * 64 + lane, r32 = lane & 31, hi = lane >> 5;
    LAS char* V_lds = lds + L_V; LAS char* K_lds = lds + L_K;
    LAS float* ws = (LAS float*)(lds + L_WS) + wid * 64; LAS float* li_l = ws; LAS float* al_l = ws + 32;
    LAS float* tab = (LAS float*)(lds + L_TAB);
    float m_reg = -1e30f, l_reg = 0.f; f32x16 o[4];
#pragma unroll
    for (int d = 0; d < 4; ++d)
#pragma unroll
        for (int r = 0; r < 16; ++r) o[d][r] = 0.f;
    bf16x8 qr[8];
    { const bf16_t* Qw = Qb + (size_t)(wid * 32 + r32) * ldq + hi * 8;
#pragma unroll
      for (int d0 = 0; d0 < 8; ++d0) qr[d0] = *(const GAS bf16x8*)(Qw + d0 * 16); }
    if (NA) { for (int idx = tid; idx < 15 * 128; idx += NTHREADS) { const int dr7 = idx >> 7, dcc = (idx & 127) - 63;
                  tab[idx] = (dcc >= -15 && dcc <= 15) ? ((const GAS float*)rpb)[dr7 * 31 + dcc + 15] * LOG2E : 0.f; } }
    const int sr = tid >> 4, sc = (tid & 15) * 8, vst0 = v_st(sr, sc), vst1 = v_st(32 + sr, sc), kst0 = KSWZ(sr, sc * 2), kst1 = KSWZ(32 + sr, sc * 2);
    const int vb0 = (int)(uintptr_t)(V_lds) + v_rd_base(lane);
    const int NT = T.nt0 + T.nt1;
    bf16x8 vs0, vs1, ks0, ks1;
#define ATT_SLOAD(t) do { const bool g0 = (t) < T.nt0; const int tt = g0 ? (t) : (t) - T.nt0; const int ld = g0 ? T.ld0 : T.ld1; \
        const bf16_t* Kp = (g0 ? T.K0 : T.K1) + (size_t)tt * 64 * ld; const bf16_t* Vp = (g0 ? T.V0 : T.V1) + (size_t)tt * 64 * ld; \
        vs0 = *(const GAS bf16x8*)(Vp + (size_t)sr * ld + sc); vs1 = *(const GAS bf16x8*)(Vp + (size_t)(32 + sr) * ld + sc); \
        ks0 = *(const GAS bf16x8*)(Kp + (size_t)sr * ld + sc); ks1 = *(const GAS bf16x8*)(Kp + (size_t)(32 + sr) * ld + sc); } while (0)
#define ATT_SWRITE(b) do { *(LAS bf16x8*)(V_lds + (b) * SHM_V + vst0) = vs0; *(LAS bf16x8*)(V_lds + (b) * SHM_V + vst1) = vs1; \
        *(LAS bf16x8*)(K_lds + (b) * SHM_K + kst0) = ks0; *(LAS bf16x8*)(K_lds + (b) * SHM_K + kst1) = ks1; } while (0)
    ATT_SLOAD(0); ATT_SWRITE(0);
    __syncthreads();
    const int qrow = qrow0 + (wid >> 1), qc = 32 * (wid & 1) + r32;
    const int r0w = min(max(qrow - 4, 0), GW - 8), c0 = min(max(qc - 8, 0), GW - 16);
    for (int t = 0; t < NT; ++t) {
        const int buf = t & 1;
        if (t + 1 < NT) ATT_SLOAD(t + 1);
        bool active = true; int dr = 0;
        if (NA && t >= T.nt0) { const int kr = kr0 + (t - T.nt0); active = (kr >= r0w) && (kr < r0w + 8); dr = kr - qrow; }
        if (active) {
            f32x16 p0, p1;
#pragma unroll
            for (int r = 0; r < 16; ++r) { p0[r] = 0.f; p1[r] = 0.f; }
            { LAS const char* Ks = K_lds + buf * SHM_K;
              __builtin_amdgcn_s_setprio(1);
#pragma unroll
              for (int d0 = 0; d0 < 8; ++d0) { const int cb = (d0 * 16 + hi * 8) * 2;
                  const bf16x8 b0 = *(LAS const bf16x8*)(Ks + KSWZ(r32, cb)); const bf16x8 b1 = *(LAS const bf16x8*)(Ks + KSWZ(32 + r32, cb));
                  p0 = __builtin_amdgcn_mfma_f32_32x32x16_bf16(b0, qr[d0], p0, 0, 0, 0); p1 = __builtin_amdgcn_mfma_f32_32x32x16_bf16(b1, qr[d0], p1, 0, 0, 0); }
              __builtin_amdgcn_s_setprio(0); }
            if (NA && t >= T.nt0) {
                LAS const float* brow = tab + (dr + 7) * 128 + 63 - qc + 4 * hi;
#pragma unroll
                for (int r = 0; r < 16; ++r) { const int kq = (r & 3) + 8 * (r >> 2); const int kc = kq + 4 * hi;
                    const float b0 = brow[kq], b1 = brow[kq + 32];
                    p0[r] = ((unsigned)(kc - c0) < 16u) ? p0[r] + b0 : -INFINITY; p1[r] = ((unsigned)(kc + 32 - c0) < 16u) ? p1[r] + b1 : -INFINITY; }
            }
            float pmax = p0[0];
#pragma unroll
            for (int r = 1; r < 16; ++r) pmax = fmaxf(pmax, p0[r]);
#pragma unroll
            for (int r = 0; r < 16; ++r) pmax = fmaxf(pmax, p1[r]);
            { auto rr = __builtin_amdgcn_permlane32_swap(__float_as_uint(pmax), __float_as_uint(pmax), false, false); pmax = fmaxf(__uint_as_float(rr[0]), __uint_as_float(rr[1])); }
            const float mn = fmaxf(m_reg, pmax), alpha = __builtin_amdgcn_exp2f(m_reg - mn); m_reg = mn;
            float ps = 0.f;
#pragma unroll
            for (int r = 0; r < 16; ++r) { p0[r] = __builtin_amdgcn_exp2f(p0[r] - mn); p1[r] = __builtin_amdgcn_exp2f(p1[r] - mn); ps += p0[r] + p1[r]; }
            { auto rr = __builtin_amdgcn_permlane32_swap(__float_as_uint(ps), __float_as_uint(ps), false, false); ps = __uint_as_float(rr[0]) + __uint_as_float(rr[1]); }
            l_reg = l_reg * alpha + ps;
            bf16x8 pa0, pa1, pa2, pa3;
#define ATT_PK4(P, BASE, OUT) do { unsigned a0 = cvt_pk_bf16(P[BASE + 0], P[BASE + 1]), a1 = cvt_pk_bf16(P[BASE + 2], P[BASE + 3]);   \
    unsigned b0 = cvt_pk_bf16(P[BASE + 4], P[BASE + 5]), b1 = cvt_pk_bf16(P[BASE + 6], P[BASE + 7]);                              \
    auto r0_ = __builtin_amdgcn_permlane32_swap(a0, b0, false, false); auto r1_ = __builtin_amdgcn_permlane32_swap(a1, b1, false, false); \
    u32x4 w_ = {r0_[0], r1_[0], r0_[1], r1_[1]}; OUT = *reinterpret_cast<bf16x8*>(&w_); } while (0)
            ATT_PK4(p0, 0, pa0); ATT_PK4(p0, 8, pa1); ATT_PK4(p1, 0, pa2); ATT_PK4(p1, 8, pa3);
#undef ATT_PK4
            if (__any(alpha < 1.f)) { if (hi == 0) al_l[r32] = alpha; asm volatile("s_waitcnt lgkmcnt(0)" ::: "memory");
#pragma unroll
                for (int r = 0; r < 16; ++r) { const float a = al_l[crow(r, hi)];
#pragma unroll
                    for (int d = 0; d < 4; ++d) o[d][r] *= a; } }
            const int vb = vb0 + buf * SHM_V;
            __builtin_amdgcn_s_setprio(1);
            pv_one<0>(o[0], vb, pa0, pa1, pa2, pa3); pv_one<1>(o[1], vb, pa0, pa1, pa2, pa3); pv_one<2>(o[2], vb, pa0, pa1, pa2, pa3); pv_one<3>(o[3], vb, pa0, pa1, pa2, pa3);
            __builtin_amdgcn_s_setprio(0);
        }
        if (t + 1 < NT) ATT_SWRITE(buf ^ 1);
        __syncthreads();
    }
#undef ATT_SLOAD
#undef ATT_SWRITE
    if (hi == 0) li_l[r32] = l_reg;
    asm volatile("s_waitcnt lgkmcnt(0)" ::: "memory");
    bf16_t* Ow = Ob + (size_t)(wid * 32) * ldo;
#pragma unroll
    for (int r = 0; r < 16; ++r) { const int orow = crow(r, hi); const float rl = __builtin_amdgcn_rcpf(li_l[orow]);
#pragma unroll
        for (int d0 = 0; d0 < 4; ++d0) ((GAS bf16_t*)Ow)[(size_t)orow * ldo + d0 * 32 + r32] = (bf16_t)(cvt_pk_bf16(o[d0][r] * rl, 0.f) & 0xffffu); }
    __syncthreads();
}
}

__device__ __forceinline__ void dft4(float& r0, float& i0, float& r1, float& i1, float& r2, float& i2, float& r3, float& i3) {
    const float t0r = r0 + r2, t0i = i0 + i2, t1r = r0 - r2, t1i = i0 - i2, t2r = r1 + r3, t2i = i1 + i3, t3r = r1 - r3, t3i = i1 - i3;
    r0 = t0r + t2r; i0 = t0i + t2i; r2 = t0r - t2r; i2 = t0i - t2i; r1 = t1r + t3i; i1 = t1i - t3r; r3 = t1r - t3i; i3 = t1i + t3r;
}
__device__ __forceinline__ void fft16(float (&xr)[16], float (&xi)[16]) {
#pragma unroll
    for (int nb = 0; nb < 4; ++nb) dft4(xr[nb], xi[nb], xr[4 + nb], xi[4 + nb], xr[8 + nb], xi[8 + nb], xr[12 + nb], xi[12 + nb]);
    constexpr float C1 = 0.92387953251128674f, S1 = 0.38268343236508977f, R2 = 0.70710678118654752f;
    constexpr float TC[10] = {1.f, C1, R2, S1, 0.f, 0.f, -R2, 0.f, 0.f, -C1};
    constexpr float TS[10] = {0.f, S1, R2, C1, 1.f, 0.f, R2, 0.f, 0.f, -S1};
#pragma unroll
    for (int nb = 1; nb < 4; ++nb)
#pragma unroll
        for (int ka = 1; ka < 4; ++ka) { const float c = TC[nb * ka], sn = TS[nb * ka]; const float ar = xr[4 * ka + nb], ai = xi[4 * ka + nb];
            xr[4 * ka + nb] = ar * c + ai * sn; xi[4 * ka + nb] = ai * c - ar * sn; }
#pragma unroll
    for (int ka = 0; ka < 4; ++ka) dft4(xr[4 * ka], xi[4 * ka], xr[4 * ka + 1], xi[4 * ka + 1], xr[4 * ka + 2], xi[4 * ka + 2], xr[4 * ka + 3], xi[4 * ka + 3]);
}

struct Args { const float* in[20]; float* out; unsigned char* ws; };
enum { I_XP = 0, I_XS, I_CK, I_CV, I_C, I_CCTX, I_WMOD, I_BMOD, I_N1G, I_WIN, I_RPB, I_WPA, I_WPB, I_WOUT, I_N2G, I_WUP, I_CONVW, I_CONVB, I_WDOWN, I_NFG };

__device__ __forceinline__ void transpose_item(const float* W, int K, int N, bf16_t* WT, int ldt, int nsc, float sc, LAS float* scr, int item, int lane) {
    const int nblk = N >> 6, kb = item / nblk, nb = item - kb * nblk, k0 = kb << 6, n0 = nb << 6;
    f32x4 v[16];
    const float* src = W + (size_t)(k0 + (lane >> 4)) * N + n0 + 4 * (lane & 15);
#pragma unroll
    for (int i = 0; i < 16; ++i) v[i] = *(const f32x4*)(src + (size_t)(4 * i) * N);
#pragma unroll
    for (int i = 0; i < 16; ++i) { LAS float* d = scr + (4 * i + (lane >> 4)) * 65 + 4 * (lane & 15); d[0] = v[i][0]; d[1] = v[i][1]; d[2] = v[i][2]; d[3] = v[i][3]; }
    LDS_WAIT(); asm volatile("" ::: "memory");
    const int c = lane & 7;
#pragma unroll
    for (int j = 0; j < 8; ++j) { const int n = (lane >> 3) + 8 * j; const LAS float* s = scr + (8 * c) * 65 + n; const float f = (n0 + n) < nsc ? sc : 1.0f;
        u32x4 o; o.x = cvt_pk_bf16(s[0 * 65] * f, s[1 * 65] * f); o.y = cvt_pk_bf16(s[2 * 65] * f, s[3 * 65] * f); o.z = cvt_pk_bf16(s[4 * 65] * f, s[5 * 65] * f); o.w = cvt_pk_bf16(s[6 * 65] * f, s[7 * 65] * f);
        *(u32x4*)(WT + (size_t)(n0 + n) * ldt + k0 + 8 * c) = o; }
    LDS_WAIT(); asm volatile("" ::: "memory");
}

__global__ void __launch_bounds__(NTHREADS, 2) fwd(Args args) {
    extern __shared__ __attribute__((aligned(16))) unsigned char lds_raw[];
    LAS unsigned char* lds = (LAS unsigned char*)lds_raw;
    volatile LAS unsigned* MISC = (volatile LAS unsigned*)(lds + MISC_OFF);
    const int G = gridDim.x, bx = blockIdx.x;
    const int vcu = (G % 8 == 0) ? (bx % 8) * (G / 8) + bx / 8 : bx;
    const int NGW = G * NWAVES;
    const int wave0 = __builtin_amdgcn_readfirstlane((int)threadIdx.x >> 6);
#define OPQ_BX() unsigned mo_ = MISC_OFF + 16; asm volatile("; opaque LDS offset" : "+v"(mo_)); int bxo_ = __builtin_amdgcn_readfirstlane((int)*(volatile LAS unsigned*)(lds + mo_)); asm volatile("; opaque virtual block index" : "+s"(bxo_)); const int bx = bxo_
#define PIN_TID() const int lane = fresh_lane(), wave = fresh_wave(wave0), tid = wave * 64 + lane, gw = vcu * NWAVES + wave; (void)gw; (void)tid
    { const int tid = threadIdx.x; if (tid < 64) MISC[tid] = 0u; }
    unsigned char* ws = args.ws;
    __syncthreads();
    XcdBarrier bar = xcd_barrier_post((unsigned*)(ws + WS_CTL) + CW_BAR, MISC);
    if (threadIdx.x == 0) { const unsigned xcc = xb_xcc_id(); MISC[2] = xcc; MISC[3] = xb_add((unsigned*)(ws + WS_CTL) + CW_XRANK + 64 * xcc, 1u); MISC[4] = blockIdx.x; }
#define GRID_BAR() do { XcdBarrier b_ = bar; asm volatile("; pin bar" : "+s"(b_.bar), "+s"(b_.x)); const bool ldr_ = (fresh_wave(wave0) == 0) && (fresh_lane() == 0); for (int rb_ = 0; rb_ < REP_BAR; ++rb_) xcd_barrier(b_, ldr_); } while (0)

    float* X = args.out;
    float* OUTK = args.out + (size_t)M * D; float* OUTV = OUTK + (size_t)NB_P * DEPTH * NH * SEQ_P * HD;
    float* MODS = (float*)(ws + WS_MODS); float* SS = (float*)(ws + WS_SS); float* BIN = (float*)(ws + WS_BIAS); float* BUP = BIN + (size_t)DEPTH * 5 * IN_DIM;
    bf16_t* CKB = (bf16_t*)(ws + WS_CACHE); bf16_t* CVB = CKB + (size_t)NB_S * DEPTH * NH * PAST * HD;
    bf16_t* DC = (bf16_t*)(ws + WS_DC); bf16_t* DP = (bf16_t*)(ws + WS_DP); bf16_t* DS = (bf16_t*)(ws + WS_DS); bf16_t* U2 = (bf16_t*)(ws + WS_UP2);
    bf16_t* HB = (bf16_t*)(ws + WS_H); bf16_t* QK = (bf16_t*)(ws + WS_BIG); float* UH = (float*)(ws + WS_UH);
    bf16_t* AF = (bf16_t*)(ws + WS_AF); bf16_t* GTS = (bf16_t*)(ws + WS_GTS); bf16_t* GTP = (bf16_t*)(ws + WS_GTP);
    float* T1 = (float*)(ws + WS_T1); bf16_t* ACT = (bf16_t*)(ws + WS_ACT); bf16_t* YB = (bf16_t*)(ws + WS_Y);

    for (int rep_ = 0; rep_ < REP_P0; ++rep_) {
        PIN_TID();
#if EN_MODS
        for (int item = bx; item < DEPTH * 48; item += G) {
            const int l = item / 48, nb = item % 48;
            LAS float* sil = (LAS float*)lds; LAS float* red = (LAS float*)(lds + 5 * D * 4);
            for (int idx = tid; idx < 5 * D; idx += NTHREADS) { const int v = idx / D, k = idx % D; const float cv = v == 0 ? args.in[I_CCTX][k] : args.in[I_C][(size_t)(v - 1) * D + k];
                sil[idx] = cv * sigmoidf_fast(cv); }
            __syncthreads();
            f32x4 a5[5];
#pragma unroll
            for (int v = 0; v < 5; ++v) a5[v] = (f32x4){0.f, 0.f, 0.f, 0.f};
            const float* Wp = args.in[I_WMOD] + ((size_t)l * D + wave * 256) * (NMOD * D) + 256 * nb + 4 * lane;
            for (int k8 = 0; k8 < 256; k8 += 8) {
                f32x4 wv[8];
#pragma unroll
                for (int j = 0; j < 8; ++j) wv[j] = *(const f32x4*)(Wp + (size_t)(k8 + j) * (NMOD * D));
#pragma unroll
                for (int j = 0; j < 8; ++j)
#pragma unroll
                    for (int v = 0; v < 5; ++v) a5[v] += sil[v * D + wave * 256 + k8 + j] * wv[j];
            }
#pragma unroll
            for (int v = 0; v < 5; ++v) *(LAS f32x4*)(red + (wave * 5 + v) * 256 + 4 * lane) = a5[v];
            __syncthreads();
            for (int o = tid; o < 5 * 256; o += NTHREADS) { const int v = o >> 8, n = o & 255; float s = args.in[I_BMOD][(size_t)l * NMOD * D + 256 * nb + n];
#pragma unroll
                for (int w = 0; w < 8; ++w) s += red[(w * 5 + v) * 256 + n];
                MODS[((size_t)l * 5 + v) * (NMOD * D) + 256 * nb + n] = s; }
            __syncthreads();
        }
#endif
#if EN_WT
        {
            LAS float* scr = (LAS float*)(lds + wave * (64 * 65 * 4));
            constexpr int I_IN = (D / 64) * (IN_DIM / 64), I_PA = (AD / 64) * (D / 64), I_PB = (FD / 64) * (D / 64), I_OUT = (D / 64) * (D / 64), I_UP = (D / 64) * (FFN2 / 64), I_DOWN = (FFN / 64) * (D / 64);
            constexpr int PER_LAYER = I_IN + I_PA + I_PB + I_OUT + I_UP + I_DOWN;
            for (int it = gw; it < DEPTH * PER_LAYER; it += NGW) {
                const int l = it / PER_LAYER; int r = it - l * PER_LAYER;
                bf16_t* wt = (bf16_t*)(ws + WS_WT + (size_t)l * WT_LAYER);
                if (r < I_IN) { transpose_item(args.in[I_WIN] + (size_t)l * D * IN_DIM, D, IN_DIM, wt + WT_IN / 2, D, AD, QSCALE, scr, r, lane); continue; } r -= I_IN;
                if (r < I_PA) { transpose_item(args.in[I_WPA] + (size_t)l * AD * D, AD, D, wt + WT_PA / 2, AD + FD, 0, 1.f, scr, r, lane); continue; } r -= I_PA;
                if (r < I_PB) { transpose_item(args.in[I_WPB] + (size_t)l * FD * D, FD, D, wt + WT_PA / 2 + AD, AD + FD, 0, 1.f, scr, r, lane); continue; } r -= I_PB;
                if (r < I_OUT) { transpose_item(args.in[I_WOUT] + (size_t)l * D * D, D, D, wt + WT_OUT / 2, D, 0, 1.f, scr, r, lane); continue; } r -= I_OUT;
                if (r < I_UP) { transpose_item(args.in[I_WUP] + (size_t)l * D * FFN2, D, FFN2, wt + WT_UP / 2, D, 0, 1.f, scr, r, lane); continue; } r -= I_UP;
                transpose_item(args.in[I_WDOWN] + (size_t)l * FFN * D, FFN, D, wt + WT_DOWN / 2, FFN, 0, 1.f, scr, r, lane);
            }
        }
#endif
#if EN_MISC
        {
            const size_t n8 = (size_t)NB_S * DEPTH * NH * PAST * HD / 8;
            for (size_t i = (size_t)gw * 64 + lane; i < 2 * n8; i += (size_t)NGW * 64) { const bool isk = i < n8; const size_t j = isk ? i : i - n8;
                const float* s = (isk ? args.in[I_CK] : args.in[I_CV]) + j * 8; const f32x4 a = *(const f32x4*)s, b = *(const f32x4*)(s + 4);
                u32x4 w; w.x = cvt_pk_bf16(a[0], a[1]); w.y = cvt_pk_bf16(a[2], a[3]); w.z = cvt_pk_bf16(b[0], b[1]); w.w = cvt_pk_bf16(b[2], b[3]);
                *(u32x4*)((isk ? CKB : CVB) + j * 8) = w; }
        }
        {
            for (int i = gw * 64 + lane; i < 512 * 256 / 8; i += NGW * 64) { const int j = i >> 5, c0 = (i & 31) * 8; const bool isin = j >= 256; const int jj = j & 255;
                float v[8];
#pragma unroll
                for (int e = 0; e < 8; ++e) { const int mm = (jj * (c0 + e)) & 255; const float x = (float)mm * (1.0f / 128.0f); v[e] = (isin ? -sinpif(x) : cospif(x)) * (1.0f / 16.0f); }
                u32x4 w; w.x = cvt_pk_bf16(v[0], v[1]); w.y = cvt_pk_bf16(v[2], v[3]); w.z = cvt_pk_bf16(v[4], v[5]); w.w = cvt_pk_bf16(v[6], v[7]);
                *(u32x4*)(DC + (size_t)j * 256 + c0) = w; }
            for (int i = gw * 64 + lane; i < 256 * 512 / 8; i += NGW * 64) { const int k1 = i >> 6, c8 = (i & 63) * 8; const bool isin = c8 >= 256; const int n0 = c8 & 255;
                float v[8];
#pragma unroll
                for (int e = 0; e < 8; ++e) { const int mm = (k1 * (n0 + e)) & 255; const float x = (float)mm * (1.0f / 128.0f); v[e] = (isin ? sinpif(x) : cospif(x)) * (1.0f / 16.0f); }
                u32x4 w; w.x = cvt_pk_bf16(v[0], v[1]); w.y = cvt_pk_bf16(v[2], v[3]); w.z = cvt_pk_bf16(v[4], v[5]); w.w = cvt_pk_bf16(v[6], v[7]);
                *(u32x4*)(DP + (size_t)k1 * 512 + c8) = w;
                w.x = cvt_pk_bf16(v[0] * 0.25f, v[1] * 0.25f); w.y = cvt_pk_bf16(v[2] * 0.25f, v[3] * 0.25f); w.z = cvt_pk_bf16(v[4] * 0.25f, v[5] * 0.25f); w.w = cvt_pk_bf16(v[6] * 0.25f, v[7] * 0.25f);
                *(u32x4*)(DS + (size_t)k1 * 512 + c8) = w; }
        }
#endif
    }
    GRID_BAR();

    if (threadIdx.x == 0) {
        unsigned* rk = (unsigned*)(ws + WS_CTL) + CW_XRANK; const unsigned xcc = MISC[2], myrank = MISC[3]; unsigned npop = 0, xidx = 0; bool ok = (G % 8) == 0;
        for (unsigned j = 0; j < 16; ++j) { const unsigned cnt = xb_ld(rk + 64 * j); if (cnt) { ++npop; if (j < xcc) ++xidx; if (cnt != (unsigned)(G / 8)) ok = false; } }
        if (ok && npop == 8) { MISC[4] = myrank * 8u + xidx; MISC[5] = 1u; }
    }
    __syncthreads();
    {
        PIN_TID();
#if EN_NORM
        { const float* gvec = args.in[I_N1G];
          for (int row = gw; row < M; row += NGW) {
            const float* src = row < MP ? args.in[I_XP] + (size_t)row * D : args.in[I_XS] + (size_t)(row - MP) * D;
            f32x4 v[8]; float ssq = 0.f;
#pragma unroll
            for (int j = 0; j < 8; ++j) { v[j] = *(const GAS f32x4*)(src + 4 * (lane + 64 * j)); ssq += (v[j][0] * v[j][0] + v[j][1] * v[j][1]) + (v[j][2] * v[j][2] + v[j][3] * v[j][3]); }
            ssq = wave_sum(ssq);
            const int bv = row < MP ? 0 : 1 + ((row - MP) >> 12);
            const float* scp = MODS + ((size_t)bv * NMOD + 1) * D;
#pragma unroll
            for (int j = 0; j < 8; ++j) { const int col = 4 * (lane + 64 * j); const f32x4 g = *(const GAS f32x4*)(gvec + col), sc = *(const GAS f32x4*)(scp + col);
                const f32x4 y = v[j] * g * (sc + 1.0f); u32x2 w; w.x = cvt_pk_bf16(y[0], y[1]); w.y = cvt_pk_bf16(y[2], y[3]); *(GAS u32x2*)(HB + (size_t)row * D + col) = w; }
            if (lane == 0) SS[row] = ssq;
          } }
#endif
#if EN_MISC
        for (int l = 0; l < DEPTH; ++l) {
            LAS float* shl = (LAS float*)lds;
            __syncthreads();
            for (int idx = tid; idx < 2 * 5 * D; idx += NTHREADS) { const int w2 = idx / (5 * D), r = idx - w2 * 5 * D, bv = r / D, k = r - bv * D; shl[idx] = MODS[(((size_t)l * 5 + bv) * NMOD + (w2 ? 3 : 0)) * D + k]; }
            __syncthreads();
            const bf16_t* wt_in = (const bf16_t*)(ws + WS_WT + (size_t)l * WT_LAYER + WT_IN); const bf16_t* wt_up = (const bf16_t*)(ws + WS_WT + (size_t)l * WT_LAYER + WT_UP);
            for (int r = gw; r < IN_DIM + FFN2; r += NGW) {
                const bool isup = r >= IN_DIM; const int n = isup ? r - IN_DIM : r;
                const bf16_t* wrow = (isup ? wt_up : wt_in) + (size_t)n * D; const LAS float* sh = shl + (isup ? 5 * D : 0);
                float a5[5] = {0.f, 0.f, 0.f, 0.f, 0.f};
#pragma unroll
                for (int j = 0; j < 4; ++j) { const int k0 = 512 * j + 8 * lane; const u32x4 w = *(const GAS u32x4*)(wrow + k0);
                    float wf[8];
#pragma unroll
                    for (int e = 0; e < 4; ++e) { wf[2 * e] = bf_lo(w[e]); wf[2 * e + 1] = bf_hi(w[e]); }
#pragma unroll
                    for (int bv = 0; bv < 5; ++bv) { const f32x4 s0 = *(const LAS f32x4*)(sh + bv * D + k0), s1 = *(const LAS f32x4*)(sh + bv * D + k0 + 4);
                        a5[bv] += (wf[0] * s0[0] + wf[1] * s0[1]) + (wf[2] * s0[2] + wf[3] * s0[3]) + (wf[4] * s1[0] + wf[5] * s1[1]) + (wf[6] * s1[2] + wf[7] * s1[3]); } }
#pragma unroll
                for (int bv = 0; bv < 5; ++bv) { const float t = wave_sum(a5[bv]); if (lane == 0) { if (isup) BUP[((size_t)l * 5 + bv) * FFN2 + n] = t; else BIN[((size_t)l * 5 + bv) * IN_DIM + n] = t; } }
            }
        }
        __syncthreads();
#endif
    }
    GRID_BAR();

    for (int l = 0; l < DEPTH; ++l) {
        const float* mods_l = MODS + (size_t)l * 5 * NMOD * D;
        const unsigned char* wt = ws + WS_WT + (size_t)l * WT_LAYER;
#if EN_GIN
        {
            OPQ_BX();
            pg8::TileOrder S; S.init(M, IN_DIM, G, bx, HB, D, wt + WT_IN, D, QK, IN_DIM, 2);
            pg8::EpiIn E{OUTK, OUTV, l, SS + (size_t)(2 * l) * M, BIN + (size_t)l * 5 * IN_DIM, (const LAS float*)(lds + pg8::STAGE_BYTES)};
            for (int rep_ = 0; rep_ < REP_GIN; ++rep_)
            pg8::gemm_phase<pg8::EpiIn, pg8::TileOrder>(lds, wave0, D, D, D, S, E);
        }
#endif
        GRID_BAR();

        unsigned mo5_ = MISC_OFF + 20; asm volatile("; opaque LDS offset" : "+v"(mo5_));
        const bool merged_ok = (G == 256) && (__builtin_amdgcn_readfirstlane((int)*(volatile LAS unsigned*)(lds + mo5_)) != 0);
        unsigned* const fcnt = (unsigned*)(ws + WS_CTL) + CW_FOUR + (size_t)l * 96 * 16;
        const bool four_ok = merged_ok && (FOUR_MERGE != 0);
        {
            OPQ_BX();
#if EN_F1
            for (int rep_ = 0; rep_ < REP_FOUR; ++rep_) {
            { F1SOrder S{{four_ok, nullptr, nullptr, 0u}, G, bx, (const char*)DC, (const char*)QK, (char*)GTS}; pg8::EpiBf16U<8192> E{(const LAS float*)(lds + pg8::STAGE_BYTES)}; pg8::gemm_phase<pg8::EpiBf16U<8192>, F1SOrder>(lds, wave0, 256, IN_DIM, 256, S, E); }
            { F1POrder S{{four_ok, nullptr, nullptr, 0u}, G, bx, (const char*)DC, (const char*)QK, (char*)GTP}; pg8::EpiBf16U<512> E{(const LAS float*)(lds + pg8::STAGE_BYTES)}; pg8::gemm_phase<pg8::EpiBf16U<512>, F1POrder>(lds, wave0, 256, IN_DIM, 256, S, E); }
            }
#endif
#if EN_ATT
            for (int rep_ = 0; rep_ < REP_ATT; ++rep_)
            for (int U = bx; U < 640; U += G) {
                if (U < 512) {
                    const int b = U >> 7, h = (U >> 4) & 7, i4 = U & 15;
                    const int kr0 = max(4 * i4 - 4, 0), ntn = (i4 == 0 || i4 == 15) ? 8 : 11;
                    const size_t rowbase = (size_t)MP + (size_t)b * SEQ_S;
                    att::TileSrc T;
                    T.K0 = CKB + (((size_t)b * DEPTH + l) * NH + h) * PAST * HD; T.V0 = CVB + (((size_t)b * DEPTH + l) * NH + h) * PAST * HD; T.ld0 = HD; T.nt0 = 4;
                    T.K1 = QK + (rowbase + (size_t)kr0 * GW) * IN_DIM + 1024 + h * HD; T.V1 = T.K1 + 1024; T.ld1 = IN_DIM; T.nt1 = ntn;
                    att::attn_unit<true>((LAS char*)lds, wave0, QK + (rowbase + (size_t)i4 * 256) * IN_DIM + h * HD, IN_DIM, T, kr0, 4 * i4,
                                         args.in[I_RPB] + ((size_t)l * NH + h) * 15 * 31, AF + (rowbase + (size_t)i4 * 256) * D + h * HD, D);
                } else {
                    const int bh = U - 512, b = bh >> 3, h = bh & 7;
                    att::TileSrc T;
                    T.K0 = QK + ((size_t)b * SEQ_P) * IN_DIM + 1024 + h * HD; T.V0 = T.K0 + 1024; T.ld0 = IN_DIM; T.nt0 = 4;
                    T.K1 = T.K0; T.V1 = T.V0; T.ld1 = IN_DIM; T.nt1 = 0;
                    att::attn_unit<false>((LAS char*)lds, wave0, QK + ((size_t)b * SEQ_P) * IN_DIM + h * HD, IN_DIM, T, 0, 0, nullptr, AF + ((size_t)b * SEQ_P) * D + h * HD, D);
                }
            }
#endif
            if (four_ok) {
                asm volatile("s_waitcnt vmcnt(0)" ::: "memory");
                if (fresh_lane() == 0) { const int x_ = bx & 7, k_ = bx >> 3;
                    __hip_atomic_fetch_add((GAS unsigned*)(fcnt + (2 * x_) * 16), 1u, __ATOMIC_RELAXED, __HIP_MEMORY_SCOPE_AGENT);
                    __hip_atomic_fetch_add((GAS unsigned*)(fcnt + (2 * x_ + 1) * 16), 1u, __ATOMIC_RELAXED, __HIP_MEMORY_SCOPE_AGENT);
                    if (k_ >= 16) __hip_atomic_fetch_add((GAS unsigned*)(fcnt + (16 + 8 * x_ + ((k_ - 16) >> 1)) * 16), 1u, __ATOMIC_RELAXED, __HIP_MEMORY_SCOPE_AGENT); }
            }
        }
        if (!four_ok || FOUR_KEEPBAR) GRID_BAR();

#if EN_F2
        {
            PIN_TID();
            OPQ_BX();
            if (four_ok) {
                unsigned sp = 0;
                for (int q = 0; q < 2; ++q) { GAS unsigned* fp = (GAS unsigned*)(fcnt + (2 * (bx & 7) + q) * 16);
                    while ((unsigned)__builtin_amdgcn_readfirstlane(__hip_atomic_load(fp, __ATOMIC_RELAXED, __HIP_MEMORY_SCOPE_AGENT)) < 256u) { __builtin_amdgcn_s_sleep(2); if (++sp > (1u << 20)) break; } }
                __builtin_amdgcn_fence(__ATOMIC_ACQUIRE, "agent"); asm volatile("s_waitcnt vmcnt(0)" ::: "memory");
            }
            for (int rep_ = 0; rep_ < REP_FOUR; ++rep_)
            for (int jt = 0; ; ++jt) {
                int it;
                if (four_ok) { if (jt >= 4) break; const int li = (bx >> 3) * NWAVES + wave + 256 * jt; it = ((2 * (bx & 7) + (li >> 9)) << 9) + (li & 511); }
                else { it = gw + jt * NGW; if (it >= 16 * 256 * 2) break; }
                const int row = it >> 1, half = it & 1;
                const char* src = (const char*)GTS + (size_t)row * 8192 * 2 + (unsigned)(half * 256 + lane * 4);
                unsigned zr[16], zi[16];
#pragma unroll
                for (int n2 = 0; n2 < 16; ++n2) { zr[n2] = *(const GAS unsigned*)(src + n2 * 512); zi[n2] = *(const GAS unsigned*)(src + 8192 + n2 * 512); }
                unsigned orr[16], oii[16];
#pragma unroll
                for (int j = 0; j < 2; ++j) {
                    float xr[16], xi[16];
#pragma unroll
                    for (int n2 = 0; n2 < 16; ++n2) { xr[n2] = j ? bf_hi(zr[n2]) : bf_lo(zr[n2]); xi[n2] = j ? bf_hi(zi[n2]) : bf_lo(zi[n2]); }
                    fft16(xr, xi);
                    float s1, c1; sincospif((float)(128 * half + 2 * lane + j) * (1.0f / 2048.0f), &s1, &c1);
                    float wr = 1.f, wi = 0.f;
#pragma unroll
                    for (int k2 = 0; k2 < 16; ++k2) { const int slot = 4 * (k2 & 3) + (k2 >> 2);
                        const float ur = xr[slot] * wr - xi[slot] * wi, ui = xr[slot] * wi + xi[slot] * wr;
                        if (j == 0) { orr[k2] = __float_as_uint(ur); oii[k2] = __float_as_uint(ui); }
                        else { orr[k2] = cvt_pk_bf16(__uint_as_float(orr[k2]), ur); oii[k2] = cvt_pk_bf16(__uint_as_float(oii[k2]), ui); }
                        const float nwr = wr * c1 + wi * s1, nwi = wi * c1 - wr * s1; wr = nwr; wi = nwi; }
                }
                const int bg = row >> 8, c = row & 255;
                char* dst = (char*)U2 + ((size_t)(bg * 16) * 256 + c) * 512 * 2 + (unsigned)(half * 256 + lane * 4);
#pragma unroll
                for (int k2 = 0; k2 < 16; ++k2) { *(GAS unsigned*)(dst + (size_t)k2 * 256 * 512 * 2) = orr[k2]; *(GAS unsigned*)(dst + (size_t)k2 * 256 * 512 * 2 + 512) = oii[k2]; }
            }
            if (four_ok) { asm volatile("s_waitcnt vmcnt(0)" ::: "memory");
                if (fresh_lane() == 0) { __hip_atomic_fetch_add((GAS unsigned*)(fcnt + (80 + 2 * (bx & 7)) * 16), 2u, __ATOMIC_RELAXED, __HIP_MEMORY_SCOPE_AGENT);
                                         __hip_atomic_fetch_add((GAS unsigned*)(fcnt + (81 + 2 * (bx & 7)) * 16), 2u, __ATOMIC_RELAXED, __HIP_MEMORY_SCOPE_AGENT); } }
        }
#endif
        if (!four_ok || FOUR_KEEPBAR) GRID_BAR();

#if EN_F2
        {
            OPQ_BX();
            for (int rep_ = 0; rep_ < REP_FOUR; ++rep_) {
            { F2SOrder S{{four_ok, nullptr, fcnt + 80 * 16, 512u}, G, bx, (const char*)DS, (const char*)U2, (char*)AF}; pg8::EpiBf16U<16 * D> E{(const LAS float*)(lds + pg8::STAGE_BYTES)}; pg8::gemm_phase<pg8::EpiBf16U<16 * D>, F2SOrder>(lds, wave0, 512, 512, 512, S, E); }
            { F2POrder S{{four_ok, nullptr, fcnt + 16 * 16, 16u}, G, bx, (const char*)DP, (const char*)GTP, (char*)AF}; pg8::EpiBf16U<D> E{(const LAS float*)(lds + pg8::STAGE_BYTES)}; pg8::gemm_phase<pg8::EpiBf16U<D>, F2POrder>(lds, wave0, 512, 512, 512, S, E); }
            }
        }
#endif
        GRID_BAR();

        if (merged_ok) {
            OPQ_BX();
            pg8::PabOutOrder S{bx, (const char*)AF, (const char*)(wt + WT_PA), (const char*)YB, (const char*)(wt + WT_OUT), (unsigned*)(ws + WS_CTL) + CW_PANEL + (size_t)l * 80 * 16};
            pg8::EpiPabOut E{pg8::EpiPab{QK, YB, (const LAS float*)(lds + pg8::STAGE_BYTES)},
                             pg8::EpiRes{args.in[I_XP], args.in[I_XS], X, mods_l, 2, l == 0, X, true, args.in[I_N2G] + (size_t)l * D, mods_l + 4 * D, SS + (size_t)(2 * l + 1) * M, HB, (const LAS float*)(lds + pg8::STAGE_BYTES)}};
            pg8::gemm_phase<pg8::EpiPabOut, pg8::PabOutOrder>(lds, wave0, D, D, D, S, E);
        } else {
#if EN_PAB
        {
            OPQ_BX();
            for (int rep_ = 0; rep_ < REP_PAB; ++rep_) {
            pg8::TileOrder S; S.init(M, D, G, bx, AF, D, wt + WT_PA, AD + FD, YB, D, 2); S.half_tail(); pg8::EpiPab E{QK, YB, (const LAS float*)(lds + pg8::STAGE_BYTES)}; pg8::gemm_phase<pg8::EpiPab, pg8::TileOrder>(lds, wave0, D, AD + FD, AD + FD, S, E);
            }
        }
#endif
        GRID_BAR();

#if EN_OUT
        {
            OPQ_BX();
            pg8::TileOrder S; S.init(M, D, G, bx, YB, D, wt + WT_OUT, D, X, D, 4); S.half_tail();
            pg8::EpiRes E{args.in[I_XP], args.in[I_XS], X, mods_l, 2, l == 0, X, true, args.in[I_N2G] + (size_t)l * D, mods_l + 4 * D, SS + (size_t)(2 * l + 1) * M, HB, (const LAS float*)(lds + pg8::STAGE_BYTES)};
            for (int rep_ = 1; rep_ < REP_OUT; ++rep_) { pg8::EpiRes E2{args.in[I_XP], args.in[I_XS], X, mods_l, 2, l == 0, (float*)QK, false, nullptr, nullptr, nullptr, nullptr, (const LAS float*)(lds + pg8::STAGE_BYTES)}; pg8::gemm_phase<pg8::EpiRes, pg8::TileOrder>(lds, wave0, D, D, D, S, E2); }
            pg8::gemm_phase<pg8::EpiRes, pg8::TileOrder>(lds, wave0, D, D, D, S, E);
        }
#endif
        }
        GRID_BAR();

#if EN_UP
        {
            OPQ_BX();
            pg8::UpOrder S; S.init(G, bx, HB, wt + WT_UP, ACT);
            pg8::EpiUpConv E{args.in[I_CONVW] + (size_t)l * 3 * FFN2, args.in[I_CONVB] + (size_t)l * FFN2, UH, SS + (size_t)(2 * l + 1) * M, BUP + (size_t)l * 5 * FFN2, (const LAS float*)(lds + pg8::STAGE_BYTES)};
            for (int rep_ = 0; rep_ < REP_UP; ++rep_)
            pg8::gemm_phase<pg8::EpiUpConv, pg8::UpOrder>(lds, wave0, D, D, D, S, E);
        }
#endif
        GRID_BAR();

#if EN_CONV
        {
            PIN_TID();
            const float* cw = args.in[I_CONVW] + (size_t)l * 3 * FFN2; const float* cb = args.in[I_CONVB] + (size_t)l * FFN2;
            for (int rep_ = 0; rep_ < REP_THIN; ++rep_)
            for (int it = gw; it < (M / 256) * 4 * 11; it += NGW) {
                const int pm = it / 44, rem = it - pm * 44, t = rem / 11, cc = rem - t * 11, j0 = cc * 512 + lane * 8;
                const int row = pm * 256 + (t == 0 ? 0 : t == 1 ? 127 : t == 2 ? 128 : 255);
                const int seqmask = row < MP ? (SEQ_P - 1) : (SEQ_S - 1);
                const int sc_ = t == 0 ? 0 : t == 1 ? 3 : t == 2 ? 4 : 7;
                const bool zprev = (t == 0) && ((row & seqmask) == 0), znext = (t == 3) && ((row & seqmask) == seqmask);
                const float* pc = UH + ((size_t)pm * 8 + sc_) * FFN2 + j0;
                const float* pp = (t == 0) ? UH + ((size_t)(pm - 1) * 8 + 7) * FFN2 + j0 : pc - FFN2;
                const float* pn = (t == 3) ? UH + ((size_t)(pm + 1) * 8 + 0) * FFN2 + j0 : pc + FFN2;
                float o[8];
#pragma unroll
                for (int h = 0; h < 2; ++h) {
                    const f32x4 z4 = {0.f, 0.f, 0.f, 0.f};
                    const f32x4 ap = zprev ? z4 : *(const GAS f32x4*)(pp + 4 * h), ac = *(const GAS f32x4*)(pc + 4 * h), an = znext ? z4 : *(const GAS f32x4*)(pn + 4 * h);
                    const f32x4 gp = zprev ? z4 : *(const GAS f32x4*)(pp + FFN + 4 * h), gc = *(const GAS f32x4*)(pc + FFN + 4 * h), gn = znext ? z4 : *(const GAS f32x4*)(pn + FFN + 4 * h);
                    const f32x4 wa0 = *(const GAS f32x4*)(cw + j0 + 4 * h), wa1 = *(const GAS f32x4*)(cw + FFN2 + j0 + 4 * h), wa2 = *(const GAS f32x4*)(cw + 2 * FFN2 + j0 + 4 * h), ba = *(const GAS f32x4*)(cb + j0 + 4 * h);
                    const f32x4 wg0 = *(const GAS f32x4*)(cw + FFN + j0 + 4 * h), wg1 = *(const GAS f32x4*)(cw + FFN2 + FFN + j0 + 4 * h), wg2 = *(const GAS f32x4*)(cw + 2 * FFN2 + FFN + j0 + 4 * h), bg = *(const GAS f32x4*)(cb + FFN + j0 + 4 * h);
#pragma unroll
                    for (int e = 0; e < 4; ++e) { const float A = wa0[e] * ap[e] + wa1[e] * ac[e] + wa2[e] * an[e] + ba[e], Gv = wg0[e] * gp[e] + wg1[e] * gc[e] + wg2[e] * gn[e] + bg[e];
                        o[4 * h + e] = Gv * sigmoidf_fast(Gv) * A; }
                }
                u32x4 w; w.x = cvt_pk_bf16(o[0], o[1]); w.y = cvt_pk_bf16(o[2], o[3]); w.z = cvt_pk_bf16(o[4], o[5]); w.w = cvt_pk_bf16(o[6], o[7]);
                *(GAS u32x4*)(ACT + (size_t)row * FFN + j0) = w;
            }
        }
#endif
        GRID_BAR();

#if EN_DOWN
        {
            OPQ_BX();
            pg8::TileOrder S; S.init(M, D, G, bx, ACT, FFN, wt + WT_DOWN, FFN, X, D, 4); S.split_tail(40, (unsigned*)(ws + WS_CTL) + CW_FLAG + (size_t)l * 128 * 16);
            const int ln = l + 1 < DEPTH ? l + 1 : l;
            pg8::EpiRes E{args.in[I_XP], args.in[I_XS], X, mods_l, 5, false, X, l + 1 < DEPTH, args.in[I_N1G] + (size_t)ln * D, MODS + (size_t)ln * 5 * NMOD * D + 1 * D, SS + (size_t)(2 * ln) * M, HB, (const LAS float*)(lds + pg8::STAGE_BYTES)};
            for (int rep_ = 1; rep_ < REP_DOWN; ++rep_) { pg8::EpiRes E2{args.in[I_XP], args.in[I_XS], X, mods_l, 5, false, (float*)QK, false, nullptr, nullptr, nullptr, nullptr, (const LAS float*)(lds + pg8::STAGE_BYTES)}; pg8::gemm_phase<pg8::EpiRes, pg8::TileOrder>(lds, wave0, FFN, FFN, FFN, S, E2); }
            pg8::gemm_phase<pg8::EpiRes, pg8::TileOrder>(lds, wave0, FFN, FFN, FFN, S, E);
        }
#endif
        GRID_BAR();
    }

#if EN_FINAL
    {
        PIN_TID();
        const float* gvec = args.in[I_NFG];
        for (int row = gw; row < M; row += NGW) {
            float* src = X + (size_t)row * D;
            f32x4 v[8]; float ss = 0.f;
#pragma unroll
            for (int j = 0; j < 8; ++j) { v[j] = *(const f32x4*)(src + 4 * (lane + 64 * j)); ss += (v[j][0] * v[j][0] + v[j][1] * v[j][1]) + (v[j][2] * v[j][2] + v[j][3] * v[j][3]); }
            const float rstd = rsqrtf(wave_sum(ss) * (1.0f / D) + RMS_EPS);
#pragma unroll
            for (int j = 0; j < 8; ++j) { const int col = 4 * (lane + 64 * j); const f32x4 g = *(const f32x4*)(gvec + col); *(f32x4*)(src + col) = (v[j] * rstd) * g; }
        }
    }
#endif
}

extern "C" void kernel_launch(void* const* d_in, const int* in_sizes, int n_in, void* d_out, int out_size, void* d_ws, size_t ws_size, hipStream_t stream) {
    static int grid = 0;
    if (grid == 0) {
        if (n_in != 20 || in_sizes[0] != MP * D || in_sizes[1] != MS * D || ws_size < WS_END) {
            fprintf(stderr, "kernel_launch: shape mismatch: n_in %d in0 %d in1 %d out %d ws %zu (need >= %zu); nothing launched\n", n_in, n_in > 0 ? in_sizes[0] : -1, n_in > 1 ? in_sizes[1] : -1, out_size, ws_size, (size_t)WS_END); grid = -1; return; }
        int dev = 0, cus = 0, per_cu = 0;
        if (hipGetDevice(&dev) != hipSuccess || hipDeviceGetAttribute(&cus, hipDeviceAttributeMultiprocessorCount, dev) != hipSuccess) { fprintf(stderr, "kernel_launch: device query failed\n"); grid = -1; return; }
        if (hipFuncSetAttribute((const void*)fwd, hipFuncAttributeMaxDynamicSharedMemorySize, LDS_BYTES) != hipSuccess) { fprintf(stderr, "kernel_launch: hipFuncSetAttribute failed\n"); grid = -1; return; }
        if (hipOccupancyMaxActiveBlocksPerMultiprocessor(&per_cu, (const void*)fwd, NTHREADS, LDS_BYTES) != hipSuccess || per_cu < 1)
            fprintf(stderr, "kernel_launch: note: occupancy query reports %d workgroups per CU\n", per_cu);
        (void)hipGetLastError();
        grid = cus;
    }
    if (grid < 0) return;
    if (hipMemsetAsync((char*)d_ws + WS_CTL, 0, CTL_ZERO_BYTES, stream) != hipSuccess) { fprintf(stderr, "kernel_launch: memset failed\n"); return; }
    Args a{};
    for (int i = 0; i < 20; ++i) a.in[i] = (const float*)d_in[i];
    a.out = (float*)d_out; a.ws = (unsigned char*)d_ws;
    hipLaunchKernelGGL(fwd, dim3(grid), dim3(NTHREADS), LDS_BYTES, stream, a);
    const hipError_t le = hipPeekAtLastError();
    if (le != hipSuccess) fprintf(stderr, "kernel_launch: launch failed: %s\n", hipGetErrorName(le));
}
```

```cpp
#include <hip/hip_runtime.h>
#include <cstdio>
#include <cstdint>

#define GAS __attribute__((address_space(1)))
#define LAS __attribute__((address_space(3)))
typedef unsigned short bf16_t;
typedef short bf16x8 __attribute__((ext_vector_type(8)));
typedef short s16x4 __attribute__((ext_vector_type(4)));
typedef float f32x4 __attribute__((ext_vector_type(4)));
typedef float f32x2 __attribute__((ext_vector_type(2)));
typedef float f32x16 __attribute__((ext_vector_type(16)));
typedef unsigned u32x4 __attribute__((ext_vector_type(4)));
typedef unsigned u32x2 __attribute__((ext_vector_type(2)));

#ifndef EN_MODS
#define EN_MODS 1
#endif
#ifndef EN_WT
#define EN_WT 1
#endif
#ifndef EN_MISC
#define EN_MISC 1
#endif
#ifndef EN_NORM
#define EN_NORM 1
#endif
#ifndef EN_GIN
#define EN_GIN 1
#endif
#ifndef EN_ATT
#define EN_ATT 1
#endif
#ifndef EN_F1
#define EN_F1 1
#endif
#ifndef EN_F2
#define EN_F2 1
#endif
#ifndef EN_PAB
#define EN_PAB 1
#endif
#ifndef EN_OUT
#define EN_OUT 1
#endif
#ifndef EN_UP
#define EN_UP 1
#endif
#ifndef EN_CONV
#define EN_CONV 1
#endif
#ifndef EN_DOWN
#define EN_DOWN 1
#endif
#ifndef EN_FINAL
#define EN_FINAL 1
#endif
#ifndef REP_P0
#define REP_P0 1
#endif
#ifndef FOUR_MERGE
#define FOUR_MERGE 0
#endif
#ifndef FOUR_KEEPBAR
#define FOUR_KEEPBAR 0
#endif
#ifndef REP_ATT
#define REP_ATT 1
#endif
#ifndef REP_THIN
#define REP_THIN 1
#endif
#ifndef REP_GIN
#define REP_GIN 1
#endif
#ifndef REP_BAR
#define REP_BAR 1
#endif
#ifndef REP_OUT
#define REP_OUT 1
#endif
#ifndef REP_DOWN
#define REP_DOWN 1
#endif
#ifndef REP_PAB
#define REP_PAB 1
#endif
#ifndef REP_FOUR
#define REP_FOUR 1
#endif
#ifndef REP_UP
#define REP_UP 1
#endif
constexpr int D = 2048, NB_P = 16, SEQ_P = 256, DEPTH = 4, NB_S = 4, SEQ_S = 4096, PAST = 256;
constexpr int MP = NB_P * SEQ_P;
constexpr int MS = NB_S * SEQ_S;
constexpr int M = MP + MS;
constexpr int NH = 8, HD = 128, AD = 1024, FD = 1024, FFN = 5632, FFN2 = 11264, IN_DIM = 8192, NMOD = 6;
constexpr int GW = 64;
constexpr float RMS_EPS = 1e-6f;
constexpr float QSCALE = 0.08838834764831845f * 1.4426950408889634f;
constexpr float LOG2E = 1.4426950408889634f;

constexpr size_t MiB = 1u << 20;
constexpr size_t WS_CTL = 0, CTL_ZERO_BYTES = 2 * MiB;
constexpr size_t WS_SS = 1 * MiB;
constexpr size_t WS_MODS = 2 * MiB;
constexpr size_t WS_BIAS = 3 * MiB;
constexpr size_t WS_CACHE = 5 * MiB;
constexpr size_t WS_DC = 21 * MiB;
constexpr size_t WS_DP = WS_DC + 256 * 1024;
constexpr size_t WS_DS = WS_DP + 256 * 1024;
constexpr size_t WS_UP2 = 22 * MiB;
constexpr size_t WS_WT = 86 * MiB;
constexpr size_t WT_IN = 0, WT_PA = (size_t)IN_DIM * D * 2, WT_PB = WT_PA + (size_t)D * AD * 2, WT_OUT = WT_PB + (size_t)D * FD * 2,
                 WT_UP = WT_OUT + (size_t)D * D * 2, WT_DOWN = WT_UP + (size_t)FFN2 * D * 2, WT_LAYER = WT_DOWN + (size_t)D * FFN * 2;
static_assert(WT_LAYER == 114 * MiB, "weight copy size");
constexpr size_t WS_H = WS_WT + 4 * WT_LAYER;
constexpr size_t WS_BIG = WS_H + 80 * MiB;
constexpr size_t WS_UH = WS_BIG + 320 * MiB;
constexpr size_t WS_AF = WS_BIG + 440 * MiB;
constexpr size_t WS_GTS = WS_AF + 80 * MiB;
constexpr size_t WS_GTP = WS_GTS + 64 * MiB;
constexpr size_t WS_T1 = WS_GTP + 16 * MiB;
constexpr size_t WS_ACT = WS_AF;
constexpr size_t WS_Y = WS_T1 + 160 * MiB;
constexpr size_t WS_END = WS_Y + 80 * MiB;
static_assert(WS_END <= 1536 * MiB, "workspace map");
static_assert((size_t)M * FFN * 2 <= 320 * MiB, "act overlay");

constexpr int CW_FLAG = 65536;
constexpr int CW_FOUR = 131072;
constexpr int CW_PANEL = 98304;
constexpr int CW_XRANK = 32768;
constexpr int CW_BAR = 4096;

constexpr int LDS_BYTES = 163840;
constexpr int MISC_OFF = LDS_BYTES - 256;
constexpr int NWAVES = 8, NTHREADS = 512;

#define LDS_WAIT() asm volatile("s_waitcnt lgkmcnt(0)" ::: "memory")
#define VM_WAIT() asm volatile("s_waitcnt vmcnt(0)" ::: "memory")
__device__ __forceinline__ unsigned cvt_pk_bf16(float lo, float hi) { unsigned r; asm volatile("v_cvt_pk_bf16_f32 %0, %1, %2" : "=v"(r) : "v"(lo), "v"(hi)); return r; }
__device__ __forceinline__ float bf_lo(unsigned w) { return __uint_as_float(w << 16); }
__device__ __forceinline__ float bf_hi(unsigned w) { return __uint_as_float(w & 0xffff0000u); }
__device__ __forceinline__ float sigmoidf_fast(float x) { return __builtin_amdgcn_rcpf(1.0f + __expf(-x)); }
template <int CTRL> __device__ __forceinline__ float dpp_add(float v) { return v + __int_as_float(__builtin_amdgcn_update_dpp(0, __float_as_int(v), CTRL, 0xf, 0xf, true)); }
__device__ __forceinline__ float wave_sum(float v) {
    v = dpp_add<0xB1>(v);
    v = dpp_add<0x4E>(v);
    v = dpp_add<0x141>(v);
    v = dpp_add<0x140>(v);
    const float s0 = __int_as_float(__builtin_amdgcn_readlane(__float_as_int(v), 0)), s1 = __int_as_float(__builtin_amdgcn_readlane(__float_as_int(v), 16));
    const float s2 = __int_as_float(__builtin_amdgcn_readlane(__float_as_int(v), 32)), s3 = __int_as_float(__builtin_amdgcn_readlane(__float_as_int(v), 48));
    return (s0 + s1) + (s2 + s3);
}
__device__ __forceinline__ int fresh_wave(int w) { asm volatile("; opaque wave index" : "+s"(w)); return w; }
__device__ __forceinline__ int fresh_lane() { int l; asm volatile("v_mbcnt_lo_u32_b32 %0, -1, 0\n\tv_mbcnt_hi_u32_b32 %0, -1, %0" : "=v"(l)); return l; }

#define XB_TMO      128
#define XB_XCNT(j)  (256  + 64 * (j))
#define XB_XSUB(j)  (1280 + 64 * (j))
#define XB_XGEN(j)  (2304 + 64 * (j))
#define XB_TOP      3328
#define XB_TOPGEN   3392
#define XCD_BAR_WORDS 3456
#define XB_SPIN_CAP (1u << 18)
__device__ __forceinline__ unsigned xb_ld(unsigned* p)              { return __hip_atomic_load((GAS unsigned*)p, __ATOMIC_RELAXED, __HIP_MEMORY_SCOPE_AGENT); }
__device__ __forceinline__ unsigned xb_add(unsigned* p, unsigned v) { return __hip_atomic_fetch_add((GAS unsigned*)p, v, __ATOMIC_RELAXED, __HIP_MEMORY_SCOPE_AGENT); }
__device__ __forceinline__ unsigned xb_xcc_id() { return (unsigned)__builtin_amdgcn_s_getreg((3 << 11) | 20) & 0xFu; }
#define XB_SPIN(cond, bar) do { unsigned _sp = 0; while (cond) { __builtin_amdgcn_s_sleep(1); \
    if ((++_sp & 255u) == 0u) { if (xb_ld(&(bar)[XB_TMO])) break; if (_sp > XB_SPIN_CAP) { xb_add(&(bar)[XB_TMO], 1u); break; } } } } while (0)
struct XcdBarrier { unsigned* bar; unsigned x; volatile LAS unsigned* st; };
__device__ __forceinline__ XcdBarrier xcd_barrier_post(unsigned* bar, volatile LAS unsigned* st) {
    XcdBarrier b; b.bar = bar; b.x = xb_xcc_id(); b.st = st;
    if (threadIdx.x == 0) (void)xb_add(&bar[XB_XCNT(b.x)], 1u);
    return b;
}
__device__ __forceinline__ void xcd_barrier_complete(unsigned* bar, unsigned x, unsigned& nloc, unsigned& nx) {
    const unsigned G = gridDim.x * gridDim.y * gridDim.z;
    unsigned sum, cnt, mine, sp = 0u;
    for (;;) {
        sum = 0u; cnt = 0u; mine = 0u;
#pragma unroll
        for (unsigned j = 0; j < 16; ++j) { const unsigned c = xb_ld(&bar[XB_XCNT(j)]); sum += c; cnt += (c > 0u) ? 1u : 0u; mine = (j == x) ? c : mine; }
        if (sum == G) break;
        __builtin_amdgcn_s_sleep(1);
        if ((++sp & 255u) == 0u) { if (xb_ld(&bar[XB_TMO])) break; if (sp > XB_SPIN_CAP) { xb_add(&bar[XB_TMO], 1u); break; } }
    }
    nloc = mine > 0u ? mine : 1u; nx = cnt > 0u ? cnt : 1u;
}
__device__ __forceinline__ void xcd_barrier(const XcdBarrier& b, const bool leader_thread) {
    asm volatile("s_waitcnt vmcnt(0)" ::: "memory");
    __syncthreads();
    if (leader_thread) {
        unsigned* bar = b.bar;
        __builtin_amdgcn_s_waitcnt(0);
        unsigned nloc = b.st[0], nx = b.st[1];
        if (nloc == 0u) { xcd_barrier_complete(bar, b.x, nloc, nx); b.st[0] = nloc; b.st[1] = nx; }
        const unsigned old = xb_add(&bar[XB_XSUB(b.x)], 1u);
        const unsigned gen = old / nloc;
        if (old + 1u == (gen + 1u) * nloc) {
            __builtin_amdgcn_fence(__ATOMIC_RELEASE, "agent");
            asm volatile("s_waitcnt vmcnt(0)" ::: "memory");
            const unsigned og = xb_add(&bar[XB_TOP], 1u);
            const unsigned tg = og / nx;
            if (og + 1u == (tg + 1u) * nx) xb_add(&bar[XB_TOPGEN], 1u);
            else XB_SPIN(xb_ld(&bar[XB_TOPGEN]) == tg, bar);
            __builtin_amdgcn_fence(__ATOMIC_ACQUIRE, "agent");
            xb_add(&bar[XB_XGEN(b.x)], 1u);
            asm volatile("s_waitcnt vmcnt(0)" ::: "memory");
        } else {
            XB_SPIN(xb_ld(&bar[XB_XGEN(b.x)]) == gen, bar);
            __builtin_amdgcn_fence(__ATOMIC_ACQUIRE, "agent");
            asm volatile("s_waitcnt vmcnt(0)" ::: "memory");
        }
    }
    __syncthreads();
}

namespace pg8 {
constexpr int BM = 256, BK = 64, HALF = 128, HTB = HALF * BK * 2, STAGE_BYTES = 8 * HTB, NXCD = 8, WGM = 8;
__host__ __device__ __forceinline__ int lds_byte(int r, int c) { const int st = (r >> 4) * 2 + (c >> 5), rr = r & 15, cc = c & 31, ob = rr * 64 + cc * 2; return st * 1024 + (ob ^ (((ob >> 9) & 1) << 5)); }
__host__ __device__ __forceinline__ void stage_rc(int b, int& R, int& C) { const int st = b / 1024, sb = b % 1024, swz = sb ^ (((sb >> 9) & 1) << 5); R = (st >> 1) * 16 + swz / 64; C = (st & 1) * 32 + (swz % 64) / 2; }
__host__ __device__ __forceinline__ int perm32(int rho) { const int n = rho >> 4, i = rho & 15; return 8 * (i >> 2) + 4 * n + (i & 3); }

struct Unit { const char* a; const char* b; char* c; int pm, pn, hm; };

struct TileOrder {
    static constexpr int BH_ROWS = 128; static constexpr bool KSPLIT = true, MERGED = false;
    int nM, nN, nwg, G, c; const char* A; const char* B; char* C; size_t astep, bstep, cstep; int ldc, cesz; int tail, ktp; size_t khalf; unsigned* flags;
    __device__ __forceinline__ void init(int M_, int N_, int G_, int c_, const void* A_, int lda, const void* B_, int ldb, void* C_, int ldc_, int cesz_) {
        nM = M_ / BM; nN = N_ / BM; nwg = nM * nN; G = G_; c = c_; A = (const char*)A_; B = (const char*)B_; C = (char*)C_;
        astep = (size_t)BM * lda * 2; bstep = (size_t)BM * ldb * 2; ldc = ldc_; cesz = cesz_; cstep = (size_t)BM * ldc_ * cesz_; tail = 0; ktp = 0; khalf = 0; flags = nullptr;
    }
    __device__ __forceinline__ void half_tail() { if (G == 256 && nwg == 640) tail = 1; }
    __device__ __forceinline__ void split_tail(int ktp_, unsigned* flags_) { if (G == 256 && nwg == 640) { tail = 2; ktp = ktp_; khalf = (size_t)ktp_ * (BK * 2); flags = flags_; } }
    __device__ __forceinline__ bool next(int i, Unit& u) const {
        int wgid; u.hm = 0;
        if (tail && i >= 2) { if (i > 2) return false;
            const int xcd = c % NXCD, k = c / NXCD, j = k >> 1; wgid = xcd * (nwg / NXCD) + 64 + j;
            u.hm = (tail == 1) ? 1 + (k & 1) : ((3 + (k & 1)) | ((xcd * 16 + j) << 4)); }
        else { const long L = (long)i * G + c; if (L >= nwg) return false;
            wgid = (int)L; { const int q = nwg / NXCD, r = nwg % NXCD, xcd = wgid % NXCD, off = wgid / NXCD; wgid = (xcd < r ? xcd * (q + 1) : r * (q + 1) + (xcd - r) * q) + off; } }
        const int nig = WGM * nN, gid = wgid / nig, fm = gid * WGM, gsz = (nM - fm) < WGM ? (nM - fm) : WGM;
        u.pm = fm + ((wgid % nig) % gsz); u.pn = (wgid % nig) / gsz;
        const size_t ko = ((u.hm & 15) == 4) ? khalf : 0;
        u.a = A + (size_t)u.pm * astep + ((u.hm & 15) == 2 ? astep / 2 : 0) + ko; u.b = B + (size_t)u.pn * bstep + ko; u.c = C + (size_t)u.pm * cstep + (size_t)u.pn * BM * cesz;
        return true;
    }
};

template <class Epi, class Sched, bool ALIGN_EPI = true>
__device__ __forceinline__ void gemm_phase(LAS unsigned char* lds, const int wave0, const int lda, const int ldb, const int K, const Sched& S, const Epi& E) {
    const int lane = fresh_lane(), wid = fresh_wave(wave0), tid = wid * 64 + lane, wr = wid >> 2, wc = wid & 3, fr = lane & 15, fq = lane >> 4;
    const int nt = K / BK;
    unsigned voffA[2], voffB[2];
#pragma unroll
    for (int i = 0; i < 2; ++i) { int R, C; stage_rc(tid * 16 + i * 8192, R, C); const int Rb = Epi::PERM ? ((R & ~31) + perm32(R & 31)) : R;
        const int Ra = Epi::APERM ? (8 * (16 * (R >> 6) + (R & 15)) + ((R >> 4) & 3)) : R;
        voffA[i] = (unsigned)(Ra * lda + C) * 2u; voffB[i] = (unsigned)(Rb * ldb + C) * 2u; }
    const size_t kstep = (size_t)(BK * 2);
    const size_t hstepA = (size_t)(Epi::APERM ? 4 : HALF) * lda * 2, hstepB = (size_t)Sched::BH_ROWS * ldb * 2;
    const unsigned ldsw = (unsigned)wid * 1024u;
    const int aoff = lds_byte(wr * 64 + fr, fq * 8), boff = lds_byte(wc * 32 + fr, fq * 8);
#define PG8_SA(b, h) (((b) * 2 + (h)) * HTB)
#define PG8_SB(b, h) ((4 + (b) * 2 + (h)) * HTB)
#ifndef PG8_AUX_A
#define PG8_AUX_A 0
#endif
#ifndef PG8_AUX_B
#define PG8_AUX_B 0
#endif
#define PG8_STAGE(bufoff, gbase, voff) do { const GAS char* gb_ = (const GAS char*)(gbase); asm("" : "+s"(gb_));   _Pragma("unroll") for (int _i = 0; _i < 2; ++_i) { asm("" : "+v"((voff)[_i]));   \
        __builtin_amdgcn_global_load_lds((const GAS unsigned*)(gb_ + (voff)[_i]), (LAS unsigned*)(lds + (bufoff) + ldsw + _i * 8192), 16, 0, PG8_AUX_A); } } while (0)
#define PG8_STAGEB(bufoff, gbase, voff) do { const GAS char* gb_ = (const GAS char*)(gbase); asm("" : "+s"(gb_));   _Pragma("unroll") for (int _i = 0; _i < 2; ++_i) { asm("" : "+v"((voff)[_i]));   \
        __builtin_amdgcn_global_load_lds((const GAS unsigned*)(gb_ + (voff)[_i]), (LAS unsigned*)(lds + (bufoff) + ldsw + _i * 8192), 16, 0, PG8_AUX_B); } } while (0)
#define PG8_LDA(dst, b, h) do { _Pragma("unroll") for (int m = 0; m < 4; ++m) _Pragma("unroll") for (int k = 0; k < 2; ++k) dst[m][k] = *(const LAS bf16x8*)(lds + PG8_SA(b, h) + aoff + m * 2048 + k * 1024); } while (0)
#define PG8_LDB(dst, b, h) do { _Pragma("unroll") for (int n = 0; n < 2; ++n) _Pragma("unroll") for (int k = 0; k < 2; ++k) dst[n][k] = *(const LAS bf16x8*)(lds + PG8_SB(b, h) + boff + n * 2048 + k * 1024); } while (0)
#define PG8_MMA(ai, bj, At, Bt) do { __builtin_amdgcn_s_setprio(1); _Pragma("unroll") for (int m = 0; m < 4; ++m) _Pragma("unroll") for (int n = 0; n < 2; ++n) _Pragma("unroll") for (int k = 0; k < 2; ++k) \
        acc[ai][bj][m][n] = __builtin_amdgcn_mfma_f32_16x16x32_bf16(Bt[n][k], At[m][k], acc[ai][bj][m][n], 0, 0, 0); __builtin_amdgcn_s_setprio(0); } while (0)
#define PG8_WAIT_V(n) asm volatile("s_waitcnt vmcnt(" #n ")" ::: "memory")
#define PG8_WAIT_L(n) asm volatile("s_waitcnt lgkmcnt(" #n ")" ::: "memory")
#define PG8_BAR __builtin_amdgcn_s_barrier()
#define PG8_SCHED __builtin_amdgcn_sched_barrier(0)
    Unit cur, nxt; int ui = 0;
    if (!S.next(0, cur)) return;
    f32x4 acc[2][2][4][2];
#pragma unroll
    for (int a = 0; a < 2; ++a)
#pragma unroll
        for (int b = 0; b < 2; ++b)
#pragma unroll
            for (int m = 0; m < 4; ++m)
#pragma unroll
                for (int n = 0; n < 2; ++n) acc[a][b][m][n] = (f32x4){0.f, 0.f, 0.f, 0.f};
    bf16x8 At[4][2], B0[2][2], B1[2][2];
    const char* cA = cur.a; const char* cB = cur.b;
    if constexpr (Sched::MERGED) { if constexpr (Sched::WAIT_FIRST) { if (S.needs_wait(cur)) { S.wait_panel(cur, wid); PG8_BAR; } } }
    PG8_STAGEB(PG8_SB(0, 0), cB, voffB); PG8_STAGEB(PG8_SB(0, 1), cB + hstepB, voffB); PG8_STAGE(PG8_SA(0, 0), cA, voffA); PG8_STAGE(PG8_SA(0, 1), cA + hstepA, voffA);
    if (wr == 1) PG8_BAR;
    PG8_WAIT_V(2); PG8_BAR;
    PG8_STAGEB(PG8_SB(1, 0), cB + kstep, voffB); PG8_STAGE(PG8_SA(1, 0), cA + kstep, voffA); PG8_STAGEB(PG8_SB(1, 1), cB + hstepB + kstep, voffB);
    PG8_WAIT_V(6); PG8_BAR;
    for (;;) {
        const bool has_next = S.next(ui + 1, nxt);
        const char* nA = has_next ? nxt.a : cA; const char* nB = has_next ? nxt.b : cB;
        const int hmode = cur.hm & 15;
        const bool full = (hmode == 0) || (hmode >= 3);
        int unt = nt; if constexpr (Sched::KSPLIT) { if (hmode == 3) unt = S.ktp; else if (hmode == 4) unt = nt - S.ktp; }
        float pf = 0.f;
        for (int t = 0; t < unt; t += 2) {
            const bool last = (t == unt - 2);
            const char* a1 = cA + (size_t)(t + 1) * kstep;
            const char* a2 = last ? nA : cA + (size_t)(t + 2) * kstep; const char* b2 = last ? nB : cB + (size_t)(t + 2) * kstep;
            const char* a3 = a2 + kstep; const char* b3 = b2 + kstep;
            if constexpr (Sched::MERGED) { if (last && has_next && S.needs_wait(nxt)) { S.wait_panel(nxt, wid); PG8_BAR; } }
            if constexpr (Epi::MIDK > 0) { if (t == Epi::MIDK) E.mid(acc, cur, wid); }
            if constexpr (Epi::PREF) { if (last) pf = E.prefetch(cur, tid); }
            PG8_LDB(B0, 0, 0); PG8_LDB(B1, 0, 1); PG8_SCHED; PG8_LDA(At, 0, 0); PG8_STAGE(PG8_SA(1, 1), a1 + hstepA, voffA);
            PG8_WAIT_V(8); PG8_WAIT_L(0); PG8_BAR; PG8_MMA(0, 0, At, B0); PG8_MMA(0, 1, At, B1); PG8_BAR; PG8_SCHED;
            if (full) PG8_LDA(At, 0, 1); PG8_STAGEB(PG8_SB(0, 0), b2, voffB); PG8_STAGEB(PG8_SB(0, 1), b2 + hstepB, voffB); PG8_STAGE(PG8_SA(0, 0), a2, voffA);
            PG8_WAIT_V(8); PG8_WAIT_L(0); PG8_BAR; if (full) { PG8_MMA(1, 0, At, B0); PG8_MMA(1, 1, At, B1); } PG8_BAR; PG8_SCHED;
            PG8_LDB(B0, 1, 0); PG8_LDB(B1, 1, 1); PG8_SCHED; PG8_LDA(At, 1, 0); PG8_STAGE(PG8_SA(0, 1), a2 + hstepA, voffA);
            PG8_WAIT_V(8); PG8_WAIT_L(0); PG8_BAR; PG8_MMA(0, 0, At, B0); PG8_MMA(0, 1, At, B1); PG8_BAR; PG8_SCHED;
            if (full) PG8_LDA(At, 1, 1); PG8_STAGEB(PG8_SB(1, 0), b3, voffB); PG8_STAGEB(PG8_SB(1, 1), b3 + hstepB, voffB); PG8_STAGE(PG8_SA(1, 0), a3, voffA);
            PG8_WAIT_V(8); PG8_WAIT_L(0); PG8_BAR; if (full) { PG8_MMA(1, 0, At, B0); PG8_MMA(1, 1, At, B1); } PG8_BAR; PG8_SCHED;
        }
        if constexpr (ALIGN_EPI) { if (wr == 0) PG8_BAR; }
        if constexpr (Epi::PREF) { static_assert(ALIGN_EPI, "the side-buffer exchange needs both halves in the epilogue together");
            *(LAS float*)(lds + STAGE_BYTES + tid * 4) = pf; PG8_WAIT_L(0); PG8_BAR; }
        if constexpr (Sched::KSPLIT) {
            if (hmode == 3) {
                E.produce(acc, cur, wid);
                PG8_WAIT_V(0); PG8_BAR;
                if (wid == 0 && fresh_lane() == 0) __hip_atomic_store((GAS unsigned*)(S.flags + (size_t)(cur.hm >> 4) * 16), 1u, __ATOMIC_RELAXED, __HIP_MEMORY_SCOPE_AGENT);
            } else {
                if (hmode == 4) {
                    if (wid == 0) { GAS unsigned* fp = (GAS unsigned*)(S.flags + (size_t)(cur.hm >> 4) * 16); unsigned sp = 0;
                        while ((unsigned)__builtin_amdgcn_readfirstlane(__hip_atomic_load(fp, __ATOMIC_RELAXED, __HIP_MEMORY_SCOPE_AGENT)) != 1u) { __builtin_amdgcn_s_sleep(2); if (++sp > (1u << 20)) break; }
                        __builtin_amdgcn_fence(__ATOMIC_ACQUIRE, "agent"); PG8_WAIT_V(0); }
                    PG8_BAR;
                }
                E(acc, cur, wid);
            }
        } else { E(acc, cur, wid);
            if constexpr (Sched::MERGED) { if (S.publishes(cur)) { PG8_WAIT_V(0); if (fresh_lane() == 0) S.publish(cur); } } }
        if (!has_next) break;
#pragma unroll
        for (int a = 0; a < 2; ++a)
#pragma unroll
            for (int b = 0; b < 2; ++b)
#pragma unroll
                for (int m = 0; m < 4; ++m)
#pragma unroll
                    for (int n = 0; n < 2; ++n) acc[a][b][m][n] = (f32x4){0.f, 0.f, 0.f, 0.f};
        cur = nxt; cA = nA; cB = nB; ++ui;
        if constexpr (ALIGN_EPI) { if (wr == 1) PG8_BAR; }
    }
    PG8_WAIT_V(0);
    if constexpr (!ALIGN_EPI) { if (wr == 0) PG8_BAR; }
    PG8_BAR;
#undef PG8_SA
#undef PG8_SB
#undef PG8_STAGE
#undef PG8_STAGEB
#undef PG8_LDA
#undef PG8_LDB
#undef PG8_MMA
#undef PG8_WAIT_V
#undef PG8_WAIT_L
#undef PG8_BAR
#undef PG8_SCHED
}

typedef f32x4 Acc[2][2][4][2];
constexpr int STG_OFF = STAGE_BYTES + 8192, STG_WAVE = 2560, STG_PITCH = 144;
struct Stage64 {
    LAS char* stg; unsigned sw, sr;
    __device__ __forceinline__ Stage64(const LAS float* side, const int wid, const int lane) { stg = (LAS char*)side + (STG_OFF - STAGE_BYTES) + wid * STG_WAVE; sw = (unsigned)((lane & 15) * 80 + (lane >> 4) * 16); sr = (unsigned)((lane >> 2) * 80 + (lane & 3) * 16); }
    __device__ __forceinline__ void put(const int slot, const u32x4 w) const { *(LAS u32x4*)(stg + slot * 1280 + sw) = w; }
    __device__ __forceinline__ u32x4 get(const int slot) const { return *(const LAS u32x4*)(stg + slot * 1280 + sr); }
};
template <int CTRL> __device__ __forceinline__ float dpp_mov(float v) { return __int_as_float(__builtin_amdgcn_update_dpp(0, __float_as_int(v), CTRL, 0xf, 0xf, true)); }

template <int LDC> struct EpiBf16U {
    static constexpr bool PERM = true, APERM = false; static constexpr int MIDK = 0; static constexpr bool PREF = false;
    const LAS float* side;
    __device__ __forceinline__ void operator()(const Acc& acc, const Unit& u, const int wid) const {
        const int lane = fresh_lane(), wr = wid >> 2, wc = wid & 3;
        const Stage64 T(side, wid, lane);
        const unsigned loff = (unsigned)((wr * 64 + (lane >> 2)) * LDC + wc * 32 + 8 * (lane & 3)) * 2u;
#pragma unroll
        for (int ai = 0; ai < 2; ++ai)
#pragma unroll
            for (int m = 0; m < 4; ++m) { char* rowp = u.c + (size_t)(ai * HALF + m * 16) * LDC * 2; asm("" : "+s"(rowp));
#pragma unroll
                for (int bj = 0; bj < 2; ++bj) { const f32x4 v0 = acc[ai][bj][m][0], v1 = acc[ai][bj][m][1];
                    u32x4 w; w.x = cvt_pk_bf16(v0[0], v0[1]); w.y = cvt_pk_bf16(v0[2], v0[3]); w.z = cvt_pk_bf16(v1[0], v1[1]); w.w = cvt_pk_bf16(v1[2], v1[3]);
                    T.put(bj, w); }
                asm volatile("" ::: "memory");
                const u32x4 r0 = T.get(0), r1 = T.get(1);
                asm volatile("" ::: "memory");
                *(GAS u32x4*)(rowp + loff) = r0; *(GAS u32x4*)(rowp + loff + HALF * 2) = r1; }
    }
};
struct EpiIn {
    static constexpr bool PERM = true, APERM = false; static constexpr int MIDK = 0; static constexpr bool PREF = true;
    float* outk; float* outv; int layer; const float* ss; const float* bias; const LAS float* side;
    __device__ __forceinline__ void produce(const Acc&, const Unit&, const int) const {}
    __device__ __forceinline__ float prefetch(const Unit& u, const int tid) const {
        const int bv = u.pm < NB_P ? 0 : 1 + ((u.pm - NB_P) >> 4);
        const float* p = tid < 256 ? ss + (size_t)u.pm * BM + tid : bias + (size_t)bv * IN_DIM + u.pn * BM + (tid - 256);
        return *(const GAS float*)p;
    }
    __device__ __forceinline__ void operator()(const Acc& acc, const Unit& u, const int wid) const {
        const int lane = fresh_lane(), wr = wid >> 2, wc = wid & 3, fr = lane & 15, fq = lane >> 4;
        const bool sig = u.pn >= 16, kv = (u.pm < NB_P) && (u.pn >= 4) && (u.pn < 12);
        const int r0 = wr * 64 + fr, c0 = wc * 32 + 8 * fq;
        const unsigned loff = (unsigned)((wr * 64 + (lane >> 2)) * IN_DIM + wc * 32 + 8 * (lane & 3)) * 2u, koff = (unsigned)((wr * 64 + (lane >> 3)) * HD + wc * 32 + 4 * (lane & 7)) * 4u;
        const Stage64 T(side, wid, lane);
        const unsigned ksw = (unsigned)(fr * STG_PITCH + fq * 32), ksr = (unsigned)((lane >> 3) * STG_PITCH + (lane & 7) * 16);
        float rstd[2][4]; f32x4 bb[2][2];
        {
#pragma unroll
          for (int ai = 0; ai < 2; ++ai)
#pragma unroll
              for (int m = 0; m < 4; ++m) rstd[ai][m] = side[r0 + ai * HALF + m * 16];
#pragma unroll
          for (int bj = 0; bj < 2; ++bj)
#pragma unroll
              for (int n = 0; n < 2; ++n) bb[bj][n] = *(const LAS f32x4*)(side + 256 + c0 + bj * HALF + 4 * n);
#pragma unroll
          for (int ai = 0; ai < 2; ++ai)
#pragma unroll
              for (int m = 0; m < 4; ++m) rstd[ai][m] = rsqrtf(rstd[ai][m] * (1.0f / D) + RMS_EPS); }
#pragma unroll
        for (int ai = 0; ai < 2; ++ai)
#pragma unroll
            for (int m = 0; m < 4; ++m) { char* rowp = u.c + (size_t)(ai * HALF + m * 16) * IN_DIM * 2; asm("" : "+s"(rowp));
                f32x4 vv[2][2];
#pragma unroll
                for (int bj = 0; bj < 2; ++bj) { f32x4 v0 = acc[ai][bj][m][0] * rstd[ai][m] + bb[bj][0], v1 = acc[ai][bj][m][1] * rstd[ai][m] + bb[bj][1];
                    if (sig) {
#pragma unroll
                        for (int j = 0; j < 4; ++j) { v0[j] = sigmoidf_fast(v0[j]); v1[j] = sigmoidf_fast(v1[j]); } }
                    u32x4 w; w.x = cvt_pk_bf16(v0[0], v0[1]); w.y = cvt_pk_bf16(v0[2], v0[3]); w.z = cvt_pk_bf16(v1[0], v1[1]); w.w = cvt_pk_bf16(v1[2], v1[3]);
                    T.put(bj, w); vv[bj][0] = v0; vv[bj][1] = v1; }
                asm volatile("" ::: "memory");
                const u32x4 q0 = T.get(0), q1 = T.get(1);
                asm volatile("" ::: "memory");
                if (kv) {
#pragma unroll
                    for (int bj = 0; bj < 2; ++bj) { const int colt = u.pn * BM + bj * HALF; const bool isv = colt >= 2048; const int head = (colt - (isv ? 2048 : 1024)) >> 7;
                        char* dst = (char*)((isv ? outv : outk) + ((((size_t)u.pm * DEPTH + layer) * NH + head) * SEQ_P + (ai * HALF + m * 16)) * HD); asm("" : "+s"(dst));
                        *(LAS f32x4*)(T.stg + ksw) = vv[bj][0]; *(LAS f32x4*)(T.stg + ksw + 16) = vv[bj][1];
                        asm volatile("" ::: "memory");
                        const f32x4 a0 = *(const LAS f32x4*)(T.stg + ksr), a1 = *(const LAS f32x4*)(T.stg + ksr + 8 * STG_PITCH);
                        asm volatile("" ::: "memory");
                        *(GAS f32x4*)(dst + koff) = a0; *(GAS f32x4*)(dst + koff + 8 * HD * 4) = a1; } }
                *(GAS u32x4*)(rowp + loff) = q0; *(GAS u32x4*)(rowp + loff + HALF * 2) = q1; }
    }
};
struct EpiPab {
    static constexpr bool PERM = true, APERM = false; static constexpr int MIDK = 16; static constexpr bool PREF = false;
    const bf16_t* G; bf16_t* Y; const LAS float* side;
    __device__ __forceinline__ void produce(const Acc&, const Unit&, const int) const {}
    __device__ __forceinline__ void mid(Acc& acc, const Unit& u, const int wid) const {
        const int lane = fresh_lane(), wr = wid >> 2, wc = wid & 3, fr = lane & 15, fq = lane >> 4;
        const unsigned goff = (unsigned)((wr * 64 + fr) * IN_DIM + wc * 32 + 8 * fq) * 2u;
        const int hb = (u.hm & 15) == 2 ? HALF : 0, na = ((u.hm & 15) == 1 || (u.hm & 15) == 2) ? 1 : 2;
#pragma unroll
        for (int ai = 0; ai < 2; ++ai) if (ai < na) {
#pragma unroll
            for (int mp = 0; mp < 2; ++mp) {
                u32x4 ga[2][2], gb[2][2];
#pragma unroll
                for (int mm = 0; mm < 2; ++mm) { const int m = 2 * mp + mm; const char* gp = (const char*)(G + (size_t)(u.pm * BM + hb + ai * HALF + m * 16) * IN_DIM + 4096 + u.pn * BM); asm("" : "+s"(gp));
#pragma unroll
                    for (int bj = 0; bj < 2; ++bj) { ga[mm][bj] = *(const GAS u32x4*)(gp + goff + bj * HALF * 2); gb[mm][bj] = *(const GAS u32x4*)(gp + goff + bj * HALF * 2 + 2048 * 2); } }
                asm volatile("" ::: "memory");
#pragma unroll
                for (int mm = 0; mm < 2; ++mm)
#pragma unroll
                    for (int bj = 0; bj < 2; ++bj)
#pragma unroll
                        for (int j = 0; j < 4; ++j) { const int m = 2 * mp + mm;
                            const float r0 = bf_lo(ga[mm][bj][j]) * __builtin_amdgcn_rcpf(fmaxf(bf_lo(gb[mm][bj][j]), 1e-30f)), r1 = bf_hi(ga[mm][bj][j]) * __builtin_amdgcn_rcpf(fmaxf(bf_hi(gb[mm][bj][j]), 1e-30f));
                            acc[ai][bj][m][j >> 1][2 * (j & 1)] *= r0; acc[ai][bj][m][j >> 1][2 * (j & 1) + 1] *= r1; }
            }
        }
    }
    __device__ __forceinline__ void operator()(const Acc& acc, const Unit& u, const int wid) const {
        const int lane = fresh_lane(), wr = wid >> 2, wc = wid & 3, fr = lane & 15, fq = lane >> 4;
        const unsigned goff = (unsigned)((wr * 64 + fr) * IN_DIM + wc * 32 + 8 * fq) * 2u, yoff = (unsigned)((wr * 64 + (lane >> 2)) * D + wc * 32 + 8 * (lane & 3)) * 2u;
        const Stage64 T(side, wid, lane);
        const int hb = (u.hm & 15) == 2 ? HALF : 0, na = ((u.hm & 15) == 1 || (u.hm & 15) == 2) ? 1 : 2;
        u32x4 gb[2][4][2];
#pragma unroll
        for (int ai = 0; ai < 2; ++ai) if (ai < na)
#pragma unroll
            for (int m = 0; m < 4; ++m) { const char* gp = (const char*)(G + (size_t)(u.pm * BM + hb + ai * HALF + m * 16) * IN_DIM + 6144 + u.pn * BM); asm("" : "+s"(gp));
#pragma unroll
                for (int bj = 0; bj < 2; ++bj) gb[ai][m][bj] = *(const GAS u32x4*)(gp + goff + bj * HALF * 2); }
        asm volatile("" ::: "memory");
#pragma unroll
        for (int ai = 0; ai < 2; ++ai) if (ai < na)
#pragma unroll
            for (int m = 0; m < 4; ++m) { char* yp = (char*)(Y + (size_t)(u.pm * BM + hb + ai * HALF + m * 16) * D + u.pn * BM); asm("" : "+s"(yp));
#pragma unroll
                for (int bj = 0; bj < 2; ++bj) { const u32x4 g = gb[ai][m][bj]; const f32x4 v0 = acc[ai][bj][m][0], v1 = acc[ai][bj][m][1];
                    u32x4 w;
                    w.x = cvt_pk_bf16(v0[0] * fmaxf(bf_lo(g[0]), 1e-30f), v0[1] * fmaxf(bf_hi(g[0]), 1e-30f)); w.y = cvt_pk_bf16(v0[2] * fmaxf(bf_lo(g[1]), 1e-30f), v0[3] * fmaxf(bf_hi(g[1]), 1e-30f));
                    w.z = cvt_pk_bf16(v1[0] * fmaxf(bf_lo(g[2]), 1e-30f), v1[1] * fmaxf(bf_hi(g[2]), 1e-30f)); w.w = cvt_pk_bf16(v1[2] * fmaxf(bf_lo(g[3]), 1e-30f), v1[3] * fmaxf(bf_hi(g[3]), 1e-30f));
                    T.put(bj, w); }
                asm volatile("" ::: "memory");
                const u32x4 r0 = T.get(0), r1 = T.get(1);
                asm volatile("" ::: "memory");
                *(GAS u32x4*)(yp + yoff) = r0; *(GAS u32x4*)(yp + yoff + HALF * 2) = r1; }
    }
};
struct EpiRes {
    static constexpr bool PERM = true, APERM = false; static constexpr int MIDK = 0; static constexpr bool PREF = true;
    const float* xp; const float* xs; float* X; const float* mods_l; int gi; bool first; float* XO;
    bool emit; const float* gvec; const float* scl; float* ss; bf16_t* HBo;
    const LAS float* side;
    __device__ __forceinline__ float prefetch(const Unit& u, const int tid) const {
        const int bv = u.pm < NB_P ? 0 : 1 + ((u.pm - NB_P) >> 4);
        unsigned to = (unsigned)tid * 4u; asm volatile("; opaque lane offset" : "+v"(to));
        if (tid >= 256) return *(const GAS float*)((const GAS char*)(mods_l + ((size_t)bv * NMOD + gi) * D + u.pn * BM - 256) + to);
        if (!emit) return 0.f;
        return *(const GAS float*)((const GAS char*)(gvec + u.pn * BM) + to) * (*(const GAS float*)((const GAS char*)(scl + (size_t)bv * NMOD * D + u.pn * BM) + to) + 1.0f);
    }
    __device__ __forceinline__ void produce(const Acc& acc, const Unit& u, const int wid) const {
        const int lane = fresh_lane(), wr = wid >> 2, wc = wid & 3, fr = lane & 15, fq = lane >> 4, rr = lane >> 3, ck = lane & 7;
        const unsigned xoff = (unsigned)((wr * 64 + rr) * D + wc * 32 + ck * 4) * 4u;
        LAS char* stg = (LAS char*)side + (STG_OFF - STAGE_BYTES) + wid * STG_WAVE;
        const unsigned sw = (unsigned)(fr * STG_PITCH + fq * 32), sr = (unsigned)(rr * STG_PITCH + ck * 16);
        const int cl = wc * 32 + ck * 4;
        const float* base = first ? (u.pm < NB_P ? xp : xs - (size_t)MP * D) : X;
        char* xt = (char*)(X + (size_t)u.pm * BM * D + u.pn * BM); asm("" : "+s"(xt));
        const __amdgpu_buffer_rsrc_t rs = __builtin_amdgcn_make_buffer_rsrc(xt, 0, 256 * D * 4, 0x00020000);
#pragma unroll
        for (int ai = 0; ai < 2; ++ai) {
            f32x4 b[4][2][2];
#pragma unroll
            for (int m = 0; m < 4; ++m) { const char* bp = (const char*)(base + (size_t)(u.pm * BM + ai * HALF + m * 16) * D + u.pn * BM); asm("" : "+s"(bp));
#pragma unroll
                for (int bj = 0; bj < 2; ++bj)
#pragma unroll
                    for (int p = 0; p < 2; ++p) b[m][bj][p] = *(const GAS f32x4*)(bp + xoff + (p * 8 * D + bj * HALF) * 4); }
            asm volatile("" ::: "memory");
#pragma unroll
            for (int m = 0; m < 4; ++m)
#pragma unroll
                for (int bj = 0; bj < 2; ++bj) {
                    *(LAS f32x4*)(stg + sw) = acc[ai][bj][m][0]; *(LAS f32x4*)(stg + sw + 16) = acc[ai][bj][m][1];
                    asm volatile("" ::: "memory");
                    const f32x4 a0 = *(const LAS f32x4*)(stg + sr), a1 = *(const LAS f32x4*)(stg + sr + 8 * STG_PITCH);
                    const f32x4 gvx = *(const LAS f32x4*)(side + 256 + cl + bj * HALF);
                    asm volatile("" ::: "memory");
                    __builtin_amdgcn_raw_buffer_store_b128(__builtin_bit_cast(u32x4, b[m][bj][0] + gvx * a0), rs, xoff, ((ai * HALF + m * 16) * D + bj * HALF) * 4, 16);
                    __builtin_amdgcn_raw_buffer_store_b128(__builtin_bit_cast(u32x4, b[m][bj][1] + gvx * a1), rs, xoff, ((ai * HALF + m * 16 + 8) * D + bj * HALF) * 4, 16); }
            asm volatile("" ::: "memory");
        }
    }
    __device__ __forceinline__ void operator()(const Acc& acc, const Unit& u, const int wid) const {
        const int lane = fresh_lane(), wr = wid >> 2, wc = wid & 3, fr = lane & 15, fq = lane >> 4, rr = lane >> 3, ck = lane & 7;
        const unsigned xoff = (unsigned)((wr * 64 + rr) * D + wc * 32 + ck * 4) * 4u, hoff = xoff >> 1;
        LAS char* stg = (LAS char*)side + (STG_OFF - STAGE_BYTES) + wid * STG_WAVE;
        const unsigned sw = (unsigned)(fr * STG_PITCH + fq * 32), sr = (unsigned)(rr * STG_PITCH + ck * 16);
        const int cl = wc * 32 + ck * 4;
        const int hmode = u.hm & 15;
        const float* base = (first && hmode != 4) ? (u.pm < NB_P ? xp : xs - (size_t)MP * D) : X;
        float* XOu = XO; const bool em = emit;
        const int hb = hmode == 2 ? HALF : 0, na = (hmode == 1 || hmode == 2) ? 1 : 2;
#pragma unroll
        for (int ai = 0; ai < 2; ++ai) if (ai < na) {
            f32x4 b[4][2][2];
#pragma unroll
            for (int m = 0; m < 4; ++m) { const char* bp = (const char*)(base + (size_t)(u.pm * BM + hb + ai * HALF + m * 16) * D + u.pn * BM); asm("" : "+s"(bp));
#pragma unroll
                for (int bj = 0; bj < 2; ++bj)
#pragma unroll
                    for (int p = 0; p < 2; ++p) b[m][bj][p] = *(const GAS f32x4*)(bp + xoff + (p * 8 * D + bj * HALF) * 4); }
            asm volatile("" ::: "memory");
#pragma unroll
            for (int m = 0; m < 4; ++m) {
                char* xq = (char*)(XOu + (size_t)(u.pm * BM + hb + ai * HALF + m * 16) * D + u.pn * BM); asm("" : "+s"(xq));
                char* hq = (char*)(HBo + (size_t)(u.pm * BM + hb + ai * HALF + m * 16) * D + u.pn * BM); asm("" : "+s"(hq));
                float q0 = 0.f, q1 = 0.f;
#pragma unroll
                for (int bj = 0; bj < 2; ++bj) {
                    *(LAS f32x4*)(stg + sw) = acc[ai][bj][m][0]; *(LAS f32x4*)(stg + sw + 16) = acc[ai][bj][m][1];
                    asm volatile("" ::: "memory");
                    const f32x4 a0 = *(const LAS f32x4*)(stg + sr), a1 = *(const LAS f32x4*)(stg + sr + 8 * STG_PITCH);
                    const f32x4 gvx = *(const LAS f32x4*)(side + 256 + cl + bj * HALF);
                    asm volatile("" ::: "memory");
                    const f32x4 x0 = b[m][bj][0] + gvx * a0, x1 = b[m][bj][1] + gvx * a1;
                    *(GAS f32x4*)(xq + xoff + (bj * HALF) * 4) = x0; *(GAS f32x4*)(xq + xoff + (8 * D + bj * HALF) * 4) = x1;
                    if (em) { const f32x4 gs = *(const LAS f32x4*)(side + cl + bj * HALF); const f32x4 h0 = x0 * gs, h1 = x1 * gs;
                        q0 += (x0[0] * x0[0] + x0[1] * x0[1]) + (x0[2] * x0[2] + x0[3] * x0[3]); q1 += (x1[0] * x1[0] + x1[1] * x1[1]) + (x1[2] * x1[2] + x1[3] * x1[3]);
                        u32x2 w0, w1; w0.x = cvt_pk_bf16(h0[0], h0[1]); w0.y = cvt_pk_bf16(h0[2], h0[3]); w1.x = cvt_pk_bf16(h1[0], h1[1]); w1.y = cvt_pk_bf16(h1[2], h1[3]);
                        *(GAS u32x2*)(hq + hoff + (bj * HALF) * 2) = w0; *(GAS u32x2*)(hq + hoff + (8 * D + bj * HALF) * 2) = w1; }
                }
                if (em) {
                    q0 += dpp_mov<0xB1>(q0); q1 += dpp_mov<0xB1>(q1); q0 += dpp_mov<0x4E>(q0); q1 += dpp_mov<0x4E>(q1); q0 += dpp_mov<0x141>(q0); q1 += dpp_mov<0x141>(q1);
                    if (ck == 0) { GAS float* sp = (GAS float*)(ss + (size_t)(u.pm * BM + hb + ai * HALF + m * 16) + wr * 64 + rr);
                        __hip_atomic_fetch_add(sp, q0, __ATOMIC_RELAXED, __HIP_MEMORY_SCOPE_AGENT); __hip_atomic_fetch_add(sp + 8, q1, __ATOMIC_RELAXED, __HIP_MEMORY_SCOPE_AGENT); }
                }
            }
            asm volatile("" ::: "memory");
        }
    }
};
struct UpOrder {
    static constexpr int BH_ROWS = FFN; static constexpr bool KSPLIT = false, MERGED = false;
    int nM, nN, nwg, G, c; const char* A; const char* B; char* C;
    __device__ __forceinline__ void init(int G_, int c_, const void* A_, const void* B_, void* C_) { nM = M / BM; nN = FFN / 128; nwg = nM * nN; G = G_; c = c_; A = (const char*)A_; B = (const char*)B_; C = (char*)C_; }
    __device__ __forceinline__ bool next(int i, Unit& u) const {
        const long L = (long)i * G + c; if (L >= nwg) return false;
        int wgid = (int)L; { const int q = nwg / NXCD, r = nwg % NXCD, xcd = wgid % NXCD, off = wgid / NXCD; wgid = (xcd < r ? xcd * (q + 1) : r * (q + 1) + (xcd - r) * q) + off; }
        const int nig = WGM * nN, gid = wgid / nig, fm = gid * WGM, gsz = (nM - fm) < WGM ? (nM - fm) : WGM;
        u.pm = fm + ((wgid % nig) % gsz); u.pn = (wgid % nig) / gsz;
        u.a = A + (size_t)u.pm * BM * D * 2; u.b = B + (size_t)u.pn * 128 * D * 2; u.c = C + ((size_t)u.pm * BM * FFN + (size_t)u.pn * 128) * 2; u.hm = 0;
        return true;
    }
};
__device__ __forceinline__ float dpp_shr1(float v) { return __int_as_float(__builtin_amdgcn_update_dpp(0, __float_as_int(v), 0x111, 0xf, 0xf, true)); }
__device__ __forceinline__ float dpp_shl1(float v) { return __int_as_float(__builtin_amdgcn_update_dpp(0, __float_as_int(v), 0x101, 0xf, 0xf, true)); }
struct EpiUpConv {
    static constexpr bool PERM = true, APERM = true; static constexpr int MIDK = 0; static constexpr bool PREF = true;
    const float* cw; const float* cb; float* UH; const float* ss; const float* bias; const LAS float* side;
    __device__ __forceinline__ float prefetch(const Unit& u, const int tid) const {
        const int bv = u.pm < NB_P ? 0 : 1 + ((u.pm - NB_P) >> 4);
        const float* p = tid < 256 ? ss + (size_t)u.pm * BM + tid : bias + (size_t)bv * FFN2 + u.pn * 128 + (tid < 384 ? tid - 256 : FFN + tid - 384);
        return *(const GAS float*)p;
    }
    __device__ __forceinline__ void operator()(const Acc& acc, const Unit& u, const int wid) const {
        const int lane = fresh_lane(), wr = wid >> 2, wc = wid & 3, fr = lane & 15, fq = lane >> 4;
        const int q = 16 * wr + fr, ch0 = 32 * wc + 8 * fq;
        const char* wbase = (const char*)(cw + u.pn * 128); const char* bbase = (const char*)(cb + u.pn * 128); asm("" : "+s"(wbase), "+s"(bbase));
        const unsigned coff = (unsigned)ch0 * 4u;
        float rstd[8];
        { const f32x4 s0 = *(const LAS f32x4*)(side + 8 * q), s1 = *(const LAS f32x4*)(side + 8 * q + 4);
#pragma unroll
          for (int k = 0; k < 4; ++k) { rstd[k] = rsqrtf(s0[k] * (1.0f / D) + RMS_EPS); rstd[4 + k] = rsqrtf(s1[k] * (1.0f / D) + RMS_EPS); } }
        unsigned outp[8][4];
#pragma unroll
        for (int n = 0; n < 2; ++n) {
            const f32x4 wa0 = *(const GAS f32x4*)(wbase + coff + n * 16), wa1 = *(const GAS f32x4*)(wbase + coff + n * 16 + FFN2 * 4), wa2 = *(const GAS f32x4*)(wbase + coff + n * 16 + 2 * FFN2 * 4);
            const f32x4 wg0 = *(const GAS f32x4*)(wbase + coff + n * 16 + FFN * 4), wg1 = *(const GAS f32x4*)(wbase + coff + n * 16 + (FFN2 + FFN) * 4), wg2 = *(const GAS f32x4*)(wbase + coff + n * 16 + (2 * FFN2 + FFN) * 4);
            const f32x4 ba = *(const GAS f32x4*)(bbase + coff + n * 16), bg = *(const GAS f32x4*)(bbase + coff + n * 16 + FFN * 4);
            const f32x4 ua_b = *(const LAS f32x4*)(side + 256 + ch0 + 4 * n), ug_b = *(const LAS f32x4*)(side + 384 + ch0 + 4 * n);
            float keep[8];
#pragma unroll
            for (int e = 0; e < 4; ++e) {
                float ua[8], ug[8];
#pragma unroll
                for (int k = 0; k < 8; ++k) { ua[k] = acc[k >> 2][0][k & 3][n][e] * rstd[k] + ua_b[e]; ug[k] = acc[k >> 2][1][k & 3][n][e] * rstd[k] + ug_b[e]; }
                const float pa = dpp_shr1(ua[7]), na = dpp_shl1(ua[0]), pg = dpp_shr1(ug[7]), ng = dpp_shl1(ug[0]);
#pragma unroll
                for (int k = 0; k < 8; ++k) {
                    const float A = wa0[e] * (k ? ua[k - 1] : pa) + wa1[e] * ua[k] + wa2[e] * (k < 7 ? ua[k + 1] : na) + ba[e];
                    const float Gv = wg0[e] * (k ? ug[k - 1] : pg) + wg1[e] * ug[k] + wg2[e] * (k < 7 ? ug[k + 1] : ng) + bg[e];
                    const float o = Gv * sigmoidf_fast(Gv) * A;
                    if (e & 1) outp[k][2 * n + (e >> 1)] = cvt_pk_bf16(keep[k], o); else keep[k] = o;
                }
            }
        }
        char* cbase = u.c; asm("" : "+s"(cbase));
        const Stage64 T(side, wid, lane);
        const int f4 = lane >> 2;
        const unsigned roff = (unsigned)(8 * (16 * wr + f4)) * (unsigned)(FFN * 2) + (unsigned)(32 * wc + 8 * (lane & 3)) * 2u;
#pragma unroll
        for (int k = 0; k < 8; k += 2) {
#pragma unroll
            for (int kk = 0; kk < 2; ++kk) { u32x4 w; w.x = outp[k + kk][0]; w.y = outp[k + kk][1]; w.z = outp[k + kk][2]; w.w = outp[k + kk][3]; T.put(kk, w); }
            asm volatile("" ::: "memory");
            const u32x4 r0 = T.get(0), r1 = T.get(1);
            asm volatile("" ::: "memory");
            if (!(k == 0 && f4 == 0)) *(GAS u32x4*)(cbase + roff + k * (FFN * 2)) = r0;
            if (!(k == 6 && f4 == 15)) *(GAS u32x4*)(cbase + roff + (k + 1) * (FFN * 2)) = r1;
        }
        if (fr == 0 || fr == 15) {
            char* ub = (char*)(UH + ((size_t)u.pm * 8 + 4 * wr) * FFN2 + u.pn * 128); asm("" : "+s"(ub));
            const unsigned uoff = (unsigned)(fr == 15 ? 2 * FFN2 * 4 : 0) + coff;
#pragma unroll
            for (int kk = 0; kk < 2; ++kk)
#pragma unroll
                for (int n = 0; n < 2; ++n) {
                    const float rs = fr == 0 ? rstd[kk] : rstd[6 + kk];
                    const f32x4 ua_b = *(const LAS f32x4*)(side + 256 + ch0 + 4 * n), ug_b = *(const LAS f32x4*)(side + 384 + ch0 + 4 * n);
                    const f32x4 va = (fr == 0 ? acc[0][0][kk][n] : acc[1][0][2 + kk][n]) * rs + ua_b, vg = (fr == 0 ? acc[0][1][kk][n] : acc[1][1][2 + kk][n]) * rs + ug_b;
                    *(GAS f32x4*)(ub + uoff + kk * (FFN2 * 4) + n * 16) = va; *(GAS f32x4*)(ub + uoff + kk * (FFN2 * 4) + FFN * 4 + n * 16) = vg; }
        }
    }
};

struct PabOutOrder {
    static constexpr int BH_ROWS = 128; static constexpr bool KSPLIT = false, MERGED = true;
    int c; const char* AF; const char* Wpab; const char* YB; const char* Wout; unsigned* cnt;
    __device__ __forceinline__ bool next(int i, Unit& u) const {
        if (i >= 5) return false;
        const int xcd = c & 7, s = 32 * i + (c >> 3), kind = s >= 80, j = kind ? s - 80 : s;
        u.pm = 10 * xcd + (j >> 3); u.pn = j & 7; u.hm = kind ? 0x1000 : 0; u.c = nullptr;
        u.a = (kind ? YB : AF) + (size_t)u.pm * BM * D * 2; u.b = (kind ? Wout : Wpab) + (size_t)u.pn * BM * D * 2;
        return true;
    }
    static constexpr bool WAIT_FIRST = false;
    __device__ __forceinline__ bool needs_wait(const Unit& u) const { return (u.hm & 0x1000) != 0; }
    __device__ __forceinline__ bool publishes(const Unit& u) const { return (u.hm & 0x1000) == 0; }
    __device__ __forceinline__ void publish(const Unit& u) const { __hip_atomic_fetch_add((GAS unsigned*)(cnt + u.pm * 16), 1u, __ATOMIC_RELAXED, __HIP_MEMORY_SCOPE_AGENT); }
    __device__ __forceinline__ void wait_panel(const Unit& u, const int wid) const {
        if (wid == 0) { GAS unsigned* fp = (GAS unsigned*)(cnt + u.pm * 16); unsigned sp = 0;
            while ((unsigned)__builtin_amdgcn_readfirstlane(__hip_atomic_load(fp, __ATOMIC_RELAXED, __HIP_MEMORY_SCOPE_AGENT)) < 64u) { __builtin_amdgcn_s_sleep(2); if (++sp > (1u << 20)) break; }
            __builtin_amdgcn_fence(__ATOMIC_ACQUIRE, "agent"); asm volatile("s_waitcnt vmcnt(0)" ::: "memory"); }
    }
};
struct EpiPabOut {
    static constexpr bool PERM = true, APERM = false; static constexpr int MIDK = 16; static constexpr bool PREF = true; static constexpr int NPF = 1;
    EpiPab P; EpiRes R;
    __device__ __forceinline__ void produce(const Acc&, const Unit&, const int) const {}
    __device__ __forceinline__ float prefetch(const Unit& u, const int tid) const { return (u.hm & 0x1000) ? R.prefetch(u, tid) : 0.f; }
    __device__ __forceinline__ void mid(Acc& acc, const Unit& u, const int wid) const { if (!(u.hm & 0x1000)) P.mid(acc, u, wid); }
    __device__ __forceinline__ void operator()(const Acc& acc, const Unit& u, const int wid) const { if (u.hm & 0x1000) R(acc, u, wid); else P(acc, u, wid); }
};
}

struct Buffers;
struct FourierSync {
    static constexpr bool WAIT_FIRST = true;
    bool mg; unsigned* pub; unsigned* wt; unsigned need;
    __device__ __forceinline__ bool needs_wait(const pg8::Unit&) const { return mg && wt != nullptr; }
    __device__ __forceinline__ bool publishes(const pg8::Unit&) const { return mg && pub != nullptr; }
    __device__ __forceinline__ void publish(const pg8::Unit& u) const { __hip_atomic_fetch_add((GAS unsigned*)(pub + u.pm * 16), 1u, __ATOMIC_RELAXED, __HIP_MEMORY_SCOPE_AGENT); }
    __device__ __forceinline__ void wait_panel(const pg8::Unit& u, const int wid) const {
        if (wid == 0) { GAS unsigned* fp = (GAS unsigned*)(wt + u.pm * 16); unsigned sp = 0;
            while ((unsigned)__builtin_amdgcn_readfirstlane(__hip_atomic_load(fp, __ATOMIC_RELAXED, __HIP_MEMORY_SCOPE_AGENT)) < need) { __builtin_amdgcn_s_sleep(2); if (++sp > (1u << 20)) break; }
            __builtin_amdgcn_fence(__ATOMIC_ACQUIRE, "agent"); asm volatile("s_waitcnt vmcnt(0)" ::: "memory"); }
    }
};
struct F1SOrder : FourierSync {
    static constexpr int BH_ROWS = 128; static constexpr bool KSPLIT = false, MERGED = true;
    int G, c; const char* DC; const char* QK; char* GTS;
    __device__ __forceinline__ bool next(int i, pg8::Unit& u) const {
        int L; if (mg) { if (i >= 2) return false; L = 64 * (c & 7) + 32 * i + (c >> 3); } else { L = i * G + c; if (L >= 512) return false; }
        const int bg = L >> 5, part = (L >> 4) & 1, nt = L & 15, b = bg >> 2, g = bg & 3;
        u.a = DC + (size_t)part * 256 * 256 * 2; u.b = QK + ((size_t)(MP + b * SEQ_S + nt * 256) * IN_DIM + 3072 + g * 256) * 2;
        u.c = GTS + ((size_t)bg * 256 * 8192 + part * 4096 + nt * 256) * 2; u.pm = bg; u.pn = nt; u.hm = 0; return true;
    }
};
struct F1POrder : FourierSync {
    static constexpr int BH_ROWS = 128; static constexpr bool KSPLIT = false, MERGED = true;
    int G, c; const char* DC; const char* QK; char* GTP;
    __device__ __forceinline__ bool next(int i, pg8::Unit& u) const {
        int L; if (mg) { if (i >= 1 || (c >> 3) < 16) return false; L = 16 * (c & 7) + (c >> 3) - 16; }      else { L = i * G + (G - 1 - c); if (L >= 128) return false; }
        const int bg = L >> 1, part = L & 1, b = bg >> 2, g = bg & 3;
        u.a = DC + (size_t)part * 256 * 256 * 2; u.b = QK + ((size_t)(b * SEQ_P) * IN_DIM + 3072 + g * 256) * 2;
        u.c = GTP + ((size_t)bg * 256 * 512 + part * 256) * 2; u.pm = bg; u.pn = 0; u.hm = 0; return true;
    }
};
struct F2SOrder : FourierSync {
    static constexpr int BH_ROWS = 128; static constexpr bool KSPLIT = false, MERGED = true;
    int G, c; const char* DS; const char* U2; char* AF;
    __device__ __forceinline__ bool next(int i, pg8::Unit& u) const {
        int L; if (mg) { if (i >= 1) return false; L = 32 * (c & 7) + (c >> 3); } else { L = i * G + c; if (L >= 256) return false; }
        const int bg = L >> 4, k2 = L & 15, b = bg >> 2, g = bg & 3;
        u.a = DS; u.b = U2 + (size_t)(bg * 16 + k2) * 256 * 512 * 2;
        u.c = AF + ((size_t)(MP + b * SEQ_S + k2) * D + 1024 + g * 256) * 2; u.pm = bg; u.pn = 0; u.hm = 0; return true;
    }
};
struct F2POrder : FourierSync {
    static constexpr int BH_ROWS = 128; static constexpr bool KSPLIT = false, MERGED = true;
    int G, c; const char* DP; const char* GTP; char* AF;
    __device__ __forceinline__ bool next(int i, pg8::Unit& u) const {
        int L; if (mg) { if (i >= 1 || (c >> 3) < 24) return false; L = 8 * (c & 7) + (c >> 3) - 24; } else { L = i * G + (G - 1 - c); if (L >= 64) return false; }
        const int bg = L, b = bg >> 2, g = bg & 3;
        u.a = DP; u.b = GTP + (size_t)bg * 256 * 512 * 2; u.c = AF + ((size_t)(b * SEQ_P) * D + 1024 + g * 256) * 2; u.pm = bg; u.pn = 0; u.hm = 0; return true;
    }
};

namespace att {
#define KSWZ(row, colB) ((row) * 256 + ((colB) ^ (((row) & 7) << 4)))
__device__ __forceinline__ int crow(int r, int hi) { return (r & 3) + 8 * (r >> 2) + 4 * hi; }
__device__ __forceinline__ int v_st(int k, int c) { const int kk = (k & ~0xC) | ((k & 4) << 1) | ((k & 8) >> 1); return ((kk >> 3) * 4 + (c >> 5)) * 512 + ((kk & 7) * 32 + (c & 31)) * 2; }
__device__ __forceinline__ int v_rd_base(int lane) { return ((lane & 3) << 3) | (((lane >> 2) & 3) << 6) | (((lane >> 4) & 1) << 5) | (((lane >> 5) & 1) << 8); }
constexpr int v_rd_off(int d0, int ks, int half) { return d0 * 512 + ks * 4096 + half * 2048; }
template <int OFF> __device__ __forceinline__ s16x4 tr_read(int vb) { s16x4 r; asm volatile("ds_read_b64_tr_b16 %0, %1 offset:%2" : "=&v"(r) : "v"(vb), "i"(OFF) : "memory"); return r; }
template <int D0> __device__ __forceinline__ void pv_one(f32x16& od, int vb, bf16x8 pa0, bf16x8 pa1, bf16x8 pa2, bf16x8 pa3) {
    const s16x4 l0 = tr_read<v_rd_off(D0, 0, 0)>(vb), h0 = tr_read<v_rd_off(D0, 0, 1)>(vb), l1 = tr_read<v_rd_off(D0, 1, 0)>(vb), h1 = tr_read<v_rd_off(D0, 1, 1)>(vb);
    const s16x4 l2 = tr_read<v_rd_off(D0, 2, 0)>(vb), h2 = tr_read<v_rd_off(D0, 2, 1)>(vb), l3 = tr_read<v_rd_off(D0, 3, 0)>(vb), h3 = tr_read<v_rd_off(D0, 3, 1)>(vb);
    asm volatile("s_waitcnt lgkmcnt(0)" ::: "memory"); __builtin_amdgcn_sched_barrier(0);
#define ATT_PK(L, H) (bf16x8){L[0], L[1], L[2], L[3], H[0], H[1], H[2], H[3]}
    od = __builtin_amdgcn_mfma_f32_32x32x16_bf16(pa0, ATT_PK(l0, h0), od, 0, 0, 0);
    od = __builtin_amdgcn_mfma_f32_32x32x16_bf16(pa1, ATT_PK(l1, h1), od, 0, 0, 0);
    od = __builtin_amdgcn_mfma_f32_32x32x16_bf16(pa2, ATT_PK(l2, h2), od, 0, 0, 0);
    od = __builtin_amdgcn_mfma_f32_32x32x16_bf16(pa3, ATT_PK(l3, h3), od, 0, 0, 0);
#undef ATT_PK
}
constexpr int SHM_V = 64 * 128 * 2, SHM_K = 64 * 128 * 2;
constexpr int L_V = 0, L_K = 2 * SHM_V, L_WS = 2 * SHM_V + 2 * SHM_K, L_TAB = L_WS + NWAVES * 64 * 4, L_END = L_TAB + 15 * 128 * 4;
static_assert(L_END <= 131072, "attention LDS");

struct TileSrc { const bf16_t* K0; const bf16_t* V0; int ld0, nt0; const bf16_t* K1; const bf16_t* V1; int ld1, nt1; };

template <bool NA>
__device__ __forceinline__ void attn_unit(LAS char* lds, const int wave0, const bf16_t* Qb, int ldq, const TileSrc T, int kr0, int qrow0, const float* rpb, bf16_t* Ob, int ldo) {
    const int lane = fresh_lane(), wid = fresh_wave(wave0), tid = wid * 64 + lane, r32 = lane & 31, hi = lane >> 5;
    LAS char* V_lds = lds + L_V; LAS char* K_lds = lds + L_K;
    LAS float* ws = (LAS float*)(lds + L_WS) + wid * 64; LAS float* li_l = ws; LAS float* al_l = ws + 32;
    LAS float* tab = (LAS float*)(lds + L_TAB);
    float m_reg = -1e30f, l_reg = 0.f; f32x16 o[4];
#pragma unroll
    for (int d = 0; d < 4; ++d)
#pragma unroll
        for (int r = 0; r < 16; ++r) o[d][r] = 0.f;
    bf16x8 qr[8];
    { const bf16_t* Qw = Qb + (size_t)(wid * 32 + r32) * ldq + hi * 8;
#pragma unroll
      for (int d0 = 0; d0 < 8; ++d0) qr[d0] = *(const GAS bf16x8*)(Qw + d0 * 16); }
    if (NA) { for (int idx = tid; idx < 15 * 128; idx += NTHREADS) { const int dr7 = idx >> 7, dcc = (idx & 127) - 63;
                  tab[idx] = (dcc >= -15 && dcc <= 15) ? ((const GAS float*)rpb)[dr7 * 31 + dcc + 15] * LOG2E : 0.f; } }
    const int sr = tid >> 4, sc = (tid & 15) * 8, vst0 = v_st(sr, sc), vst1 = v_st(32 + sr, sc), kst0 = KSWZ(sr, sc * 2), kst1 = KSWZ(32 + sr, sc * 2);
    const int vb0 = (int)(uintptr_t)(V_lds) + v_rd_base(lane);
    const int NT = T.nt0 + T.nt1;
    bf16x8 vs0, vs1, ks0, ks1;
#define ATT_SLOAD(t) do { const bool g0 = (t) < T.nt0; const int tt = g0 ? (t) : (t) - T.nt0; const int ld = g0 ? T.ld0 : T.ld1; \
        const bf16_t* Kp = (g0 ? T.K0 : T.K1) + (size_t)tt * 64 * ld; const bf16_t* Vp = (g0 ? T.V0 : T.V1) + (size_t)tt * 64 * ld; \
        vs0 = *(const GAS bf16x8*)(Vp + (size_t)sr * ld + sc); vs1 = *(const GAS bf16x8*)(Vp + (size_t)(32 + sr) * ld + sc); \
        ks0 = *(const GAS bf16x8*)(Kp + (size_t)sr * ld + sc); ks1 = *(const GAS bf16x8*)(Kp + (size_t)(32 + sr) * ld + sc); } while (0)
#define ATT_SWRITE(b) do { *(LAS bf16x8*)(V_lds + (b) * SHM_V + vst0) = vs0; *(LAS bf16x8*)(V_lds + (b) * SHM_V + vst1) = vs1; \
        *(LAS bf16x8*)(K_lds + (b) * SHM_K + kst0) = ks0; *(LAS bf16x8*)(K_lds + (b) * SHM_K + kst1) = ks1; } while (0)
    ATT_SLOAD(0); ATT_SWRITE(0);
    __syncthreads();
    const int qrow = qrow0 + (wid >> 1), qc = 32 * (wid & 1) + r32;
    const int r0w = min(max(qrow - 4, 0), GW - 8), c0 = min(max(qc - 8, 0), GW - 16);
    for (int t = 0; t < NT; ++t) {
        const int buf = t & 1;
        if (t + 1 < NT) ATT_SLOAD(t + 1);
        bool active = true; int dr = 0;
        if (NA && t >= T.nt0) { const int kr = kr0 + (t - T.nt0); active = (kr >= r0w) && (kr < r0w + 8); dr = kr - qrow; }
        if (active) {
            f32x16 p0, p1;
#pragma unroll
            for (int r = 0; r < 16; ++r) { p0[r] = 0.f; p1[r] = 0.f; }
            { LAS const char* Ks = K_lds + buf * SHM_K;
              __builtin_amdgcn_s_setprio(1);
#pragma unroll
              for (int d0 = 0; d0 < 8; ++d0) { const int cb = (d0 * 16 + hi * 8) * 2;
                  const bf16x8 b0 = *(LAS const bf16x8*)(Ks + KSWZ(r32, cb)); const bf16x8 b1 = *(LAS const bf16x8*)(Ks + KSWZ(32 + r32, cb));
                  p0 = __builtin_amdgcn_mfma_f32_32x32x16_bf16(b0, qr[d0], p0, 0, 0, 0); p1 = __builtin_amdgcn_mfma_f32_32x32x16_bf16(b1, qr[d0], p1, 0, 0, 0); }
              __builtin_amdgcn_s_setprio(0); }
            if (NA && t >= T.nt0) {
                LAS const float* brow = tab + (dr + 7) * 128 + 63 - qc + 4 * hi;
#pragma unroll
                for (int r = 0; r < 16; ++r) { const int kq = (r & 3) + 8 * (r >> 2); const int kc = kq + 4 * hi;
                    const float b0 = brow[kq], b1 = brow[kq + 32];
                    p0[r] = ((unsigned)(kc - c0) < 16u) ? p0[r] + b0 : -INFINITY; p1[r] = ((unsigned)(kc + 32 - c0) < 16u) ? p1[r] + b1 : -INFINITY; }
            }
            float pmax = p0[0];
#pragma unroll
            for (int r = 1; r < 16; ++r) pmax = fmaxf(pmax, p0[r]);
#pragma unroll
            for (int r = 0; r < 16; ++r) pmax = fmaxf(pmax, p1[r]);
            { auto rr = __builtin_amdgcn_permlane32_swap(__float_as_uint(pmax), __float_as_uint(pmax), false, false); pmax = fmaxf(__uint_as_float(rr[0]), __uint_as_float(rr[1])); }
            const float mn = fmaxf(m_reg, pmax), alpha = __builtin_amdgcn_exp2f(m_reg - mn); m_reg = mn;
            float ps = 0.f;
#pragma unroll
            for (int r = 0; r < 16; ++r) { p0[r] = __builtin_amdgcn_exp2f(p0[r] - mn); p1[r] = __builtin_amdgcn_exp2f(p1[r] - mn); ps += p0[r] + p1[r]; }
            { auto rr = __builtin_amdgcn_permlane32_swap(__float_as_uint(ps), __float_as_uint(ps), false, false); ps = __uint_as_float(rr[0]) + __uint_as_float(rr[1]); }
            l_reg = l_reg * alpha + ps;
            bf16x8 pa0, pa1, pa2, pa3;
#define ATT_PK4(P, BASE, OUT) do { unsigned a0 = cvt_pk_bf16(P[BASE + 0], P[BASE + 1]), a1 = cvt_pk_bf16(P[BASE + 2], P[BASE + 3]);   \
    unsigned b0 = cvt_pk_bf16(P[BASE + 4], P[BASE + 5]), b1 = cvt_pk_bf16(P[BASE + 6], P[BASE + 7]);                              \
    auto r0_ = __builtin_amdgcn_permlane32_swap(a0, b0, false, false); auto r1_ = __builtin_amdgcn_permlane32_swap(a1, b1, false, false); \
    u32x4 w_ = {r0_[0], r1_[0], r0_[1], r1_[1]}; OUT = *reinterpret_cast<bf16x8*>(&w_); } while (0)
            ATT_PK4(p0, 0, pa0); ATT_PK4(p0, 8, pa1); ATT_PK4(p1, 0, pa2); ATT_PK4(p1, 8, pa3);
#undef ATT_PK4
            if (__any(alpha < 1.f)) { if (hi == 0) al_l[r32] = alpha; asm volatile("s_waitcnt lgkmcnt(0)" ::: "memory");
#pragma unroll
                for (int r = 0; r < 16; ++r) { const float a = al_l[crow(r, hi)];
#pragma unroll
                    for (int d = 0; d < 4; ++d) o[d][r] *= a; } }
            const int vb = vb0 + buf * SHM_V;
            __builtin_amdgcn_s_setprio(1);
            pv_one<0>(o[0], vb, pa0, pa1, pa2, pa3); pv_one<1>(o[1], vb, pa0, pa1, pa2, pa3); pv_one<2>(o[2], vb, pa0, pa1, pa2, pa3); pv_one<3>(o[3], vb, pa0, pa1, pa2, pa3);
            __builtin_amdgcn_s_setprio(0);
        }
        if (t + 1 < NT) ATT_SWRITE(buf ^ 1);
        __syncthreads();
    }
#undef ATT_SLOAD
#undef ATT_SWRITE
    if (hi == 0) li_l[r32] = l_reg;
    asm volatile("s_waitcnt lgkmcnt(0)" ::: "memory");
    bf16_t* Ow = Ob + (size_t)(wid * 32) * ldo;
#pragma unroll
    for (int r = 0; r < 16; ++r) { const int orow = crow(r, hi); const float rl = __builtin_amdgcn_rcpf(li_l[orow]);
#pragma unroll
        for (int d0 = 0; d0 < 4; ++d0) ((GAS bf16_t*)Ow)[(size_t)orow * ldo + d0 * 32 + r32] = (bf16_t)(cvt_pk_bf16(o[d0][r] * rl, 0.f) & 0xffffu); }
    __syncthreads();
}
}

__device__ __forceinline__ void dft4(float& r0, float& i0, float& r1, float& i1, float& r2, float& i2, float& r3, float& i3) {
    const float t0r = r0 + r2, t0i = i0 + i2, t1r = r0 - r2, t1i = i0 - i2, t2r = r1 + r3, t2i = i1 + i3, t3r = r1 - r3, t3i = i1 - i3;
    r0 = t0r + t2r; i0 = t0i + t2i; r2 = t0r - t2r; i2 = t0i - t2i; r1 = t1r + t3i; i1 = t1i - t3r; r3 = t1r - t3i; i3 = t1i + t3r;
}
__device__ __forceinline__ void fft16(float (&xr)[16], float (&xi)[16]) {
#pragma unroll
    for (int nb = 0; nb < 4; ++nb) dft4(xr[nb], xi[nb], xr[4 + nb], xi[4 + nb], xr[8 + nb], xi[8 + nb], xr[12 + nb], xi[12 + nb]);
    constexpr float C1 = 0.92387953251128674f, S1 = 0.38268343236508977f, R2 = 0.70710678118654752f;
    constexpr float TC[10] = {1.f, C1, R2, S1, 0.f, 0.f, -R2, 0.f, 0.f, -C1};
    constexpr float TS[10] = {0.f, S1, R2, C1, 1.f, 0.f, R2, 0.f, 0.f, -S1};
#pragma unroll
    for (int nb = 1; nb < 4; ++nb)
#pragma unroll
        for (int ka = 1; ka < 4; ++ka) { const float c = TC[nb * ka], sn = TS[nb * ka]; const float ar = xr[4 * ka + nb], ai = xi[4 * ka + nb];
            xr[4 * ka + nb] = ar * c + ai * sn; xi[4 * ka + nb] = ai * c - ar * sn; }
#pragma unroll
    for (int ka = 0; ka < 4; ++ka) dft4(xr[4 * ka], xi[4 * ka], xr[4 * ka + 1], xi[4 * ka + 1], xr[4 * ka + 2], xi[4 * ka + 2], xr[4 * ka + 3], xi[4 * ka + 3]);
}

struct Args { const float* in[20]; float* out; unsigned char* ws; };
enum { I_XP = 0, I_XS, I_CK, I_CV, I_C, I_CCTX, I_WMOD, I_BMOD, I_N1G, I_WIN, I_RPB, I_WPA, I_WPB, I_WOUT, I_N2G, I_WUP, I_CONVW, I_CONVB, I_WDOWN, I_NFG };

__device__ __forceinline__ void transpose_item(const float* W, int K, int N, bf16_t* WT, int ldt, int nsc, float sc, LAS float* scr, int item, int lane) {
    const int nblk = N >> 6, kb = item / nblk, nb = item - kb * nblk, k0 = kb << 6, n0 = nb << 6;
    f32x4 v[16];
    const float* src = W + (size_t)(k0 + (lane >> 4)) * N + n0 + 4 * (lane & 15);
#pragma unroll
    for (int i = 0; i < 16; ++i) v[i] = *(const f32x4*)(src + (size_t)(4 * i) * N);
#pragma unroll
    for (int i = 0; i < 16; ++i) { LAS float* d = scr + (4 * i + (lane >> 4)) * 65 + 4 * (lane & 15); d[0] = v[i][0]; d[1] = v[i][1]; d[2] = v[i][2]; d[3] = v[i][3]; }
    LDS_WAIT(); asm volatile("" ::: "memory");
    const int c = lane & 7;
#pragma unroll
    for (int j = 0; j < 8; ++j) { const int n = (lane >> 3) + 8 * j; const LAS float* s = scr + (8 * c) * 65 + n; const float f = (n0 + n) < nsc ? sc : 1.0f;
        u32x4 o; o.x = cvt_pk_bf16(s[0 * 65] * f, s[1 * 65] * f); o.y = cvt_pk_bf16(s[2 * 65] * f, s[3 * 65] * f); o.z = cvt_pk_bf16(s[4 * 65] * f, s[5 * 65] * f); o.w = cvt_pk_bf16(s[6 * 65] * f, s[7 * 65] * f);
        *(u32x4*)(WT + (size_t)(n0 + n) * ldt + k0 + 8 * c) = o; }
    LDS_WAIT(); asm volatile("" ::: "memory");
}

__global__ void __launch_bounds__(NTHREADS, 2) fwd(Args args) {
    extern __shared__ __attribute__((aligned(16))) unsigned char lds_raw[];
    LAS unsigned char* lds = (LAS unsigned char*)lds_raw;
    volatile LAS unsigned* MISC = (volatile LAS unsigned*)(lds + MISC_OFF);
    const int G = gridDim.x, bx = blockIdx.x;
    const int vcu = (G % 8 == 0) ? (bx % 8) * (G / 8) + bx / 8 : bx;
    const int NGW = G * NWAVES;
    const int wave0 = __builtin_amdgcn_readfirstlane((int)threadIdx.x >> 6);
#define OPQ_BX() unsigned mo_ = MISC_OFF + 16; asm volatile("; opaque LDS offset" : "+v"(mo_)); int bxo_ = __builtin_amdgcn_readfirstlane((int)*(volatile LAS unsigned*)(lds + mo_)); asm volatile("; opaque virtual block index" : "+s"(bxo_)); const int bx = bxo_
#define PIN_TID() const int lane = fresh_lane(), wave = fresh_wave(wave0), tid = wave * 64 + lane, gw = vcu * NWAVES + wave; (void)gw; (void)tid
    { const int tid = threadIdx.x; if (tid < 64) MISC[tid] = 0u; }
    unsigned char* ws = args.ws;
    __syncthreads();
    XcdBarrier bar = xcd_barrier_post((unsigned*)(ws + WS_CTL) + CW_BAR, MISC);
    if (threadIdx.x == 0) { const unsigned xcc = xb_xcc_id(); MISC[2] = xcc; MISC[3] = xb_add((unsigned*)(ws + WS_CTL) + CW_XRANK + 64 * xcc, 1u); MISC[4] = blockIdx.x; }
#define GRID_BAR() do { XcdBarrier b_ = bar; asm volatile("; pin bar" : "+s"(b_.bar), "+s"(b_.x)); const bool ldr_ = (fresh_wave(wave0) == 0) && (fresh_lane() == 0); for (int rb_ = 0; rb_ < REP_BAR; ++rb_) xcd_barrier(b_, ldr_); } while (0)

    float* X = args.out;
    float* OUTK = args.out + (size_t)M * D; float* OUTV = OUTK + (size_t)NB_P * DEPTH * NH * SEQ_P * HD;
    float* MODS = (float*)(ws + WS_MODS); float* SS = (float*)(ws + WS_SS); float* BIN = (float*)(ws + WS_BIAS); float* BUP = BIN + (size_t)DEPTH * 5 * IN_DIM;
    bf16_t* CKB = (bf16_t*)(ws + WS_CACHE); bf16_t* CVB = CKB + (size_t)NB_S * DEPTH * NH * PAST * HD;
    bf16_t* DC = (bf16_t*)(ws + WS_DC); bf16_t* DP = (bf16_t*)(ws + WS_DP); bf16_t* DS = (bf16_t*)(ws + WS_DS); bf16_t* U2 = (bf16_t*)(ws + WS_UP2);
    bf16_t* HB = (bf16_t*)(ws + WS_H); bf16_t* QK = (bf16_t*)(ws + WS_BIG); float* UH = (float*)(ws + WS_UH);
    bf16_t* AF = (bf16_t*)(ws + WS_AF); bf16_t* GTS = (bf16_t*)(ws + WS_GTS); bf16_t* GTP = (bf16_t*)(ws + WS_GTP);
    float* T1 = (float*)(ws + WS_T1); bf16_t* ACT = (bf16_t*)(ws + WS_ACT); bf16_t* YB = (bf16_t*)(ws + WS_Y);

    for (int rep_ = 0; rep_ < REP_P0; ++rep_) {
        PIN_TID();
#if EN_MODS
        for (int item = bx; item < DEPTH * 48; item += G) {
            const int l = item / 48, nb = item % 48;
            LAS float* sil = (LAS float*)lds; LAS float* red = (LAS float*)(lds + 5 * D * 4);
            for (int idx = tid; idx < 5 * D; idx += NTHREADS) { const int v = idx / D, k = idx % D; const float cv = v == 0 ? args.in[I_CCTX][k] : args.in[I_C][(size_t)(v - 1) * D + k];
                sil[idx] = cv * sigmoidf_fast(cv); }
            __syncthreads();
            f32x4 a5[5];
#pragma unroll
            for (int v = 0; v < 5; ++v) a5[v] = (f32x4){0.f, 0.f, 0.f, 0.f};
            const float* Wp = args.in[I_WMOD] + ((size_t)l * D + wave * 256) * (NMOD * D) + 256 * nb + 4 * lane;
            for (int k8 = 0; k8 < 256; k8 += 8) {
                f32x4 wv[8];
#pragma unroll
                for (int j = 0; j < 8; ++j) wv[j] = *(const f32x4*)(Wp + (size_t)(k8 + j) * (NMOD * D));
#pragma unroll
                for (int j = 0; j < 8; ++j)
#pragma unroll
                    for (int v = 0; v < 5; ++v) a5[v] += sil[v * D + wave * 256 + k8 + j] * wv[j];
            }
#pragma unroll
            for (int v = 0; v < 5; ++v) *(LAS f32x4*)(red + (wave * 5 + v) * 256 + 4 * lane) = a5[v];
            __syncthreads();
            for (int o = tid; o < 5 * 256; o += NTHREADS) { const int v = o >> 8, n = o & 255; float s = args.in[I_BMOD][(size_t)l * NMOD * D + 256 * nb + n];
#pragma unroll
                for (int w = 0; w < 8; ++w) s += red[(w * 5 + v) * 256 + n];
                MODS[((size_t)l * 5 + v) * (NMOD * D) + 256 * nb + n] = s; }
            __syncthreads();
        }
#endif
#if EN_WT
        {
            LAS float* scr = (LAS float*)(lds + wave * (64 * 65 * 4));
            constexpr int I_IN = (D / 64) * (IN_DIM / 64), I_PA = (AD / 64) * (D / 64), I_PB = (FD / 64) * (D / 64), I_OUT = (D / 64) * (D / 64), I_UP = (D / 64) * (FFN2 / 64), I_DOWN = (FFN / 64) * (D / 64);
            constexpr int PER_LAYER = I_IN + I_PA + I_PB + I_OUT + I_UP + I_DOWN;
            for (int it = gw; it < DEPTH * PER_LAYER; it += NGW) {
                const int l = it / PER_LAYER; int r = it - l * PER_LAYER;
                bf16_t* wt = (bf16_t*)(ws + WS_WT + (size_t)l * WT_LAYER);
                if (r < I_IN) { transpose_item(args.in[I_WIN] + (size_t)l * D * IN_DIM, D, IN_DIM, wt + WT_IN / 2, D, AD, QSCALE, scr, r, lane); continue; } r -= I_IN;
                if (r < I_PA) { transpose_item(args.in[I_WPA] + (size_t)l * AD * D, AD, D, wt + WT_PA / 2, AD + FD, 0, 1.f, scr, r, lane); continue; } r -= I_PA;
                if (r < I_PB) { transpose_item(args.in[I_WPB] + (size_t)l * FD * D, FD, D, wt + WT_PA / 2 + AD, AD + FD, 0, 1.f, scr, r, lane); continue; } r -= I_PB;
                if (r < I_OUT) { transpose_item(args.in[I_WOUT] + (size_t)l * D * D, D, D, wt + WT_OUT / 2, D, 0, 1.f, scr, r, lane); continue; } r -= I_OUT;
                if (r < I_UP) { transpose_item(args.in[I_WUP] + (size_t)l * D * FFN2, D, FFN2, wt + WT_UP / 2, D, 0, 1.f, scr, r, lane); continue; } r -= I_UP;
                transpose_item(args.in[I_WDOWN] + (size_t)l * FFN * D, FFN, D, wt + WT_DOWN / 2, FFN, 0, 1.f, scr, r, lane);
            }
        }
#endif
#if EN_MISC
        {
            const size_t n8 = (size_t)NB_S * DEPTH * NH * PAST * HD / 8;
            for (size_t i = (size_t)gw * 64 + lane; i < 2 * n8; i += (size_t)NGW * 64) { const bool isk = i < n8; const size_t j = isk ? i : i - n8;
                const float* s = (isk ? args.in[I_CK] : args.in[I_CV]) + j * 8; const f32x4 a = *(const f32x4*)s, b = *(const f32x4*)(s + 4);
                u32x4 w; w.x = cvt_pk_bf16(a[0], a[1]); w.y = cvt_pk_bf16(a[2], a[3]); w.z = cvt_pk_bf16(b[0], b[1]); w.w = cvt_pk_bf16(b[2], b[3]);
                *(u32x4*)((isk ? CKB : CVB) + j * 8) = w; }
        }
        {
            for (int i = gw * 64 + lane; i < 512 * 256 / 8; i += NGW * 64) { const int j = i >> 5, c0 = (i & 31) * 8; const bool isin = j >= 256; const int jj = j & 255;
                float v[8];
#pragma unroll
                for (int e = 0; e < 8; ++e) { const int mm = (jj * (c0 + e)) & 255; const float x = (float)mm * (1.0f / 128.0f); v[e] = (isin ? -sinpif(x) : cospif(x)) * (1.0f / 16.0f); }
                u32x4 w; w.x = cvt_pk_bf16(v[0], v[1]); w.y = cvt_pk_bf16(v[2], v[3]); w.z = cvt_pk_bf16(v[4], v[5]); w.w = cvt_pk_bf16(v[6], v[7]);
                *(u32x4*)(DC + (size_t)j * 256 + c0) = w; }
            for (int i = gw * 64 + lane; i < 256 * 512 / 8; i += NGW * 64) { const int k1 = i >> 6, c8 = (i & 63) * 8; const bool isin = c8 >= 256; const int n0 = c8 & 255;
                float v[8];
#pragma unroll
                for (int e = 0; e < 8; ++e) { const int mm = (k1 * (n0 + e)) & 255; const float x = (float)mm * (1.0f / 128.0f); v[e] = (isin ? sinpif(x) : cospif(x)) * (1.0f / 16.0f); }
                u32x4 w; w.x = cvt_pk_bf16(v[0], v[1]); w.y = cvt_pk_bf16(v[2], v[3]); w.z = cvt_pk_bf16(v[4], v[5]); w.w = cvt_pk_bf16(v[6], v[7]);
                *(u32x4*)(DP + (size_t)k1 * 512 + c8) = w;
                w.x = cvt_pk_bf16(v[0] * 0.25f, v[1] * 0.25f); w.y = cvt_pk_bf16(v[2] * 0.25f, v[3] * 0.25f); w.z = cvt_pk_bf16(v[4] * 0.25f, v[5] * 0.25f); w.w = cvt_pk_bf16(v[6] * 0.25f, v[7] * 0.25f);
                *(u32x4*)(DS + (size_t)k1 * 512 + c8) = w; }
        }
#endif
    }
    GRID_BAR();

    if (threadIdx.x == 0) {
        unsigned* rk = (unsigned*)(ws + WS_CTL) + CW_XRANK; const unsigned xcc = MISC[2], myrank = MISC[3]; unsigned npop = 0, xidx = 0; bool ok = (G % 8) == 0;
        for (unsigned j = 0; j < 16; ++j) { const unsigned cnt = xb_ld(rk + 64 * j); if (cnt) { ++npop; if (j < xcc) ++xidx; if (cnt != (unsigned)(G / 8)) ok = false; } }
        if (ok && npop == 8) { MISC[4] = myrank * 8u + xidx; MISC[5] = 1u; }
    }
    __syncthreads();
    {
        PIN_TID();
#if EN_NORM
        { const float* gvec = args.in[I_N1G];
          for (int row = gw; row < M; row += NGW) {
            const float* src = row < MP ? args.in[I_XP] + (size_t)row * D : args.in[I_XS] + (size_t)(row - MP) * D;
            f32x4 v[8]; float ssq = 0.f;
#pragma unroll
            for (int j = 0; j < 8; ++j) { v[j] = *(const GAS f32x4*)(src + 4 * (lane + 64 * j)); ssq += (v[j][0] * v[j][0] + v[j][1] * v[j][1]) + (v[j][2] * v[j][2] + v[j][3] * v[j][3]); }
            ssq = wave_sum(ssq);
            const int bv = row < MP ? 0 : 1 + ((row - MP) >> 12);
            const float* scp = MODS + ((size_t)bv * NMOD + 1) * D;
#pragma unroll
            for (int j = 0; j < 8; ++j) { const int col = 4 * (lane + 64 * j); const f32x4 g = *(const GAS f32x4*)(gvec + col), sc = *(const GAS f32x4*)(scp + col);
                const f32x4 y = v[j] * g * (sc + 1.0f); u32x2 w; w.x = cvt_pk_bf16(y[0], y[1]); w.y = cvt_pk_bf16(y[2], y[3]); *(GAS u32x2*)(HB + (size_t)row * D + col) = w; }
            if (lane == 0) SS[row] = ssq;
          } }
#endif
#if EN_MISC
        for (int l = 0; l < DEPTH; ++l) {
            LAS float* shl = (LAS float*)lds;
            __syncthreads();
            for (int idx = tid; idx < 2 * 5 * D; idx += NTHREADS) { const int w2 = idx / (5 * D), r = idx - w2 * 5 * D, bv = r / D, k = r - bv * D; shl[idx] = MODS[(((size_t)l * 5 + bv) * NMOD + (w2 ? 3 : 0)) * D + k]; }
            __syncthreads();
            const bf16_t* wt_in = (const bf16_t*)(ws + WS_WT + (size_t)l * WT_LAYER + WT_IN); const bf16_t* wt_up = (const bf16_t*)(ws + WS_WT + (size_t)l * WT_LAYER + WT_UP);
            for (int r = 2 * gw; r < IN_DIM + FFN2; r += 2 * NGW) {
                const bool isup = r >= IN_DIM; const int n = isup ? r - IN_DIM : r;
                const bf16_t* wrow = (isup ? wt_up : wt_in) + (size_t)n * D; const LAS float* sh = shl + (isup ? 5 * D : 0);
                float a5[2][5];
#pragma unroll
                for (int q = 0; q < 2; ++q)
#pragma unroll
                    for (int bv = 0; bv < 5; ++bv) a5[q][bv] = 0.f;
#pragma unroll
                for (int j = 0; j < 4; ++j) { const int k0 = 512 * j + 8 * lane; const u32x4 w0 = *(const GAS u32x4*)(wrow + k0), w1 = *(const GAS u32x4*)(wrow + D + k0);
                    float wf[2][8];
#pragma unroll
                    for (int e = 0; e < 4; ++e) { wf[0][2 * e] = bf_lo(w0[e]); wf[0][2 * e + 1] = bf_hi(w0[e]); wf[1][2 * e] = bf_lo(w1[e]); wf[1][2 * e + 1] = bf_hi(w1[e]); }
#pragma unroll
                    for (int bv = 0; bv < 5; ++bv) { const f32x4 s0 = *(const LAS f32x4*)(sh + bv * D + k0), s1 = *(const LAS f32x4*)(sh + bv * D + k0 + 4);
#pragma unroll
                        for (int q = 0; q < 2; ++q)
                            a5[q][bv] += (wf[q][0] * s0[0] + wf[q][1] * s0[1]) + (wf[q][2] * s0[2] + wf[q][3] * s0[3]) + (wf[q][4] * s1[0] + wf[q][5] * s1[1]) + (wf[q][6] * s1[2] + wf[q][7] * s1[3]); } }
#pragma unroll
                for (int q = 0; q < 2; ++q)
#pragma unroll
                    for (int bv = 0; bv < 5; ++bv) { const float t = wave_sum(a5[q][bv]); if (lane == 0) { if (isup) BUP[((size_t)l * 5 + bv) * FFN2 + n + q] = t; else BIN[((size_t)l * 5 + bv) * IN_DIM + n + q] = t; } }
            }
        }
        __syncthreads();
#endif
    }
    GRID_BAR();

    for (int l = 0; l < DEPTH; ++l) {
        const float* mods_l = MODS + (size_t)l * 5 * NMOD * D;
        const unsigned char* wt = ws + WS_WT + (size_t)l * WT_LAYER;
#if EN_GIN
        {
            OPQ_BX();
            pg8::TileOrder S; S.init(M, IN_DIM, G, bx, HB, D, wt + WT_IN, D, QK, IN_DIM, 2);
            pg8::EpiIn E{OUTK, OUTV, l, SS + (size_t)(2 * l) * M, BIN + (size_t)l * 5 * IN_DIM, (const LAS float*)(lds + pg8::STAGE_BYTES)};
            for (int rep_ = 0; rep_ < REP_GIN; ++rep_)
            pg8::gemm_phase<pg8::EpiIn, pg8::TileOrder>(lds, wave0, D, D, D, S, E);
        }
#endif
        GRID_BAR();

        unsigned mo5_ = MISC_OFF + 20; asm volatile("; opaque LDS offset" : "+v"(mo5_));
        const bool merged_ok = (G == 256) && (__builtin_amdgcn_readfirstlane((int)*(volatile LAS unsigned*)(lds + mo5_)) != 0);
        unsigned* const fcnt = (unsigned*)(ws + WS_CTL) + CW_FOUR + (size_t)l * 96 * 16;
        const bool four_ok = merged_ok && (FOUR_MERGE != 0);
        {
            OPQ_BX();
#if EN_F1
            for (int rep_ = 0; rep_ < REP_FOUR; ++rep_) {
            { F1SOrder S{{four_ok, nullptr, nullptr, 0u}, G, bx, (const char*)DC, (const char*)QK, (char*)GTS}; pg8::EpiBf16U<8192> E{(const LAS float*)(lds + pg8::STAGE_BYTES)}; pg8::gemm_phase<pg8::EpiBf16U<8192>, F1SOrder>(lds, wave0, 256, IN_DIM, 256, S, E); }
            { F1POrder S{{four_ok, nullptr, nullptr, 0u}, G, bx, (const char*)DC, (const char*)QK, (char*)GTP}; pg8::EpiBf16U<512> E{(const LAS float*)(lds + pg8::STAGE_BYTES)}; pg8::gemm_phase<pg8::EpiBf16U<512>, F1POrder>(lds, wave0, 256, IN_DIM, 256, S, E); }
            }
#endif
#if EN_ATT
            for (int rep_ = 0; rep_ < REP_ATT; ++rep_)
            for (int U = bx; U < 640; U += G) {
                if (U < 512) {
                    const int b = U >> 7, h = (U >> 4) & 7, i4 = U & 15;
                    const int kr0 = max(4 * i4 - 4, 0), ntn = (i4 == 0 || i4 == 15) ? 8 : 11;
                    const size_t rowbase = (size_t)MP + (size_t)b * SEQ_S;
                    att::TileSrc T;
                    T.K0 = CKB + (((size_t)b * DEPTH + l) * NH + h) * PAST * HD; T.V0 = CVB + (((size_t)b * DEPTH + l) * NH + h) * PAST * HD; T.ld0 = HD; T.nt0 = 4;
                    T.K1 = QK + (rowbase + (size_t)kr0 * GW) * IN_DIM + 1024 + h * HD; T.V1 = T.K1 + 1024; T.ld1 = IN_DIM; T.nt1 = ntn;
                    att::attn_unit<true>((LAS char*)lds, wave0, QK + (rowbase + (size_t)i4 * 256) * IN_DIM + h * HD, IN_DIM, T, kr0, 4 * i4,
                                         args.in[I_RPB] + ((size_t)l * NH + h) * 15 * 31, AF + (rowbase + (size_t)i4 * 256) * D + h * HD, D);
                } else {
                    const int bh = U - 512, b = bh >> 3, h = bh & 7;
                    att::TileSrc T;
                    T.K0 = QK + ((size_t)b * SEQ_P) * IN_DIM + 1024 + h * HD; T.V0 = T.K0 + 1024; T.ld0 = IN_DIM; T.nt0 = 4;
                    T.K1 = T.K0; T.V1 = T.V0; T.ld1 = IN_DIM; T.nt1 = 0;
                    att::attn_unit<false>((LAS char*)lds, wave0, QK + ((size_t)b * SEQ_P) * IN_DIM + h * HD, IN_DIM, T, 0, 0, nullptr, AF + ((size_t)b * SEQ_P) * D + h * HD, D);
                }
            }
#endif
            if (four_ok) {
                asm volatile("s_waitcnt vmcnt(0)" ::: "memory");
                if (fresh_lane() == 0) { const int x_ = bx & 7, k_ = bx >> 3;
                    __hip_atomic_fetch_add((GAS unsigned*)(fcnt + (2 * x_) * 16), 1u, __ATOMIC_RELAXED, __HIP_MEMORY_SCOPE_AGENT);
                    __hip_atomic_fetch_add((GAS unsigned*)(fcnt + (2 * x_ + 1) * 16), 1u, __ATOMIC_RELAXED, __HIP_MEMORY_SCOPE_AGENT);
                    if (k_ >= 16) __hip_atomic_fetch_add((GAS unsigned*)(fcnt + (16 + 8 * x_ + ((k_ - 16) >> 1)) * 16), 1u, __ATOMIC_RELAXED, __HIP_MEMORY_SCOPE_AGENT); }
            }
        }
        if (!four_ok || FOUR_KEEPBAR) GRID_BAR();

#if EN_F2
        {
            PIN_TID();
            OPQ_BX();
            if (four_ok) {
                unsigned sp = 0;
                for (int q = 0; q < 2; ++q) { GAS unsigned* fp = (GAS unsigned*)(fcnt + (2 * (bx & 7) + q) * 16);
                    while ((unsigned)__builtin_amdgcn_readfirstlane(__hip_atomic_load(fp, __ATOMIC_RELAXED, __HIP_MEMORY_SCOPE_AGENT)) < 256u) { __builtin_amdgcn_s_sleep(2); if (++sp > (1u << 20)) break; } }
                __builtin_amdgcn_fence(__ATOMIC_ACQUIRE, "agent"); asm volatile("s_waitcnt vmcnt(0)" ::: "memory");
            }
            for (int rep_ = 0; rep_ < REP_FOUR; ++rep_)
            for (int jt = 0; ; ++jt) {
                int it;
                if (four_ok) { if (jt >= 4) break; const int li = (bx >> 3) * NWAVES + wave + 256 * jt; it = ((2 * (bx & 7) + (li >> 9)) << 9) + (li & 511); }
                else { it = gw + jt * NGW; if (it >= 16 * 256 * 2) break; }
                const int row = it >> 1, half = it & 1;
                const char* src = (const char*)GTS + (size_t)row * 8192 * 2 + (unsigned)(half * 256 + lane * 4);
                unsigned zr[16], zi[16];
#pragma unroll
                for (int n2 = 0; n2 < 16; ++n2) { zr[n2] = *(const GAS unsigned*)(src + n2 * 512); zi[n2] = *(const GAS unsigned*)(src + 8192 + n2 * 512); }
                unsigned orr[16], oii[16];
#pragma unroll
                for (int j = 0; j < 2; ++j) {
                    float xr[16], xi[16];
#pragma unroll
                    for (int n2 = 0; n2 < 16; ++n2) { xr[n2] = j ? bf_hi(zr[n2]) : bf_lo(zr[n2]); xi[n2] = j ? bf_hi(zi[n2]) : bf_lo(zi[n2]); }
                    fft16(xr, xi);
                    float s1, c1; sincospif((float)(128 * half + 2 * lane + j) * (1.0f / 2048.0f), &s1, &c1);
                    float wr = 1.f, wi = 0.f;
#pragma unroll
                    for (int k2 = 0; k2 < 16; ++k2) { const int slot = 4 * (k2 & 3) + (k2 >> 2);
                        const float ur = xr[slot] * wr - xi[slot] * wi, ui = xr[slot] * wi + xi[slot] * wr;
                        if (j == 0) { orr[k2] = __float_as_uint(ur); oii[k2] = __float_as_uint(ui); }
                        else { orr[k2] = cvt_pk_bf16(__uint_as_float(orr[k2]), ur); oii[k2] = cvt_pk_bf16(__uint_as_float(oii[k2]), ui); }
                        const float nwr = wr * c1 + wi * s1, nwi = wi * c1 - wr * s1; wr = nwr; wi = nwi; }
                }
                const int bg = row >> 8, c = row & 255;
                char* dst = (char*)U2 + ((size_t)(bg * 16) * 256 + c) * 512 * 2 + (unsigned)(half * 256 + lane * 4);
#pragma unroll
                for (int k2 = 0; k2 < 16; ++k2) { *(GAS unsigned*)(dst + (size_t)k2 * 256 * 512 * 2) = orr[k2]; *(GAS unsigned*)(dst + (size_t)k2 * 256 * 512 * 2 + 512) = oii[k2]; }
            }
            if (four_ok) { asm volatile("s_waitcnt vmcnt(0)" ::: "memory");
                if (fresh_lane() == 0) { __hip_atomic_fetch_add((GAS unsigned*)(fcnt + (80 + 2 * (bx & 7)) * 16), 2u, __ATOMIC_RELAXED, __HIP_MEMORY_SCOPE_AGENT);
                                         __hip_atomic_fetch_add((GAS unsigned*)(fcnt + (81 + 2 * (bx & 7)) * 16), 2u, __ATOMIC_RELAXED, __HIP_MEMORY_SCOPE_AGENT); } }
        }
#endif
        if (!four_ok || FOUR_KEEPBAR) GRID_BAR();

#if EN_F2
        {
            OPQ_BX();
            for (int rep_ = 0; rep_ < REP_FOUR; ++rep_) {
            { F2SOrder S{{four_ok, nullptr, fcnt + 80 * 16, 512u}, G, bx, (const char*)DS, (const char*)U2, (char*)AF}; pg8::EpiBf16U<16 * D> E{(const LAS float*)(lds + pg8::STAGE_BYTES)}; pg8::gemm_phase<pg8::EpiBf16U<16 * D>, F2SOrder>(lds, wave0, 512, 512, 512, S, E); }
            { F2POrder S{{four_ok, nullptr, fcnt + 16 * 16, 16u}, G, bx, (const char*)DP, (const char*)GTP, (char*)AF}; pg8::EpiBf16U<D> E{(const LAS float*)(lds + pg8::STAGE_BYTES)}; pg8::gemm_phase<pg8::EpiBf16U<D>, F2POrder>(lds, wave0, 512, 512, 512, S, E); }
            }
        }
#endif
        GRID_BAR();

        if (merged_ok) {
            OPQ_BX();
            pg8::PabOutOrder S{bx, (const char*)AF, (const char*)(wt + WT_PA), (const char*)YB, (const char*)(wt + WT_OUT), (unsigned*)(ws + WS_CTL) + CW_PANEL + (size_t)l * 80 * 16};
            pg8::EpiPabOut E{pg8::EpiPab{QK, YB, (const LAS float*)(lds + pg8::STAGE_BYTES)},
                             pg8::EpiRes{args.in[I_XP], args.in[I_XS], X, mods_l, 2, l == 0, X, true, args.in[I_N2G] + (size_t)l * D, mods_l + 4 * D, SS + (size_t)(2 * l + 1) * M, HB, (const LAS float*)(lds + pg8::STAGE_BYTES)}};
            pg8::gemm_phase<pg8::EpiPabOut, pg8::PabOutOrder>(lds, wave0, D, D, D, S, E);
        } else {
#if EN_PAB
        {
            OPQ_BX();
            for (int rep_ = 0; rep_ < REP_PAB; ++rep_) {
            pg8::TileOrder S; S.init(M, D, G, bx, AF, D, wt + WT_PA, AD + FD, YB, D, 2); S.half_tail(); pg8::EpiPab E{QK, YB, (const LAS float*)(lds + pg8::STAGE_BYTES)}; pg8::gemm_phase<pg8::EpiPab, pg8::TileOrder>(lds, wave0, D, AD + FD, AD + FD, S, E);
            }
        }
#endif
        GRID_BAR();

#if EN_OUT
        {
            OPQ_BX();
            pg8::TileOrder S; S.init(M, D, G, bx, YB, D, wt + WT_OUT, D, X, D, 4); S.half_tail();
            pg8::EpiRes E{args.in[I_XP], args.in[I_XS], X, mods_l, 2, l == 0, X, true, args.in[I_N2G] + (size_t)l * D, mods_l + 4 * D, SS + (size_t)(2 * l + 1) * M, HB, (const LAS float*)(lds + pg8::STAGE_BYTES)};
            for (int rep_ = 1; rep_ < REP_OUT; ++rep_) { pg8::EpiRes E2{args.in[I_XP], args.in[I_XS], X, mods_l, 2, l == 0, (float*)QK, false, nullptr, nullptr, nullptr, nullptr, (const LAS float*)(lds + pg8::STAGE_BYTES)}; pg8::gemm_phase<pg8::EpiRes, pg8::TileOrder>(lds, wave0, D, D, D, S, E2); }
            pg8::gemm_phase<pg8::EpiRes, pg8::TileOrder>(lds, wave0, D, D, D, S, E);
        }
#endif
        }
        GRID_BAR();

#if EN_UP
        {
            OPQ_BX();
            pg8::UpOrder S; S.init(G, bx, HB, wt + WT_UP, ACT);
            pg8::EpiUpConv E{args.in[I_CONVW] + (size_t)l * 3 * FFN2, args.in[I_CONVB] + (size_t)l * FFN2, UH, SS + (size_t)(2 * l + 1) * M, BUP + (size_t)l * 5 * FFN2, (const LAS float*)(lds + pg8::STAGE_BYTES)};
            for (int rep_ = 0; rep_ < REP_UP; ++rep_)
            pg8::gemm_phase<pg8::EpiUpConv, pg8::UpOrder>(lds, wave0, D, D, D, S, E);
        }
#endif
        GRID_BAR();

#if EN_CONV
        {
            PIN_TID();
            const float* cw = args.in[I_CONVW] + (size_t)l * 3 * FFN2; const float* cb = args.in[I_CONVB] + (size_t)l * FFN2;
            for (int rep_ = 0; rep_ < REP_THIN; ++rep_)
            for (int it = gw; it < (M / 256) * 4 * 11; it += NGW) {
                const int pm = it / 44, rem = it - pm * 44, t = rem / 11, cc = rem - t * 11, j0 = cc * 512 + lane * 8;
                const int row = pm * 256 + (t == 0 ? 0 : t == 1 ? 127 : t == 2 ? 128 : 255);
                const int seqmask = row < MP ? (SEQ_P - 1) : (SEQ_S - 1);
                const int sc_ = t == 0 ? 0 : t == 1 ? 3 : t == 2 ? 4 : 7;
                const bool zprev = (t == 0) && ((row & seqmask) == 0), znext = (t == 3) && ((row & seqmask) == seqmask);
                const float* pc = UH + ((size_t)pm * 8 + sc_) * FFN2 + j0;
                const float* pp = (t == 0) ? UH + ((size_t)(pm - 1) * 8 + 7) * FFN2 + j0 : pc - FFN2;
                const float* pn = (t == 3) ? UH + ((size_t)(pm + 1) * 8 + 0) * FFN2 + j0 : pc + FFN2;
                float o[8];
#pragma unroll
                for (int h = 0; h < 2; ++h) {
                    const f32x4 z4 = {0.f, 0.f, 0.f, 0.f};
                    const f32x4 ap = zprev ? z4 : *(const GAS f32x4*)(pp + 4 * h), ac = *(const GAS f32x4*)(pc + 4 * h), an = znext ? z4 : *(const GAS f32x4*)(pn + 4 * h);
                    const f32x4 gp = zprev ? z4 : *(const GAS f32x4*)(pp + FFN + 4 * h), gc = *(const GAS f32x4*)(pc + FFN + 4 * h), gn = znext ? z4 : *(const GAS f32x4*)(pn + FFN + 4 * h);
                    const f32x4 wa0 = *(const GAS f32x4*)(cw + j0 + 4 * h), wa1 = *(const GAS f32x4*)(cw + FFN2 + j0 + 4 * h), wa2 = *(const GAS f32x4*)(cw + 2 * FFN2 + j0 + 4 * h), ba = *(const GAS f32x4*)(cb + j0 + 4 * h);
                    const f32x4 wg0 = *(const GAS f32x4*)(cw + FFN + j0 + 4 * h), wg1 = *(const GAS f32x4*)(cw + FFN2 + FFN + j0 + 4 * h), wg2 = *(const GAS f32x4*)(cw + 2 * FFN2 + FFN + j0 + 4 * h), bg = *(const GAS f32x4*)(cb + FFN + j0 + 4 * h);
#pragma unroll
                    for (int e = 0; e < 4; ++e) { const float A = wa0[e] * ap[e] + wa1[e] * ac[e] + wa2[e] * an[e] + ba[e], Gv = wg0[e] * gp[e] + wg1[e] * gc[e] + wg2[e] * gn[e] + bg[e];
                        o[4 * h + e] = Gv * sigmoidf_fast(Gv) * A; }
                }
                u32x4 w; w.x = cvt_pk_bf16(o[0], o[1]); w.y = cvt_pk_bf16(o[2], o[3]); w.z = cvt_pk_bf16(o[4], o[5]); w.w = cvt_pk_bf16(o[6], o[7]);
                *(GAS u32x4*)(ACT + (size_t)row * FFN + j0) = w;
            }
        }
#endif
        GRID_BAR();

#if EN_DOWN
        {
            OPQ_BX();
            pg8::TileOrder S; S.init(M, D, G, bx, ACT, FFN, wt + WT_DOWN, FFN, X, D, 4); S.split_tail(40, (unsigned*)(ws + WS_CTL) + CW_FLAG + (size_t)l * 128 * 16);
            const int ln = l + 1 < DEPTH ? l + 1 : l;
            pg8::EpiRes E{args.in[I_XP], args.in[I_XS], X, mods_l, 5, false, X, l + 1 < DEPTH, args.in[I_N1G] + (size_t)ln * D, MODS + (size_t)ln * 5 * NMOD * D + 1 * D, SS + (size_t)(2 * ln) * M, HB, (const LAS float*)(lds + pg8::STAGE_BYTES)};
            for (int rep_ = 1; rep_ < REP_DOWN; ++rep_) { pg8::EpiRes E2{args.in[I_XP], args.in[I_XS], X, mods_l, 5, false, (float*)QK, false, nullptr, nullptr, nullptr, nullptr, (const LAS float*)(lds + pg8::STAGE_BYTES)}; pg8::gemm_phase<pg8::EpiRes, pg8::TileOrder>(lds, wave0, FFN, FFN, FFN, S, E2); }
            pg8::gemm_phase<pg8::EpiRes, pg8::TileOrder>(lds, wave0, FFN, FFN, FFN, S, E);
        }
#endif
        GRID_BAR();
    }

#if EN_FINAL
    {
        PIN_TID();
        const float* gvec = args.in[I_NFG];
        for (int row = gw; row < M; row += NGW) {
            float* src = X + (size_t)row * D;
            f32x4 v[8]; float ss = 0.f;
#pragma unroll
            for (int j = 0; j < 8; ++j) { v[j] = *(const f32x4*)(src + 4 * (lane + 64 * j)); ss += (v[j][0] * v[j][0] + v[j][1] * v[j][1]) + (v[j][2] * v[j][2] + v[j][3] * v[j][3]); }
            const float rstd = rsqrtf(wave_sum(ss) * (1.0f / D) + RMS_EPS);
#pragma unroll
            for (int j = 0; j < 8; ++j) { const int col = 4 * (lane + 64 * j); const f32x4 g = *(const f32x4*)(gvec + col); *(f32x4*)(src + col) = (v[j] * rstd) * g; }
        }
    }
#endif
}

extern "C" void kernel_launch(void* const* d_in, const int* in_sizes, int n_in, void* d_out, int out_size, void* d_ws, size_t ws_size, hipStream_t stream) {
    static int grid = 0;
    if (grid == 0) {
        if (n_in != 20 || in_sizes[0] != MP * D || in_sizes[1] != MS * D || ws_size < WS_END) {
            fprintf(stderr, "kernel_launch: shape mismatch: n_in %d in0 %d in1 %d out %d ws %zu (need >= %zu); nothing launched\n", n_in, n_in > 0 ? in_sizes[0] : -1, n_in > 1 ? in_sizes[1] : -1, out_size, ws_size, (size_t)WS_END); grid = -1; return; }
        int dev = 0, cus = 0, per_cu = 0;
        if (hipGetDevice(&dev) != hipSuccess || hipDeviceGetAttribute(&cus, hipDeviceAttributeMultiprocessorCount, dev) != hipSuccess) { fprintf(stderr, "kernel_launch: device query failed\n"); grid = -1; return; }
        if (hipFuncSetAttribute((const void*)fwd, hipFuncAttributeMaxDynamicSharedMemorySize, LDS_BYTES) != hipSuccess) { fprintf(stderr, "kernel_launch: hipFuncSetAttribute failed\n"); grid = -1; return; }
        if (hipOccupancyMaxActiveBlocksPerMultiprocessor(&per_cu, (const void*)fwd, NTHREADS, LDS_BYTES) != hipSuccess || per_cu < 1)
            fprintf(stderr, "kernel_launch: note: occupancy query reports %d workgroups per CU\n", per_cu);
        (void)hipGetLastError();
        grid = cus;
    }
    if (grid < 0) return;
    if (hipMemsetAsync((char*)d_ws + WS_CTL, 0, CTL_ZERO_BYTES, stream) != hipSuccess) { fprintf(stderr, "kernel_launch: memset failed\n"); return; }
    Args a{};
    for (int i = 0; i < 20; ++i) a.in[i] = (const float*)d_in[i];
    a.out = (float*)d_out; a.ws = (unsigned char*)d_ws;
    hipLaunchKernelGGL(fwd, dim3(grid), dim3(NTHREADS), LDS_BYTES, stream, a);
    const hipError_t le = hipPeekAtLastError();
    if (le != hipSuccess) fprintf(stderr, "kernel_launch: launch failed: %s\n", hipGetErrorName(le));
}
```
